# Optimizing an MI355X kernel written in HIP

```python
import math
import jax
import jax.numpy as jnp
from jax import lax
import numpy as np

D_MODEL = 2048
BATCH = 16
SEQ = 2048
DEPTH = 4

D_MIX = D_MODEL
HG_DK = 128
HG_DV = 128
HG_WIDTH = D_MIX // 2
HG_HEADS = HG_WIDTH // HG_DV
HG_QK = HG_HEADS * HG_DK
HG_CHUNK = 32
DA_HEAD_DIM = 64
DA_VDIM = 2 * DA_HEAD_DIM
DA_WIDTH = D_MIX // 4
DA_HEADS = DA_WIDTH // DA_VDIM
DA_QK = DA_HEADS * 2 * DA_HEAD_DIM
SC_WIDTH = D_MIX - HG_WIDTH - DA_WIDTH
SC_GROUPS = 4
SC_GROUP_DIM = SC_WIDTH // SC_GROUPS
SC_KSIZE = 3
D_FF = ((8 * D_MODEL // 3 + 127) // 128) * 128
ROPE_THETA = 10000.0
Q_BLOCK = 128
EPS = 1e-6
IN_SPLITS = (HG_QK, HG_WIDTH, HG_QK, HG_QK, HG_WIDTH, DA_QK, DA_QK, DA_WIDTH, SC_WIDTH, SC_WIDTH, SC_WIDTH)
D_IN = sum(IN_SPLITS)

kernel_name = "hybrid_hgrn2_diffattn_shortconv_macaron"


def _rms_norm(x, gain):
    xf = x.astype(jnp.float32)
    y = xf * lax.rsqrt(jnp.mean(xf * xf, axis=-1, keepdims=True) + EPS)
    return (y * gain.astype(jnp.float32)).astype(x.dtype)


def _swiglu(h, w_gate, w_up, w_down):
    return (jax.nn.silu(h @ w_gate) * (h @ w_up)) @ w_down


def _rope(t, cos, sin):
    half = t.shape[-1] // 2
    t1, t2 = t[..., :half], t[..., half:]
    return jnp.concatenate([t1 * cos - t2 * sin, t2 * cos + t1 * sin], axis=-1)


def _split_columns(proj):
    parts = []
    start = 0
    for width in IN_SPLITS:
        parts.append(proj[..., start:start + width])
        start += width
    return parts


def _gla_chunk_scan(q, k, v, log_f):
    b_, s_, h_, dk = q.shape
    dv = v.shape[-1]
    n_chunks = s_ // HG_CHUNK

    def to_chunks(t):
        return t.astype(jnp.float32).reshape(b_, n_chunks, HG_CHUNK, h_, t.shape[-1]).transpose(1, 0, 3, 2, 4)

    lower = jnp.tril(jnp.ones((HG_CHUNK, HG_CHUNK), dtype=bool))[:, :, None]

    def step(state, inp):
        qc, kc, vc, lf = inp
        cum = jnp.cumsum(lf, axis=2)
        o_inter = jnp.einsum('bhtk,bhkv->bhtv', qc * jnp.exp(cum), state)
        rel = cum[:, :, :, None, :] - cum[:, :, None, :, :]
        decay = jnp.exp(jnp.where(lower, rel, -jnp.inf))
        scores = jnp.einsum('bhtsk,bhsk->bhts', qc[:, :, :, None, :] * decay, kc)
        o_intra = jnp.einsum('bhts,bhsv->bhtv', scores, vc)
        cum_end = cum[:, :, -1:, :]
        state = (jnp.exp(cum_end[:, :, 0, :])[..., None] * state
                 + jnp.einsum('bhsk,bhsv->bhkv', kc * jnp.exp(cum_end - cum), vc))
        return state, o_inter + o_intra

    state0 = jnp.zeros((b_, h_, dk, dv), jnp.float32)
    _, o = lax.scan(step, state0, (to_chunks(q), to_chunks(k), to_chunks(v), to_chunks(log_f)))
    return o.transpose(1, 0, 3, 2, 4).reshape(b_, s_, h_, dv)


def _hgrn2_gates(z, lb):
    zf = z.astype(jnp.float32)
    f = lb + (1.0 - lb) * jax.nn.sigmoid(zf)
    return jnp.log(f), (1.0 - lb) * jax.nn.sigmoid(-zf)


def _hgrn2_mixer(q, i, z_fwd, z_bwd, g, lb_fwd, lb_bwd, norm_gain):
    b_, s_, _ = q.shape

    def heads(t):
        return t.reshape(b_, s_, HG_HEADS, -1)

    def flip(t):
        return jnp.flip(t, axis=1)

    lf_fwd, k_fwd = _hgrn2_gates(z_fwd, lb_fwd)
    lf_bwd, k_bwd = _hgrn2_gates(z_bwd, lb_bwd)
    qh, ih = heads(q), heads(i)
    o_fwd = _gla_chunk_scan(qh, heads(k_fwd), ih, heads(lf_fwd))
    o_bwd = flip(_gla_chunk_scan(flip(qh), flip(heads(k_bwd)), flip(ih), flip(heads(lf_bwd))))
    o = _rms_norm(o_fwd + o_bwd, norm_gain.reshape(HG_HEADS, HG_DV))
    return o.reshape(b_, s_, HG_WIDTH).astype(g.dtype) * jax.nn.silu(g)


def _diff_attention(q, k, v, q_gain, k_gain, lam, cos, sin):
    b_, s_, _ = q.shape
    dt = q.dtype

    def prep(t, gain):
        t = _rms_norm(t.reshape(b_, s_, DA_HEADS, 2, DA_HEAD_DIM), gain)
        return _rope(t.astype(jnp.float32), cos, sin).astype(dt)

    qh, kh = prep(q, q_gain), prep(k, k_gain)
    vh = v.reshape(b_, s_, DA_HEADS, DA_VDIM)
    n_blocks = s_ // Q_BLOCK
    q_blocks = qh.reshape(b_, n_blocks, Q_BLOCK, DA_HEADS, 2, DA_HEAD_DIM).transpose(1, 0, 2, 3, 4, 5)
    scale = DA_HEAD_DIM ** -0.5

    def block(qb):
        s = jnp.einsum('bqhmd,bkhmd->bhmqk', qb, kh).astype(jnp.float32) * scale
        p = jax.nn.softmax(s, axis=-1)
        a = p[:, :, 0] - lam * p[:, :, 1]
        return jnp.einsum('bhqk,bkhe->bqhe', a.astype(dt), vh)

    o = lax.map(block, q_blocks)
    return o.transpose(1, 0, 2, 3, 4).reshape(b_, s_, DA_HEADS, DA_VDIM)


def _short_conv_mixer(b_gate, c_gate, u, conv_w, conv_b, norm_gain):
    b_, s_, _ = u.shape
    v = c_gate * u
    pad = SC_KSIZE // 2
    vp = jnp.pad(v, ((0, 0), (pad, pad), (0, 0)))
    y = conv_b
    for j in range(SC_KSIZE):
        y = y + vp[:, j:j + s_] * conv_w[j]
    y = b_gate * y
    y = _rms_norm(y.reshape(b_, s_, SC_GROUPS, SC_GROUP_DIM), norm_gain.reshape(SC_GROUPS, SC_GROUP_DIM))
    return y.reshape(b_, s_, SC_WIDTH)


def setup_inputs(seed: int = 0) -> dict:
    key = jax.random.key(seed)
    ks = jax.random.split(key, 32)
    f32 = jnp.float32

    def nrm(k, shape, scale):
        return jax.random.normal(k, shape, f32) * scale

    def gain(k, shape):
        return 1.0 + 0.1 * jax.random.normal(k, shape, f32)

    sd = D_MODEL ** -0.5
    sf = D_FF ** -0.5
    sm = D_MIX ** -0.5
    return {
        "x": jax.random.normal(ks[0], (BATCH, SEQ, D_MODEL), f32),
        "positions": jnp.broadcast_to(jnp.arange(SEQ, dtype=jnp.int32), (BATCH, SEQ)),
        "ffn1_norm": gain(ks[1], (DEPTH, D_MODEL)),
        "ffn1_w_gate": nrm(ks[2], (DEPTH, D_MODEL, D_FF), sd),
        "ffn1_w_up": nrm(ks[3], (DEPTH, D_MODEL, D_FF), sd),
        "ffn1_w_down": nrm(ks[4], (DEPTH, D_FF, D_MODEL), sf),
        "mix_norm": gain(ks[5], (DEPTH, D_MODEL)),
        "w_in": nrm(ks[6], (DEPTH, D_MODEL, D_IN), sd),
        "hgrn_lb_logits": nrm(ks[7], (2, DEPTH, HG_QK), 0.1),
        "hgrn_norm": gain(ks[8], (DEPTH, HG_WIDTH)),
        "da_q_norm": gain(ks[9], (DEPTH, DA_HEAD_DIM)),
        "da_k_norm": gain(ks[10], (DEPTH, DA_HEAD_DIM)),
        "da_lambda_q1": nrm(ks[11], (DEPTH, DA_HEAD_DIM), 0.1),
        "da_lambda_k1": nrm(ks[12], (DEPTH, DA_HEAD_DIM), 0.1),
        "da_lambda_q2": nrm(ks[13], (DEPTH, DA_HEAD_DIM), 0.1),
        "da_lambda_k2": nrm(ks[14], (DEPTH, DA_HEAD_DIM), 0.1),
        "da_out_norm": gain(ks[15], (DEPTH, DA_WIDTH)),
        "conv_w": nrm(ks[16], (DEPTH, SC_KSIZE, SC_WIDTH), SC_KSIZE ** -0.5),
        "conv_b": nrm(ks[17], (DEPTH, SC_WIDTH), 0.02),
        "conv_norm": gain(ks[18], (DEPTH, SC_WIDTH)),
        "w_out": nrm(ks[19], (DEPTH, D_MIX, D_MODEL), sm),
        "ffn2_norm": gain(ks[20], (DEPTH, D_MODEL)),
        "ffn2_w_gate": nrm(ks[21], (DEPTH, D_MODEL, D_FF), sd),
        "ffn2_w_up": nrm(ks[22], (DEPTH, D_MODEL, D_FF), sd),
        "ffn2_w_down": nrm(ks[23], (DEPTH, D_FF, D_MODEL), sf),
    }


def reference(x, positions, ffn1_norm, ffn1_w_gate, ffn1_w_up, ffn1_w_down, mix_norm, w_in,
              hgrn_lb_logits, hgrn_norm, da_q_norm, da_k_norm, da_lambda_q1, da_lambda_k1,
              da_lambda_q2, da_lambda_k2, da_out_norm, conv_w, conv_b, conv_norm, w_out,
              ffn2_norm, ffn2_w_gate, ffn2_w_up, ffn2_w_down):
    f32 = jnp.float32
    inv_freq = ROPE_THETA ** (-jnp.arange(0, DA_HEAD_DIM, 2, dtype=f32) / DA_HEAD_DIM)
    ang = positions.astype(f32)[..., None] * inv_freq
    cos = jnp.cos(ang)[:, :, None, None, :]
    sin = jnp.sin(ang)[:, :, None, None, :]
    lb_all = jnp.cumsum(jax.nn.softmax(hgrn_lb_logits.astype(f32), axis=1), axis=1)
    lb_all = lb_all - lb_all[:, :1]

    for layer in range(DEPTH):
        h = _rms_norm(x, ffn1_norm[layer])
        x = x + 0.5 * _swiglu(h, ffn1_w_gate[layer], ffn1_w_up[layer], ffn1_w_down[layer])

        h = _rms_norm(x, mix_norm[layer])
        (hg_q, hg_i, hg_zf, hg_zb, hg_g, da_q, da_k, da_v,
         sc_b, sc_c, sc_u) = _split_columns(h @ w_in[layer])

        y_a = _hgrn2_mixer(hg_q, hg_i, hg_zf, hg_zb, hg_g,
                           lb_all[0, layer], lb_all[1, layer], hgrn_norm[layer])

        lam_init = 0.8 - 0.6 * math.exp(-0.3 * layer)
        lam = (jnp.exp(jnp.sum(da_lambda_q1[layer].astype(f32) * da_lambda_k1[layer].astype(f32)))
               - jnp.exp(jnp.sum(da_lambda_q2[layer].astype(f32) * da_lambda_k2[layer].astype(f32)))
               + lam_init)
        o_b = _diff_attention(da_q, da_k, da_v, da_q_norm[layer], da_k_norm[layer], lam, cos, sin)
        y_b = (_rms_norm(o_b, da_out_norm[layer].reshape(DA_HEADS, DA_VDIM)) * (1.0 - lam_init)).reshape(
            x.shape[0], x.shape[1], DA_WIDTH)

        y_c = _short_conv_mixer(sc_b, sc_c, sc_u, conv_w[layer], conv_b[layer], conv_norm[layer])

        y = jnp.concatenate([y_a.astype(h.dtype), y_b.astype(h.dtype), y_c.astype(h.dtype)], axis=-1)
        x = x + y @ w_out[layer]

        h = _rms_norm(x, ffn2_norm[layer])
        x = x + 0.5 * _swiglu(h, ffn2_w_gate[layer], ffn2_w_up[layer], ffn2_w_down[layer])
    return x
```

```cpp
#include <hip/hip_runtime.h>
#include <cstdio>
#include <cstdint>
namespace pg8 {
#define PG8_LAS __attribute__((address_space(3)))
typedef unsigned short bf16_t;
typedef short bf16x8 __attribute__((ext_vector_type(8)));
typedef float f32x4 __attribute__((ext_vector_type(4)));
typedef unsigned u32x4 __attribute__((ext_vector_type(4)));
constexpr int BM = 256, BK = 64, HALF = 128, HTB = HALF * BK * 2  , STAGE_BYTES = 8 * HTB, NXCD = 8, WGM = 8;

__host__ __device__ __forceinline__ int lds_byte(int r, int c) { const int st = (r >> 4) * 2 + (c >> 5), rr = r & 15, cc = c & 31, ob = rr * 64 + cc * 2; return st * 1024 + (ob ^ (((ob >> 9) & 1) << 5)); }
__host__ __device__ __forceinline__ void stage_rc(int b, int& R, int& C) { const int st = b / 1024, sb = b % 1024, swz = sb ^ (((sb >> 9) & 1) << 5); R = (st >> 1) * 16 + swz / 64; C = (st & 1) * 32 + (swz % 64) / 2; }
__host__ __device__ __forceinline__ int perm32(int rho) { const int n = rho >> 4, i = rho & 15; return 8 * (i >> 2) + 4 * n + (i & 3); }

struct Unit { int pm, pn; };
struct Gemm { const bf16_t* A; const bf16_t* Bt; int M, N, K; };

struct StaticOrder {
    int nM, nN, nwg, G, c;
    __host__ __device__ void init(int M, int N, int G_, int c_) { nM = M / BM; nN = N / BM; nwg = nM * nN; G = G_; c = c_; }
    __host__ __device__ bool next(int i, Unit& u) const {
        const long L = (long)i * G + c; if (L >= nwg) return false;
        int wgid = (int)L; { const int q = nwg / NXCD, r = nwg % NXCD, xcd = wgid % NXCD, off = wgid / NXCD; wgid = (xcd < r ? xcd * (q + 1) : r * (q + 1) + (xcd - r) * q) + off; }
        const int nig = WGM * nN, gid = wgid / nig, fm = gid * WGM, gsz = (nM - fm) < WGM ? (nM - fm) : WGM;
        u.pm = fm + ((wgid % nig) % gsz); u.pn = (wgid % nig) / gsz; return true;
    }
    __device__ __forceinline__ void a_ready(const Unit&) const {}
    __device__ __forceinline__ void done(const Unit&) const {}
};

__device__ __forceinline__ unsigned cvt_pk_bf16(float lo, float hi) { unsigned r; asm volatile("v_cvt_pk_bf16_f32 %0, %1, %2" : "=v"(r) : "v"(lo), "v"(hi)); return r; }

struct EpiBf16 {
    static constexpr bool PERM = true, AFTER_DRAIN = false;
    bf16_t* O; int ldc;
    __device__ __forceinline__ void operator()(const f32x4 (&acc)[2][2][4][2], const Unit& u, int wr, int wc, int fr, int fq) const {
        const int row0 = u.pm * BM + wr * 64 + fr, col0 = u.pn * BM + wc * 32 + 8 * fq;
#pragma unroll
        for (int ai = 0; ai < 2; ++ai)
#pragma unroll
            for (int m = 0; m < 4; ++m) { bf16_t* rowp = O + (size_t)(row0 + ai * HALF + m * 16) * ldc + col0;
#pragma unroll
                for (int bj = 0; bj < 2; ++bj) { const f32x4 v0 = acc[ai][bj][m][0], v1 = acc[ai][bj][m][1];
                    u32x4 w; w.x = cvt_pk_bf16(v0[0], v0[1]); w.y = cvt_pk_bf16(v0[2], v0[3]); w.z = cvt_pk_bf16(v1[0], v1[1]); w.w = cvt_pk_bf16(v1[2], v1[3]);
                    *(u32x4*)(rowp + bj * HALF) = w; } }
    }
};
struct EpiSwiGLU {
    static constexpr bool PERM = true, AFTER_DRAIN = false;
    bf16_t* O; int ldc;
    __device__ __forceinline__ float sg(float g, float u) const { const float e = __builtin_amdgcn_exp2f(g * -1.44269504088896341f); return g * __builtin_amdgcn_rcpf(1.0f + e) * u; }
    __device__ __forceinline__ void operator()(const f32x4 (&acc)[2][2][4][2], const Unit& u, int wr, int wc, int fr, int fq) const {
        const int row0 = u.pm * BM + wr * 64 + fr, col0 = u.pn * HALF + wc * 32 + 8 * fq;
#pragma unroll
        for (int ai = 0; ai < 2; ++ai)
#pragma unroll
            for (int m = 0; m < 4; ++m) { bf16_t* rowp = O + (size_t)(row0 + ai * HALF + m * 16) * ldc + col0;
                const f32x4 g0 = acc[ai][0][m][0], g1 = acc[ai][0][m][1], u0 = acc[ai][1][m][0], u1 = acc[ai][1][m][1];
                u32x4 w; w.x = cvt_pk_bf16(sg(g0[0], u0[0]), sg(g0[1], u0[1])); w.y = cvt_pk_bf16(sg(g0[2], u0[2]), sg(g0[3], u0[3]));
                w.z = cvt_pk_bf16(sg(g1[0], u1[0]), sg(g1[1], u1[1])); w.w = cvt_pk_bf16(sg(g1[2], u1[2]), sg(g1[3], u1[3]));
                *(u32x4*)rowp = w; }
    }
};
struct EpiResAdd {
    static constexpr bool PERM = false, AFTER_DRAIN = false;
    const float* base; float* out; int ldc; float scale;
    __device__ __forceinline__ void operator()(const f32x4 (&acc)[2][2][4][2], const Unit& u, int wr, int wc, int fr, int fq) const {
        const int row0 = u.pm * BM + wr * 64 + fr, col0 = u.pn * BM + wc * 32 + 4 * fq;
#pragma unroll
        for (int ai = 0; ai < 2; ++ai)
#pragma unroll
            for (int m = 0; m < 4; ++m) { const size_t off = (size_t)(row0 + ai * HALF + m * 16) * ldc + col0;
#pragma unroll
                for (int bj = 0; bj < 2; ++bj)
#pragma unroll
                    for (int n = 0; n < 2; ++n) { const f32x4 b = *(const f32x4*)(base + off + bj * HALF + n * 16); *(f32x4*)(out + off + bj * HALF + n * 16) = b + acc[ai][bj][m][n] * scale; }
                asm volatile("" ::: "memory"); }
    }
};

template <class Epi, class Sched, bool ALIGN_EPI = false, bool SP2 = false>
__device__ __forceinline__ void gemm_phase(PG8_LAS unsigned char* lds, const Gemm g, const Sched& S, const Epi& E) {
    int tid_ = threadIdx.x; asm volatile("" : "+v"(tid_));
    const int tid = tid_, wid = __builtin_amdgcn_readfirstlane(tid >> 6), lane = tid & 63, wr = wid >> 2, wc = wid & 3, fr = lane & 15, fq = lane >> 4;
    const int K = g.K, nt = K / BK;
    unsigned voffA[2], voffB[2];
#pragma unroll
    for (int i = 0; i < 2; ++i) { int R, C; stage_rc(tid * 16 + i * 8192, R, C); const int Rb = Epi::PERM ? ((R & ~31) + perm32(R & 31)) : R;
        voffA[i] = (unsigned)(R * K + C) * 2u; voffB[i] = (unsigned)(Rb * K + C) * 2u; }
    const size_t kstep = (size_t)(BK * 2);
    const size_t hstep = (size_t)HALF * K * 2;
    const size_t tstep = 2 * hstep;
    const unsigned ldsw = (unsigned)wid * 1024u;
    const int aoff = lds_byte(wr * 64 + fr, fq * 8), boff = lds_byte(wc * 32 + fr, fq * 8);
#define PG8_SA(b, h) (((b) * 2 + (h)) * HTB)
#define PG8_SB(b, h) ((4 + (b) * 2 + (h)) * HTB)
#define PG8_STAGE(bufoff, gbase, voff) do { _Pragma("unroll") for (int _i = 0; _i < 2; ++_i) \
        __builtin_amdgcn_global_load_lds((const unsigned*)((const char*)(gbase) + (voff)[_i]), (PG8_LAS unsigned*)(lds + (bufoff) + ldsw + _i * 8192), 16, 0, 0); } while (0)
#define PG8_LDA(dst, b, h) do { _Pragma("unroll") for (int m = 0; m < 4; ++m) _Pragma("unroll") for (int k = 0; k < 2; ++k) dst[m][k] = *(const PG8_LAS bf16x8*)(lds + PG8_SA(b, h) + aoff + m * 2048 + k * 1024); } while (0)
#define PG8_LDB(dst, b, h) do { _Pragma("unroll") for (int n = 0; n < 2; ++n) _Pragma("unroll") for (int k = 0; k < 2; ++k) dst[n][k] = *(const PG8_LAS bf16x8*)(lds + PG8_SB(b, h) + boff + n * 2048 + k * 1024); } while (0)
#define PG8_MMA(ai, bj, At, Bt) do { __builtin_amdgcn_s_setprio(1); _Pragma("unroll") for (int m = 0; m < 4; ++m) _Pragma("unroll") for (int n = 0; n < 2; ++n) _Pragma("unroll") for (int k = 0; k < 2; ++k) \
        acc[ai][bj][m][n] = __builtin_amdgcn_mfma_f32_16x16x32_bf16(Bt[n][k], At[m][k], acc[ai][bj][m][n], 0, 0, 0); __builtin_amdgcn_s_setprio(0); } while (0)
#define PG8_WAIT_V(n) asm volatile("s_waitcnt vmcnt(" #n ")" ::: "memory")
#define PG8_WAIT_L(n) asm volatile("s_waitcnt lgkmcnt(" #n ")" ::: "memory")
#define PG8_BAR __builtin_amdgcn_s_barrier()
#define PG8_SCHED __builtin_amdgcn_sched_barrier(0)
    Unit cur, nxt; int ui = 0;
    if (!S.next(0, cur)) return;
    f32x4 acc[2][2][4][2];
#pragma unroll
    for (int a = 0; a < 2; ++a)
#pragma unroll
        for (int b = 0; b < 2; ++b)
#pragma unroll
            for (int m = 0; m < 4; ++m)
#pragma unroll
                for (int n = 0; n < 2; ++n) acc[a][b][m][n] = (f32x4){0.f, 0.f, 0.f, 0.f};
    bf16x8 At[4][2], B0[2][2], B1[2][2];
    const char* cA = (const char*)g.A + (size_t)cur.pm * tstep; const char* cB = (const char*)g.Bt + (size_t)cur.pn * tstep;
    S.a_ready(cur);
    if constexpr (SP2) {
        PG8_STAGE(PG8_SB(0, 0), cB, voffB); PG8_STAGE(PG8_SB(0, 1), cB + hstep, voffB); PG8_STAGE(PG8_SA(0, 0), cA, voffA); PG8_STAGE(PG8_SA(0, 1), cA + hstep, voffA);
        if (wr == 1) PG8_BAR;
        PG8_WAIT_V(2); PG8_BAR;
        PG8_STAGE(PG8_SB(1, 0), cB + kstep, voffB); PG8_STAGE(PG8_SA(1, 0), cA + kstep, voffA); PG8_STAGE(PG8_SB(1, 1), cB + hstep + kstep, voffB);
        PG8_WAIT_V(6); PG8_BAR;
    } else {
        PG8_STAGE(PG8_SB(0, 0), cB, voffB); PG8_STAGE(PG8_SA(0, 0), cA, voffA); PG8_STAGE(PG8_SB(0, 1), cB + hstep, voffB); PG8_STAGE(PG8_SA(0, 1), cA + hstep, voffA);
        if (wr == 1) PG8_BAR;
        PG8_WAIT_V(4); PG8_BAR;
        PG8_STAGE(PG8_SB(1, 0), cB + kstep, voffB); PG8_STAGE(PG8_SA(1, 0), cA + kstep, voffA); PG8_STAGE(PG8_SB(1, 1), cB + hstep + kstep, voffB);
        PG8_WAIT_V(6); PG8_BAR;
    }
    for (;;) {
        const bool has_next = S.next(ui + 1, nxt);
        const char* nA = has_next ? (const char*)g.A + (size_t)nxt.pm * tstep : cA; const char* nB = has_next ? (const char*)g.Bt + (size_t)nxt.pn * tstep : cB;
        for (int t = 0; t < nt; t += 2) {
            const bool last = (t == nt - 2);
            const char* a1 = cA + (size_t)(t + 1) * kstep;
            const char* a2 = last ? nA : cA + (size_t)(t + 2) * kstep; const char* b2 = last ? nB : cB + (size_t)(t + 2) * kstep;
            const char* a3 = a2 + kstep; const char* b3 = b2 + kstep;
            if (last && has_next) S.a_ready(nxt);
            if constexpr (SP2) {
            PG8_LDB(B0, 0, 0); PG8_LDB(B1, 0, 1); PG8_SCHED; PG8_LDA(At, 0, 0); PG8_STAGE(PG8_SA(1, 1), a1 + hstep, voffA);
            PG8_WAIT_V(8); PG8_WAIT_L(0); PG8_BAR; PG8_MMA(0, 0, At, B0); PG8_MMA(0, 1, At, B1); PG8_BAR; PG8_SCHED;
            PG8_LDA(At, 0, 1); PG8_STAGE(PG8_SB(0, 0), b2, voffB); PG8_STAGE(PG8_SB(0, 1), b2 + hstep, voffB); PG8_STAGE(PG8_SA(0, 0), a2, voffA);
            PG8_WAIT_V(8); PG8_WAIT_L(0); PG8_BAR; PG8_MMA(1, 0, At, B0); PG8_MMA(1, 1, At, B1); PG8_BAR; PG8_SCHED;
            PG8_LDB(B0, 1, 0); PG8_LDB(B1, 1, 1); PG8_SCHED; PG8_LDA(At, 1, 0); PG8_STAGE(PG8_SA(0, 1), a2 + hstep, voffA);
            PG8_WAIT_V(8); PG8_WAIT_L(0); PG8_BAR; PG8_MMA(0, 0, At, B0); PG8_MMA(0, 1, At, B1); PG8_BAR; PG8_SCHED;
            PG8_LDA(At, 1, 1); PG8_STAGE(PG8_SB(1, 0), b3, voffB); PG8_STAGE(PG8_SB(1, 1), b3 + hstep, voffB); PG8_STAGE(PG8_SA(1, 0), a3, voffA);
            PG8_WAIT_V(8); PG8_WAIT_L(0); PG8_BAR; PG8_MMA(1, 0, At, B0); PG8_MMA(1, 1, At, B1); PG8_BAR; PG8_SCHED;
            } else {
            PG8_LDB(B0, 0, 0); PG8_SCHED; PG8_LDA(At, 0, 0); PG8_STAGE(PG8_SA(1, 1), a1 + hstep, voffA);
            PG8_WAIT_L(8); PG8_BAR; PG8_WAIT_L(0); PG8_MMA(0, 0, At, B0); PG8_BAR; PG8_SCHED;
            PG8_LDB(B1, 0, 1); PG8_STAGE(PG8_SB(0, 0), b2, voffB);
            PG8_BAR; PG8_WAIT_L(0); PG8_MMA(0, 1, At, B1); PG8_BAR;
            PG8_LDA(At, 0, 1); PG8_STAGE(PG8_SA(0, 0), a2, voffA);
            PG8_BAR; PG8_WAIT_L(0); PG8_MMA(1, 0, At, B0); PG8_BAR; PG8_SCHED;
            PG8_STAGE(PG8_SB(0, 1), b2 + hstep, voffB);
            PG8_WAIT_V(6); PG8_BAR; PG8_MMA(1, 1, At, B1); PG8_BAR;
            PG8_LDB(B0, 1, 0); PG8_SCHED; PG8_LDA(At, 1, 0); PG8_STAGE(PG8_SA(0, 1), a2 + hstep, voffA);
            PG8_WAIT_L(8); PG8_BAR; PG8_WAIT_L(0); PG8_MMA(0, 0, At, B0); PG8_BAR; PG8_SCHED;
            PG8_LDB(B1, 1, 1); PG8_STAGE(PG8_SB(1, 0), b3, voffB);
            PG8_BAR; PG8_WAIT_L(0); PG8_MMA(0, 1, At, B1); PG8_BAR;
            PG8_LDA(At, 1, 1); PG8_STAGE(PG8_SA(1, 0), a3, voffA);
            PG8_BAR; PG8_WAIT_L(0); PG8_MMA(1, 0, At, B0); PG8_BAR; PG8_SCHED;
            PG8_STAGE(PG8_SB(1, 1), b3 + hstep, voffB);
            PG8_WAIT_V(6); PG8_BAR; PG8_MMA(1, 1, At, B1); PG8_BAR;
            }
        }
        if constexpr (ALIGN_EPI) { if (wr == 0) PG8_BAR; }
        if constexpr (!Epi::AFTER_DRAIN) { E(acc, cur, wr, wc, fr, fq); S.done(cur); }
        if (!has_next) break;
#pragma unroll
        for (int a = 0; a < 2; ++a)
#pragma unroll
            for (int b = 0; b < 2; ++b)
#pragma unroll
                for (int m = 0; m < 4; ++m)
#pragma unroll
                    for (int n = 0; n < 2; ++n) acc[a][b][m][n] = (f32x4){0.f, 0.f, 0.f, 0.f};
        cur = nxt; cA = nA; cB = nB; ++ui;
        if constexpr (ALIGN_EPI) { if (wr == 1) PG8_BAR; }
    }
    PG8_WAIT_V(0);
    if constexpr (!ALIGN_EPI) { if (wr == 0) PG8_BAR; }
    PG8_BAR;
    if constexpr (Epi::AFTER_DRAIN) { E.fused(acc, cur, wr, wc, fr, fq, lds, wid, lane); S.done(cur); }
#undef PG8_SA
#undef PG8_SB
#undef PG8_STAGE
#undef PG8_LDA
#undef PG8_LDB
#undef PG8_MMA
#undef PG8_WAIT_V
#undef PG8_WAIT_L
#undef PG8_BAR
#undef PG8_SCHED
}
}

#define GAS __attribute__((address_space(1)))
#define LAS __attribute__((address_space(3)))
typedef unsigned short bf16;
typedef unsigned v4u __attribute__((ext_vector_type(4)));
typedef float f32x4 __attribute__((ext_vector_type(4)));
typedef GAS unsigned gu32;
#define LDS_WAIT() asm volatile("s_waitcnt lgkmcnt(0)" ::: "memory")
#define VM_WAIT() asm volatile("s_waitcnt vmcnt(0)" ::: "memory")

#define XB_TMO      128
#define XB_XCNT(j)  (256  + 64 * (j))
#define XB_XSUB(j)  (1280 + 64 * (j))
#define XB_XGEN(j)  (2304 + 64 * (j))
#define XB_TOP      3328
#define XB_TOPGEN   3392
#define XCD_BAR_WORDS 3456
#define XB_SPIN_CAP (1u << 18)

__device__ __forceinline__ unsigned xb_ld(unsigned* p)              { return __hip_atomic_load(p, __ATOMIC_RELAXED, __HIP_MEMORY_SCOPE_AGENT); }
__device__ __forceinline__ unsigned xb_add(unsigned* p, unsigned v) { return __hip_atomic_fetch_add(p, v, __ATOMIC_RELAXED, __HIP_MEMORY_SCOPE_AGENT); }
__device__ __forceinline__ unsigned xb_xcc_id() { return (unsigned)__builtin_amdgcn_s_getreg((3 << 11) | 20) & 0xFu; }
#define XB_SPIN(cond, bar) do { unsigned _sp = 0; while (cond) { __builtin_amdgcn_s_sleep(1); \
    if ((++_sp & 255u) == 0u) { if (xb_ld(&(bar)[XB_TMO])) break; if (_sp > XB_SPIN_CAP) { atomicAdd(&(bar)[XB_TMO], 1u); break; } } } } while (0)

struct XcdBarrier {
    unsigned* bar; unsigned x;
    volatile LAS unsigned* st;
};

__device__ __forceinline__ XcdBarrier xcd_barrier_post(unsigned* bar, volatile LAS unsigned* st) {
    XcdBarrier b; b.bar = bar; b.x = xb_xcc_id(); b.st = st;
    if (threadIdx.x == 0) (void)xb_add(&bar[XB_XCNT(b.x)], 1u);
    return b;
}
__device__ __forceinline__ void xcd_barrier_complete(unsigned* bar, unsigned x, unsigned& nloc, unsigned& nx) {
    const unsigned G = gridDim.x * gridDim.y * gridDim.z;
    unsigned sum, cnt, mine, sp = 0u;
    for (;;) {
        sum = 0u; cnt = 0u; mine = 0u;
#pragma unroll
        for (unsigned j = 0; j < 16; ++j) { const unsigned c = xb_ld(&bar[XB_XCNT(j)]); sum += c; cnt += (c > 0u) ? 1u : 0u; mine = (j == x) ? c : mine; }
        if (sum == G) break;
        __builtin_amdgcn_s_sleep(1);
        if ((++sp & 255u) == 0u) { if (xb_ld(&bar[XB_TMO])) break; if (sp > XB_SPIN_CAP) { atomicAdd(&bar[XB_TMO], 1u); break; } }
    }
    nloc = mine > 0u ? mine : 1u; nx = cnt > 0u ? cnt : 1u;
}

__device__ __forceinline__ void xcd_barrier(const XcdBarrier& b) {
    asm volatile("s_waitcnt vmcnt(0)" ::: "memory");
    __syncthreads();
    if (threadIdx.x == 0) {
        unsigned* bar = b.bar;
        __builtin_amdgcn_s_waitcnt(0);
        unsigned nloc = b.st[0], nx = b.st[1];
        if (nloc == 0u) { xcd_barrier_complete(bar, b.x, nloc, nx); b.st[0] = nloc; b.st[1] = nx; }
        const unsigned old = xb_add(&bar[XB_XSUB(b.x)], 1u);
        const unsigned gen = old / nloc;
        if (old + 1u == (gen + 1u) * nloc) {
            __builtin_amdgcn_fence(__ATOMIC_RELEASE, "agent");
            asm volatile("s_waitcnt vmcnt(0)" ::: "memory");
            const unsigned og = xb_add(&bar[XB_TOP], 1u);
            const unsigned tg = og / nx;
            if (og + 1u == (tg + 1u) * nx) xb_add(&bar[XB_TOPGEN], 1u);
            else XB_SPIN(xb_ld(&bar[XB_TOPGEN]) == tg, bar);
            __builtin_amdgcn_fence(__ATOMIC_ACQUIRE, "agent");
            xb_add(&bar[XB_XGEN(b.x)], 1u);
            asm volatile("s_waitcnt vmcnt(0)" ::: "memory");
        } else {
            XB_SPIN(xb_ld(&bar[XB_XGEN(b.x)]) == gen, bar);
            __builtin_amdgcn_fence(__ATOMIC_ACQUIRE, "agent");
            asm volatile("s_waitcnt vmcnt(0)" ::: "memory");
        }
    }
    __syncthreads();
}

namespace att {
using bf16x8 = __attribute__((ext_vector_type(8))) short;
using s16x4  = __attribute__((ext_vector_type(4))) short;
using f32x16 = __attribute__((ext_vector_type(16))) float;
using u32x4  = __attribute__((ext_vector_type(4))) unsigned;
constexpr int QBLK = 32, KVBLK = 64, NW = 8, DV = 128, DQK = 64;
constexpr float SCALE = 0.125f, THR = 8.f;
constexpr int ATT_LDP = 8192, ATT_LDO = 1024;
constexpr int SHM_V = KVBLK * DV * 2, SHM_K = KVBLK * DQK * 2, SHM_ATTN = 2 * SHM_V + 2 * SHM_K + NW * 64 * 4;
#define ATT_KSWZ(row, colB) ((row) * 128 + ((colB) ^ ((((row) >> 1) & 7) << 4)))
#define ATT_SBAR() __builtin_amdgcn_sched_barrier(0)
__device__ __forceinline__ int crow(int r, int hi) { return (r & 3) + 8 * (r >> 2) + 4 * hi; }
__device__ __forceinline__ unsigned cvtpk(float lo, float hi) { unsigned r; asm volatile("v_cvt_pk_bf16_f32 %0, %1, %2" : "=v"(r) : "v"(lo), "v"(hi)); return r; }

__device__ __forceinline__ void partialSM(f32x16& p0, f32x16& p1, float& m_reg, float& mn, float& alpha) {
  constexpr float C = SCALE * 1.4426950408889634f;
  float pmax = p0[0];
#pragma unroll
  for (int r = 1; r < 16; ++r) pmax = fmaxf(pmax, p0[r]);
#pragma unroll
  for (int r = 0; r < 16; ++r) pmax = fmaxf(pmax, p1[r]);
  { auto rr = __builtin_amdgcn_permlane32_swap(__float_as_uint(pmax), __float_as_uint(pmax), false, false);
    pmax = fmaxf(__uint_as_float(rr[0]), __uint_as_float(rr[1])); }
  if (__builtin_expect(__all(pmax - m_reg <= THR / SCALE), 1)) { mn = m_reg; alpha = 1.f; }
  else { mn = fmaxf(m_reg, pmax); alpha = __builtin_amdgcn_exp2f((m_reg - mn) * C); m_reg = mn; }
  float mnC = -mn * C;
#pragma unroll
  for (int r = 0; r < 16; ++r) p0[r] = fmaf(p0[r], C, mnC);
#pragma unroll
  for (int r = 0; r < 16; ++r) p1[r] = fmaf(p1[r], C, mnC);
#pragma unroll
  for (int r = 0; r < 16; ++r) p0[r] = __builtin_amdgcn_exp2f(p0[r]);
}
__device__ __forceinline__ void finishSM(f32x16& p0, f32x16& p1, float alpha, float& l_reg, bf16x8& pa0, bf16x8& pa1, bf16x8& pa2, bf16x8& pa3) {
#pragma unroll
  for (int r = 0; r < 16; ++r) p1[r] = __builtin_amdgcn_exp2f(p1[r]);
  float ps = 0;
#pragma unroll
  for (int r = 0; r < 16; ++r) ps += p0[r];
#pragma unroll
  for (int r = 0; r < 16; ++r) ps += p1[r];
  { auto rr = __builtin_amdgcn_permlane32_swap(__float_as_uint(ps), __float_as_uint(ps), false, false);
    ps = __uint_as_float(rr[0]) + __uint_as_float(rr[1]); }
  l_reg = l_reg * alpha + ps;
#define ATT_PK4(P, BASE, OUT) do { unsigned a0 = cvtpk(P[BASE + 0], P[BASE + 1]), a1 = cvtpk(P[BASE + 2], P[BASE + 3]);   \
    unsigned b0 = cvtpk(P[BASE + 4], P[BASE + 5]), b1 = cvtpk(P[BASE + 6], P[BASE + 7]);                              \
    auto r0 = __builtin_amdgcn_permlane32_swap(a0, b0, false, false); auto r1 = __builtin_amdgcn_permlane32_swap(a1, b1, false, false); \
    u32x4 w = {r0[0], r1[0], r0[1], r1[1]}; OUT = *reinterpret_cast<bf16x8*>(&w); } while (0)
  ATT_PK4(p0, 0, pa0); ATT_PK4(p0, 8, pa1); ATT_PK4(p1, 0, pa2); ATT_PK4(p1, 8, pa3);
#undef ATT_PK4
}
__device__ __forceinline__ void qkt(f32x16& p0, f32x16& p1, const char* Ks, const bf16x8 (&qr)[4], int r32, int hi) {
  p0 = f32x16{}; p1 = f32x16{};
#pragma unroll
  for (int d0 = 0; d0 < 4; ++d0) { const int cb = (d0 * 16 + hi * 8) * 2;
    bf16x8 b0 = *reinterpret_cast<const bf16x8*>(Ks + ATT_KSWZ(r32, cb));
    bf16x8 b1 = *reinterpret_cast<const bf16x8*>(Ks + ATT_KSWZ(32 + r32, cb));
    p0 = __builtin_amdgcn_mfma_f32_32x32x16_bf16(b0, qr[d0], p0, 0, 0, 0);
    p1 = __builtin_amdgcn_mfma_f32_32x32x16_bf16(b1, qr[d0], p1, 0, 0, 0); }
}
__device__ __forceinline__ int v_st(int k, int c) { const int kk = (k & ~0xC) | ((k & 4) << 1) | ((k & 8) >> 1); return ((kk >> 3) * 4 + (c >> 5)) * 512 + ((kk & 7) * 32 + (c & 31)) * 2; }
__device__ __forceinline__ int v_rd_base(int lane) { return ((lane & 3) << 3) | (((lane >> 2) & 3) << 6) | (((lane >> 4) & 1) << 5) | (((lane >> 5) & 1) << 8); }
constexpr int v_rd_off(int d0, int ks, int half) { return d0 * 512 + ks * 4096 + half * 2048; }
template <int OFF> __device__ __forceinline__ s16x4 tr_read(int vb) {
  s16x4 r; asm volatile("ds_read_b64_tr_b16 %0, %1 offset:%2" : "=&v"(r) : "v"(vb), "i"(OFF) : "memory"); return r;
}
template <int D0> __device__ __forceinline__ void pv_one(f32x16& od, int vb, bf16x8 pa0, bf16x8 pa1, bf16x8 pa2, bf16x8 pa3) {
  const s16x4 l0 = tr_read<v_rd_off(D0, 0, 0)>(vb), h0 = tr_read<v_rd_off(D0, 0, 1)>(vb), l1 = tr_read<v_rd_off(D0, 1, 0)>(vb), h1 = tr_read<v_rd_off(D0, 1, 1)>(vb);
  const s16x4 l2 = tr_read<v_rd_off(D0, 2, 0)>(vb), h2 = tr_read<v_rd_off(D0, 2, 1)>(vb), l3 = tr_read<v_rd_off(D0, 3, 0)>(vb), h3 = tr_read<v_rd_off(D0, 3, 1)>(vb);
  asm volatile("s_waitcnt lgkmcnt(0)" ::: "memory"); ATT_SBAR();
#define ATT_PK(L, H) (bf16x8){L[0], L[1], L[2], L[3], H[0], H[1], H[2], H[3]}
  od = __builtin_amdgcn_mfma_f32_32x32x16_bf16(pa0, ATT_PK(l0, h0), od, 0, 0, 0);
  od = __builtin_amdgcn_mfma_f32_32x32x16_bf16(pa1, ATT_PK(l1, h1), od, 0, 0, 0);
  od = __builtin_amdgcn_mfma_f32_32x32x16_bf16(pa2, ATT_PK(l2, h2), od, 0, 0, 0);
  od = __builtin_amdgcn_mfma_f32_32x32x16_bf16(pa3, ATT_PK(l3, h3), od, 0, 0, 0);
#undef ATT_PK
}
__device__ __forceinline__ void pv_d0(f32x16 (&o)[4], int vb, bf16x8 pa0, bf16x8 pa1, bf16x8 pa2, bf16x8 pa3) {
  pv_one<0>(o[0], vb, pa0, pa1, pa2, pa3); pv_one<1>(o[1], vb, pa0, pa1, pa2, pa3); pv_one<2>(o[2], vb, pa0, pa1, pa2, pa3); pv_one<3>(o[3], vb, pa0, pa1, pa2, pa3);
}
__device__ __forceinline__ unsigned short f2bf(float f) { unsigned u = __builtin_bit_cast(unsigned, f); return (unsigned short)((u + 0x7fffu + ((u >> 16) & 1u)) >> 16); }

__device__ __forceinline__ void attn_unit(const unsigned short* __restrict__ Qb, const unsigned short* __restrict__ Kh, const unsigned short* __restrict__ Vh,
                                          unsigned short* __restrict__ Ob, int seq, char* lds) {
  int tid_ = threadIdx.x; asm volatile("" : "+v"(tid_));
  const int tid = tid_, wid = tid >> 6, lane = tid & 63, r32 = lane & 31, hi = lane >> 5;
  char* V_lds = lds; char* K_lds = lds + 2 * SHM_V;
  float* wsf = (float*)(lds + 2 * SHM_V + 2 * SHM_K) + wid * 64; float* li_l = wsf; float* al_l = wsf + 32;
  float m_reg = -1e30f, l_reg = 0; f32x16 o[4] = {}; bf16x8 qr[4];
  const unsigned short* Qw = Qb + (long)(wid * QBLK + r32) * ATT_LDP + hi * 8;
#pragma unroll
  for (int d0 = 0; d0 < 4; ++d0) qr[d0] = *reinterpret_cast<const bf16x8*>(Qw + d0 * 16);
  const int sr = tid >> 4, sc = (tid & 15) * 8, vst0 = v_st(sr, sc), vst1 = v_st(32 + sr, sc);
  const int kr = tid >> 3, kc = (tid & 7) * 8, kst = ATT_KSWZ(kr, kc * 2);
  const int vb0 = (int)(uintptr_t)V_lds + v_rd_base(lane);
  bf16x8 s_vs0[2], s_vs1[2], s_ks[2];
#define ATT_SLOAD(i, k0) do { s_vs0[i] = *reinterpret_cast<const bf16x8*>(&Vh[(long)((k0) + sr) * ATT_LDP + sc]); s_vs1[i] = *reinterpret_cast<const bf16x8*>(&Vh[(long)((k0) + 32 + sr) * ATT_LDP + sc]); \
    s_ks[i] = *reinterpret_cast<const bf16x8*>(&Kh[(long)((k0) + kr) * ATT_LDP + kc]); } while (0)
#define ATT_SWRITE(b, i) do { *(bf16x8*)(V_lds + (b) * SHM_V + vst0) = s_vs0[i]; *(bf16x8*)(V_lds + (b) * SHM_V + vst1) = s_vs1[i]; \
    *(bf16x8*)(K_lds + (b) * SHM_K + kst) = s_ks[i]; } while (0)
#define ATT_SWAIT() asm volatile("s_waitcnt vmcnt(3)" ::: "memory")
#define ATT_RESC(a) do { if (__any((a) < 1.f)) { if (hi == 0) al_l[r32] = (a); asm volatile("s_waitcnt lgkmcnt(0)" ::: "memory"); \
    _Pragma("unroll") for (int d = 0; d < 4; ++d) _Pragma("unroll") for (int r = 0; r < 16; ++r) o[d][r] *= al_l[crow(r, hi)]; } } while (0)
  f32x16 pA0, pA1, pB0, pB1; float mnA, mnB, alA, alB; bf16x8 pa0, pa1, pa2, pa3; const int NT = seq / KVBLK;
  ATT_SLOAD(0, 0); asm volatile("s_waitcnt vmcnt(0)" ::: "memory"); ATT_SWRITE(0, 0); __syncthreads();
  qkt(pA0, pA1, K_lds, qr, r32, hi); partialSM(pA0, pA1, m_reg, mnA, alA);
  ATT_SLOAD(1, KVBLK); if (2 < NT) ATT_SLOAD(0, 2 * KVBLK);
  ATT_SWAIT(); ATT_SWRITE(1, 1); __syncthreads();
  for (int j = 1; j + 1 < NT; j += 2) {
    ATT_SBAR(); qkt(pB0, pB1, K_lds + SHM_K, qr, r32, hi);
    finishSM(pA0, pA1, alA, l_reg, pa0, pa1, pa2, pa3); ATT_SBAR();
    ATT_SLOAD(1, (j + 2) * KVBLK); ATT_SBAR();
    pv_d0(o, vb0, pa0, pa1, pa2, pa3); partialSM(pB0, pB1, m_reg, mnB, alB);
    __syncthreads(); ATT_SWAIT(); ATT_SWRITE(0, 0);
    ATT_RESC(alB); __syncthreads();
    ATT_SBAR(); qkt(pA0, pA1, K_lds, qr, r32, hi);
    finishSM(pB0, pB1, alB, l_reg, pa0, pa1, pa2, pa3); ATT_SBAR();
    if (j + 3 < NT) ATT_SLOAD(0, (j + 3) * KVBLK); ATT_SBAR();
    pv_d0(o, vb0 + SHM_V, pa0, pa1, pa2, pa3); partialSM(pA0, pA1, m_reg, mnA, alA);
    __syncthreads(); ATT_SWAIT(); ATT_SWRITE(1, 1);
    ATT_RESC(alA); __syncthreads();
  }
  ATT_SBAR(); qkt(pB0, pB1, K_lds + SHM_K, qr, r32, hi);
  finishSM(pA0, pA1, alA, l_reg, pa0, pa1, pa2, pa3); ATT_SBAR();
  pv_d0(o, vb0, pa0, pa1, pa2, pa3); partialSM(pB0, pB1, m_reg, mnB, alB);
  __syncthreads(); ATT_RESC(alB);
  finishSM(pB0, pB1, alB, l_reg, pa0, pa1, pa2, pa3); ATT_SBAR();
  pv_d0(o, vb0 + SHM_V, pa0, pa1, pa2, pa3);
  if (hi == 0) li_l[r32] = l_reg; asm volatile("s_waitcnt lgkmcnt(0)" ::: "memory");
  float rli[16];
#pragma unroll
  for (int r = 0; r < 16; ++r) rli[r] = __builtin_amdgcn_rcpf(li_l[crow(r, hi)]);
  unsigned short* Ow = Ob + (long)(wid * QBLK) * ATT_LDO;
#pragma unroll
  for (int r = 0; r < 16; ++r) { const int orow = crow(r, hi);
#pragma unroll
    for (int d0 = 0; d0 < 4; ++d0) Ow[(long)orow * ATT_LDO + d0 * 32 + r32] = f2bf(o[d0][r] * rli[r]); }
#undef ATT_SLOAD
#undef ATT_SWRITE
#undef ATT_SWAIT
#undef ATT_RESC
}
}

constexpr int NWAVES = 8;
constexpr int D = 2048, BATCH = 16, SEQ = 2048, DEPTH = 4, M = BATCH * SEQ;
constexpr int DFF = 5504, NGU = 2 * DFF, DIN = 8192;
constexpr int C_HGQ = 0, C_HGI = 1024, C_HGZF = 2048, C_HGZB = 3072, C_HGG = 4096, C_DAQ = 5120, C_DAK = 5632, C_DAV = 6144, C_SCB = 6656, C_SCC = 7168, C_SCU = 7680;
constexpr float EPS = 1e-6f;
enum { I_X = 0, I_POS, I_F1N, I_F1G, I_F1U, I_F1D, I_MIXN, I_WIN, I_LB, I_HGN, I_DAQN, I_DAKN, I_LQ1, I_LK1, I_LQ2, I_LK2, I_DAON, I_CW, I_CB, I_CN, I_WOUT, I_F2N, I_F2G, I_F2U, I_F2D, N_IN };

constexpr size_t MiB = 1u << 20;
constexpr size_t WS_CTL = 0, CTL_ZERO_BYTES = 1 * MiB;
constexpr size_t WS_SMALL = 1 * MiB;
constexpr size_t WS_ROPE = 2 * MiB;
constexpr size_t SZ_WGU = (size_t)NGU * D * 2, SZ_WD = (size_t)D * DFF * 2, SZ_WIN = (size_t)DIN * D * 2, SZ_WOUT = (size_t)D * D * 2;
constexpr size_t WS_WGU = 10 * MiB;
constexpr size_t WS_WD = WS_WGU + 8 * SZ_WGU;
constexpr size_t WS_WIN = WS_WD + 8 * SZ_WD;
constexpr size_t WS_WOUT = WS_WIN + 4 * SZ_WIN;
constexpr size_t WS_H = WS_WOUT + 4 * SZ_WOUT;
constexpr size_t WS_P = WS_H + (size_t)M * D * 2;
constexpr size_t WS_OF = WS_P + (size_t)M * DIN * 2;
constexpr size_t WS_OA = WS_OF + (size_t)2 * M * 1024 * 2;
constexpr size_t WS_END = WS_OA + (size_t)M * 1024 * 2;
static_assert(WS_WGU % 256 == 0 && WS_WD % 256 == 0 && WS_WIN % 256 == 0 && WS_H % 256 == 0 && WS_P % 256 == 0 && WS_OF % 256 == 0 && WS_OA % 256 == 0, "ws alignment");
constexpr int CW_BAR = 4096;

constexpr int RING_OFF = 0, RING_BYTES = 131072;
constexpr int LDSCTL_OFF = RING_BYTES, MISC_OFF = LDSCTL_OFF + 320;
constexpr int LDS_BYTES = 147456;
static_assert(MISC_OFF + 128 <= LDS_BYTES, "LDS map");

typedef unsigned v2u __attribute__((ext_vector_type(2)));
typedef float f32x2 __attribute__((ext_vector_type(2)));
__device__ __forceinline__ float wave_sum(float v) {
#pragma unroll
    for (int o = 1; o < 64; o <<= 1) v += __shfl_xor(v, o);
    return v;
}
__device__ __forceinline__ float bflo(unsigned w) { return __builtin_bit_cast(float, w << 16); }
__device__ __forceinline__ float bfhi(unsigned w) { return __builtin_bit_cast(float, w & 0xffff0000u); }
__device__ __forceinline__ void unpack8(const v4u w, float (&x)[8]) { x[0] = bflo(w.x); x[1] = bfhi(w.x); x[2] = bflo(w.y); x[3] = bfhi(w.y); x[4] = bflo(w.z); x[5] = bfhi(w.z); x[6] = bflo(w.w); x[7] = bfhi(w.w); }
__device__ __forceinline__ v4u pack8(const float (&x)[8]) { v4u w; w.x = pg8::cvt_pk_bf16(x[0], x[1]); w.y = pg8::cvt_pk_bf16(x[2], x[3]); w.z = pg8::cvt_pk_bf16(x[4], x[5]); w.w = pg8::cvt_pk_bf16(x[6], x[7]); return w; }

__constant__ double c_inv_freq[32] = {1.0, 0.7498942093324559, 0.5623413251903491, 0.4216965034285822, 0.31622776601683794, 0.23713737056616552, 0.1778279410038923, 0.1333521432163324, 0.1, 0.07498942093324558, 0.05623413251903491,
    0.042169650342858224, 0.03162277660168379, 0.023713737056616554, 0.01778279410038923, 0.01333521432163324, 0.01, 0.007498942093324558, 0.005623413251903491, 0.004216965034285823, 0.0031622776601683794, 0.0023713737056616554,
    0.0017782794100389228, 0.001333521432163324, 0.001, 0.0007498942093324559, 0.0005623413251903491, 0.00042169650342858224, 0.00031622776601683794, 0.00023713737056616554, 0.00017782794100389227, 0.0001333521432163324};
__constant__ float c_lam_init[4] = {0.20000000000000007f, 0.35550906759096934f, 0.4707130183435842f, 0.5560582041556406f};

__device__ __forceinline__ void p0_transpose_item(const float* W, int K, int N, bf16* WT, int gu, LAS float* scr, int item, int lane) {
    const int nblk = N / 32, kb = item / nblk, nb = item % nblk, k0 = 64 * kb, n0 = 32 * nb;
#pragma unroll
    for (int i = 0; i < 8; ++i) { const int kk = 8 * i + (lane >> 3), n4 = (lane & 7) * 4;
        const f32x4 v = *(const GAS f32x4*)(W + (size_t)(k0 + kk) * N + n0 + n4);
        LAS float* d = scr + kk * 33 + n4; d[0] = v.x; d[1] = v.y; d[2] = v.z; d[3] = v.w; }
    LDS_WAIT(); asm volatile("" ::: "memory");
    const int c = lane & 7;
#pragma unroll
    for (int j = 0; j < 4; ++j) { const int n = (lane >> 3) + 8 * j; const LAS float* s = scr + (8 * c) * 33 + n;
        v4u o; o.x = pg8::cvt_pk_bf16(s[0 * 33], s[1 * 33]); o.y = pg8::cvt_pk_bf16(s[2 * 33], s[3 * 33]); o.z = pg8::cvt_pk_bf16(s[4 * 33], s[5 * 33]); o.w = pg8::cvt_pk_bf16(s[6 * 33], s[7 * 33]);
        const int ns = n0 + n; const int dr = gu ? ((ns >> 7) * 256 + (gu - 1) * 128 + (ns & 127)) : ns;
        *(GAS v4u*)(WT + (size_t)dr * K + k0 + 8 * c) = o; }
    LDS_WAIT(); asm volatile("" ::: "memory");
}

__device__ __forceinline__ void norm_phase(const float* x, const float* gain, bf16* H, int gw, int NGW, int lane) {
    f32x4 g[8];
#pragma unroll
    for (int j = 0; j < 8; ++j) g[j] = ((const GAS f32x4*)gain)[lane + 64 * j];
    for (int m = gw; m < M; m += NGW) {
        const GAS f32x4* xr = (const GAS f32x4*)(x + (size_t)m * D) + lane;
        f32x4 v[8]; float s = 0.f;
#pragma unroll
        for (int j = 0; j < 8; ++j) { v[j] = xr[64 * j]; s += (v[j].x * v[j].x + v[j].y * v[j].y) + (v[j].z * v[j].z + v[j].w * v[j].w); }
        const float rstd = 1.0f / sqrtf(wave_sum(s) * (1.0f / D) + EPS);
        GAS v2u* o8 = (GAS v2u*)(H + (size_t)m * D) + lane;
#pragma unroll
        for (int j = 0; j < 8; ++j) { v2u w; w.x = pg8::cvt_pk_bf16(v[j].x * rstd * g[j].x, v[j].y * rstd * g[j].y); w.y = pg8::cvt_pk_bf16(v[j].z * rstd * g[j].z, v[j].w * rstd * g[j].w); o8[64 * j] = w; }
    }
}

__device__ __forceinline__ void prep_phase(bf16* P, bf16* Y, const float* cosT, const float* sinT, const float* qg, const float* kg, const float* cw, const float* cb, const float* cn, int gw, int NGW, int lane) {
    const int grp = lane >> 2, sub = lane & 3;
    float ga1[8], ga2[8];
    { const float* gp = (grp < 8 ? qg : kg);
#pragma unroll
      for (int e = 0; e < 8; ++e) { ga1[e] = gp[sub * 8 + e]; ga2[e] = gp[32 + sub * 8 + e]; } }
    const int c0 = lane * 8;
    float w0[8], w1[8], w2[8], bb[8], gn[8];
#pragma unroll
    for (int e = 0; e < 8; ++e) { w0[e] = cw[c0 + e]; w1[e] = cw[512 + c0 + e]; w2[e] = cw[1024 + c0 + e]; bb[e] = cb[c0 + e]; gn[e] = cn[c0 + e]; }
    for (int m = gw; m < M; m += NGW) {
        bf16* row = P + (size_t)m * DIN;
        {
            bf16* p1 = row + C_DAQ + grp * 64 + sub * 8; bf16* p2 = p1 + 32;
            const v4u a = *(const GAS v4u*)p1, b = *(const GAS v4u*)p2;
            float x1[8], x2[8]; unpack8(a, x1); unpack8(b, x2);
            float ss = 0.f;
#pragma unroll
            for (int e = 0; e < 8; ++e) ss += x1[e] * x1[e] + x2[e] * x2[e];
            ss += __shfl_xor(ss, 1); ss += __shfl_xor(ss, 2);
            const float rstd = 1.0f / sqrtf(ss * (1.0f / 64.0f) + EPS);
            const GAS f32x4* cp = (const GAS f32x4*)(cosT + (size_t)m * 32 + sub * 8); const GAS f32x4* sp = (const GAS f32x4*)(sinT + (size_t)m * 32 + sub * 8);
            const f32x4 cA = cp[0], cB = cp[1], sA = sp[0], sB = sp[1];
            const float cs[8] = {cA.x, cA.y, cA.z, cA.w, cB.x, cB.y, cB.z, cB.w}, sn[8] = {sA.x, sA.y, sA.z, sA.w, sB.x, sB.y, sB.z, sB.w};
            float o1[8], o2[8];
#pragma unroll
            for (int e = 0; e < 8; ++e) { const float y1 = x1[e] * rstd * ga1[e], y2 = x2[e] * rstd * ga2[e]; o1[e] = y1 * cs[e] - y2 * sn[e]; o2[e] = y2 * cs[e] + y1 * sn[e]; }
            *(GAS v4u*)p1 = pack8(o1); *(GAS v4u*)p2 = pack8(o2);
        }
        {
            const int s = m & (SEQ - 1);
            float vc[8], vp[8], vn[8], bg[8], t1[8], t2[8];
            unpack8(*(const GAS v4u*)(row + C_SCC + c0), t1); unpack8(*(const GAS v4u*)(row + C_SCU + c0), t2);
#pragma unroll
            for (int e = 0; e < 8; ++e) vc[e] = t1[e] * t2[e];
            if (s > 0) { unpack8(*(const GAS v4u*)(row - DIN + C_SCC + c0), t1); unpack8(*(const GAS v4u*)(row - DIN + C_SCU + c0), t2);
#pragma unroll
                for (int e = 0; e < 8; ++e) vp[e] = t1[e] * t2[e]; }
            else {
#pragma unroll
                for (int e = 0; e < 8; ++e) vp[e] = 0.f; }
            if (s < SEQ - 1) { unpack8(*(const GAS v4u*)(row + DIN + C_SCC + c0), t1); unpack8(*(const GAS v4u*)(row + DIN + C_SCU + c0), t2);
#pragma unroll
                for (int e = 0; e < 8; ++e) vn[e] = t1[e] * t2[e]; }
            else {
#pragma unroll
                for (int e = 0; e < 8; ++e) vn[e] = 0.f; }
            unpack8(*(const GAS v4u*)(row + C_SCB + c0), bg);
            float y[8]; float ss = 0.f;
#pragma unroll
            for (int e = 0; e < 8; ++e) { y[e] = (bb[e] + w0[e] * vp[e] + w1[e] * vc[e] + w2[e] * vn[e]) * bg[e]; ss += y[e] * y[e]; }
            ss += __shfl_xor(ss, 1); ss += __shfl_xor(ss, 2); ss += __shfl_xor(ss, 4); ss += __shfl_xor(ss, 8);
            const float rstd = 1.0f / sqrtf(ss * (1.0f / 128.0f) + EPS);
#pragma unroll
            for (int e = 0; e < 8; ++e) y[e] = y[e] * rstd * gn[e];
            *(GAS v4u*)(Y + (size_t)m * D + 1536 + c0) = pack8(y);
        }
    }
}

__device__ __forceinline__ void combine_phase(const bf16* P, const bf16* OF, const bf16* OA, bf16* Y, const float* hgn, const float* daon, const float* lq1, const float* lk1, const float* lq2, const float* lk2, float lam_init,
                                              int gw, int NGW, int lane) {
    const float d1 = wave_sum(lq1[lane] * lk1[lane]), d2 = wave_sum(lq2[lane] * lk2[lane]);
    const float lam = expf(d1) - expf(d2) + lam_init;
    const int ca = lane * 16, cbk = lane * 8;
    float ga[16], gb[8];
#pragma unroll
    for (int e = 0; e < 16; ++e) ga[e] = hgn[ca + e];
#pragma unroll
    for (int e = 0; e < 8; ++e) gb[e] = daon[cbk + e] * (1.0f - lam_init);
    for (int m = gw; m < M; m += NGW) {
        {
            const bf16* f0 = OF + (size_t)m * 1024 + ca; const bf16* f1 = OF + ((size_t)M + m) * 1024 + ca; const bf16* gp = P + (size_t)m * DIN + C_HGG + ca;
            float a[16], b[16], g[16];
            { float t[8]; unpack8(*(const GAS v4u*)f0, t);
#pragma unroll
              for (int e = 0; e < 8; ++e) a[e] = t[e];
              unpack8(*(const GAS v4u*)(f0 + 8), t);
#pragma unroll
              for (int e = 0; e < 8; ++e) a[8 + e] = t[e];
              unpack8(*(const GAS v4u*)f1, t);
#pragma unroll
              for (int e = 0; e < 8; ++e) b[e] = t[e];
              unpack8(*(const GAS v4u*)(f1 + 8), t);
#pragma unroll
              for (int e = 0; e < 8; ++e) b[8 + e] = t[e];
              unpack8(*(const GAS v4u*)gp, t);
#pragma unroll
              for (int e = 0; e < 8; ++e) g[e] = t[e];
              unpack8(*(const GAS v4u*)(gp + 8), t);
#pragma unroll
              for (int e = 0; e < 8; ++e) g[8 + e] = t[e]; }
            float ss = 0.f;
#pragma unroll
            for (int e = 0; e < 16; ++e) { a[e] += b[e]; ss += a[e] * a[e]; }
            ss += __shfl_xor(ss, 1); ss += __shfl_xor(ss, 2); ss += __shfl_xor(ss, 4);
            const float rstd = 1.0f / sqrtf(ss * (1.0f / 128.0f) + EPS);
            float o0[8], o1[8];
#pragma unroll
            for (int e = 0; e < 8; ++e) { const float g0 = g[e], g1 = g[8 + e];
                o0[e] = a[e] * rstd * ga[e] * (g0 / (1.0f + __expf(-g0))); o1[e] = a[8 + e] * rstd * ga[8 + e] * (g1 / (1.0f + __expf(-g1))); }
            GAS v4u* yp = (GAS v4u*)(Y + (size_t)m * D + ca); yp[0] = pack8(o0); yp[1] = pack8(o1);
        }
        {
            const int head = lane >> 4, v0 = (lane & 15) * 8;
            const bf16* ap = OA + (size_t)m * 1024 + head * 256 + v0;
            float a0[8], a1[8]; unpack8(*(const GAS v4u*)ap, a0); unpack8(*(const GAS v4u*)(ap + 128), a1);
            float ss = 0.f;
#pragma unroll
            for (int e = 0; e < 8; ++e) { a0[e] = a0[e] - lam * a1[e]; ss += a0[e] * a0[e]; }
            ss += __shfl_xor(ss, 1); ss += __shfl_xor(ss, 2); ss += __shfl_xor(ss, 4); ss += __shfl_xor(ss, 8);
            const float rstd = 1.0f / sqrtf(ss * (1.0f / 128.0f) + EPS);
#pragma unroll
            for (int e = 0; e < 8; ++e) a0[e] = a0[e] * rstd * gb[e];
            *(GAS v4u*)(Y + (size_t)m * D + 1024 + cbk) = pack8(a0);
        }
    }
}

__device__ __forceinline__ void scan_unit_v1(const bf16* P, const float* lbt, bf16* OFd, int b, int h, int dir, LAS unsigned char* ldsb, int tid) {
    LAS float* Fs = (LAS float*)ldsb; LAS float* Ks = Fs + 4096; LAS float* Qs = Ks + 4096; LAS float* Vs = Qs + 4096; LAS float* Os = Vs + 4096;
    const int lane = tid & 63, wv = tid >> 6, v = wv * 16 + (lane & 15), kq = lane >> 4;
    const int tok = tid >> 4, ch0 = (tid & 15) * 8;
    float lbv[8];
#pragma unroll
    for (int e = 0; e < 8; ++e) lbv[e] = lbt[h * 128 + ch0 + e];
    float S[32];
#pragma unroll
    for (int j = 0; j < 32; ++j) S[j] = 0.f;
    const int zc = (dir ? C_HGZB : C_HGZF) + h * 128 + ch0;
    for (int blk = 0; blk < SEQ / 32; ++blk) {
        const int tau = blk * 32 + tok, s = dir ? (SEQ - 1 - tau) : tau; const size_t m = (size_t)b * SEQ + s;
        const bf16* row = P + m * DIN;
        { float q[8], iv[8], z[8], f[8], kk[8];
          unpack8(*(const GAS v4u*)(row + C_HGQ + h * 128 + ch0), q); unpack8(*(const GAS v4u*)(row + C_HGI + h * 128 + ch0), iv); unpack8(*(const GAS v4u*)(row + zc), z);
#pragma unroll
          for (int e = 0; e < 8; ++e) { const float ex = __expf(-z[e]); const float sg = 1.0f / (1.0f + ex); const float om = 1.0f - lbv[e]; f[e] = lbv[e] + om * sg; kk[e] = om * (ex * sg); }
          LAS f32x4* d;
          d = (LAS f32x4*)(Fs + tok * 128 + ch0); d[0] = (f32x4){f[0], f[1], f[2], f[3]}; d[1] = (f32x4){f[4], f[5], f[6], f[7]};
          d = (LAS f32x4*)(Ks + tok * 128 + ch0); d[0] = (f32x4){kk[0], kk[1], kk[2], kk[3]}; d[1] = (f32x4){kk[4], kk[5], kk[6], kk[7]};
          d = (LAS f32x4*)(Qs + tok * 128 + ch0); d[0] = (f32x4){q[0], q[1], q[2], q[3]}; d[1] = (f32x4){q[4], q[5], q[6], q[7]};
          d = (LAS f32x4*)(Vs + tok * 128 + ch0); d[0] = (f32x4){iv[0], iv[1], iv[2], iv[3]}; d[1] = (f32x4){iv[4], iv[5], iv[6], iv[7]}; }
        __syncthreads();
#pragma unroll 1
        for (int t = 0; t < 32; ++t) {
            const float vv = Vs[t * 128 + v]; float acc = 0.f;
            const LAS f32x4* fp = (const LAS f32x4*)(Fs + t * 128 + kq * 32); const LAS f32x4* kp = (const LAS f32x4*)(Ks + t * 128 + kq * 32); const LAS f32x4* qp = (const LAS f32x4*)(Qs + t * 128 + kq * 32);
#pragma unroll
            for (int j4 = 0; j4 < 8; ++j4) { const f32x4 f4 = fp[j4], k4 = kp[j4], q4 = qp[j4];
                S[4 * j4 + 0] = f4.x * S[4 * j4 + 0] + k4.x * vv; acc += S[4 * j4 + 0] * q4.x;
                S[4 * j4 + 1] = f4.y * S[4 * j4 + 1] + k4.y * vv; acc += S[4 * j4 + 1] * q4.y;
                S[4 * j4 + 2] = f4.z * S[4 * j4 + 2] + k4.z * vv; acc += S[4 * j4 + 2] * q4.z;
                S[4 * j4 + 3] = f4.w * S[4 * j4 + 3] + k4.w * vv; acc += S[4 * j4 + 3] * q4.w; }
            acc += __shfl_xor(acc, 16); acc += __shfl_xor(acc, 32);
            if (kq == 0) Os[t * 128 + v] = acc;
        }
        __syncthreads();
        { const LAS f32x4* op = (const LAS f32x4*)(Os + tok * 128 + ch0); const f32x4 oA = op[0], oB = op[1];
          const float o8[8] = {oA.x, oA.y, oA.z, oA.w, oB.x, oB.y, oB.z, oB.w};
          *(GAS v4u*)(OFd + m * 1024 + h * 128 + ch0) = pack8(o8); }
    }
    __syncthreads();
}

#ifndef EN_P0
#define EN_P0 1
#endif
#ifndef EN_NORM
#define EN_NORM 1
#endif
#ifndef EN_GU
#define EN_GU 1
#endif
#ifndef EN_WIN
#define EN_WIN 1
#endif
#ifndef EN_PREP
#define EN_PREP 1
#endif
#ifndef EN_SCAN
#define EN_SCAN 1
#endif
#ifndef EN_ATTN
#define EN_ATTN 1
#endif
#ifndef EN_COMB
#define EN_COMB 1
#endif
#ifndef EN_RES
#define EN_RES 1
#endif
struct Args { const void* in[N_IN]; float* out; unsigned char* ws; int ph_lo, ph_hi; };
constexpr int PH_PER_LAYER = 13, NPH = 1 + DEPTH * PH_PER_LAYER;

__global__ void __launch_bounds__(NWAVES * 64, 2) fwd_kernel(Args args) {
    extern __shared__ __attribute__((aligned(16))) unsigned char lds[];
    LAS unsigned char* ldsb = (LAS unsigned char*)lds;
    volatile LAS unsigned* MISC = (volatile LAS unsigned*)(ldsb + MISC_OFF);
    const int tid0 = threadIdx.x;
    const int G = gridDim.x; const int bx = blockIdx.x; const int vcu = (G % 8 == 0) ? (bx % 8) * (G / 8) + bx / 8 : bx;
    const int NGW = G * NWAVES;
#define PHASE_IDS() int tid = threadIdx.x; asm volatile("" : "+v"(tid)); const int lane = tid & 63, wave = __builtin_amdgcn_readfirstlane(tid >> 6), gw = vcu * NWAVES + wave; (void)lane; (void)gw
    unsigned char* ws = args.ws;
    gu32* ctl = (gu32*)(ws + WS_CTL);
    for (int u = tid0; u < (LDS_BYTES - LDSCTL_OFF) / 4; u += NWAVES * 64) ((LAS unsigned*)(ldsb + LDSCTL_OFF))[u] = 0u;
    __syncthreads();
    const int lo = args.ph_lo, hi = args.ph_hi;
    const bool multi = (hi - lo) > 1;
    XcdBarrier bar; bar.bar = (unsigned*)(ctl + CW_BAR); bar.x = 0; bar.st = nullptr;
    if (multi) bar = xcd_barrier_post((unsigned*)(ctl + CW_BAR), MISC + 8);
#define RUN(k) (lo <= (k) && (k) < hi)
#define SEAM(k) do { if (RUN(k) && RUN((k) + 1)) xcd_barrier(bar); } while (0)

    float* out = args.out;
    bf16* H = (bf16*)(ws + WS_H); bf16* Y = H; bf16* P = (bf16*)(ws + WS_P); bf16* ACT = P; bf16* OF = (bf16*)(ws + WS_OF); bf16* OA = (bf16*)(ws + WS_OA);
    float* lbt = (float*)(ws + WS_SMALL); float* cosT = (float*)(ws + WS_ROPE); float* sinT = cosT + (size_t)M * 32;

    if (EN_P0 && RUN(0)) {
        PHASE_IDS();
        LAS float* scr = (LAS float*)(ldsb + RING_OFF + wave * 16384);
        constexpr int I_GU = (D / 64) * (DFF / 32), I_DN = (DFF / 64) * (D / 32), I_IN = (D / 64) * (DIN / 32), I_OUT = (D / 64) * (D / 32);
        constexpr int PER_LAYER = 2 * (2 * I_GU + I_DN) + I_IN + I_OUT, NITEMS = DEPTH * PER_LAYER;
        for (int it = gw; it < NITEMS; it += NGW) {
            const int L = it / PER_LAYER; int r = it % PER_LAYER;
            const size_t oGU = (size_t)L * D * DFF;
            if (r < I_GU) { p0_transpose_item((const float*)args.in[I_F1G] + oGU, D, DFF, (bf16*)(ws + WS_WGU + (size_t)(2 * L) * SZ_WGU), 1, scr, r, lane); continue; } r -= I_GU;
            if (r < I_GU) { p0_transpose_item((const float*)args.in[I_F1U] + oGU, D, DFF, (bf16*)(ws + WS_WGU + (size_t)(2 * L) * SZ_WGU), 2, scr, r, lane); continue; } r -= I_GU;
            if (r < I_DN) { p0_transpose_item((const float*)args.in[I_F1D] + oGU, DFF, D, (bf16*)(ws + WS_WD + (size_t)(2 * L) * SZ_WD), 0, scr, r, lane); continue; } r -= I_DN;
            if (r < I_GU) { p0_transpose_item((const float*)args.in[I_F2G] + oGU, D, DFF, (bf16*)(ws + WS_WGU + (size_t)(2 * L + 1) * SZ_WGU), 1, scr, r, lane); continue; } r -= I_GU;
            if (r < I_GU) { p0_transpose_item((const float*)args.in[I_F2U] + oGU, D, DFF, (bf16*)(ws + WS_WGU + (size_t)(2 * L + 1) * SZ_WGU), 2, scr, r, lane); continue; } r -= I_GU;
            if (r < I_DN) { p0_transpose_item((const float*)args.in[I_F2D] + oGU, DFF, D, (bf16*)(ws + WS_WD + (size_t)(2 * L + 1) * SZ_WD), 0, scr, r, lane); continue; } r -= I_DN;
            if (r < I_IN) { p0_transpose_item((const float*)args.in[I_WIN] + (size_t)L * D * DIN, D, DIN, (bf16*)(ws + WS_WIN + (size_t)L * SZ_WIN), 0, scr, r, lane); continue; } r -= I_IN;
            p0_transpose_item((const float*)args.in[I_WOUT] + (size_t)L * D * D, D, D, (bf16*)(ws + WS_WOUT + (size_t)L * SZ_WOUT), 0, scr, r, lane);
        }
        { const int* pos = (const int*)args.in[I_POS];
          for (int i = (vcu * NWAVES * 64 + tid); i < M * 32; i += G * NWAVES * 64) { const int m = i >> 5, j = i & 31;
              const double ang = (double)(float)((float)pos[m] * (float)c_inv_freq[j]);
              double rev = ang * 0.15915494309189533577; rev -= __builtin_rint(rev);
              const float rf = (float)rev; cosT[i] = __builtin_amdgcn_cosf(rf); sinT[i] = __builtin_amdgcn_sinf(rf); } }
        { const float* lg = (const float*)args.in[I_LB];
          for (int i = (vcu * NWAVES * 64 + tid); i < 2 * 1024; i += G * NWAVES * 64) { const int dir = i >> 10, c = i & 1023;
              float l[DEPTH], mx = -1e30f;
#pragma unroll
              for (int j = 0; j < DEPTH; ++j) { l[j] = lg[(dir * DEPTH + j) * 1024 + c]; mx = fmaxf(mx, l[j]); }
              float sum = 0.f;
#pragma unroll
              for (int j = 0; j < DEPTH; ++j) { l[j] = expf(l[j] - mx); sum += l[j]; }
              float cum = 0.f;
#pragma unroll
              for (int j = 0; j < DEPTH; ++j) { if (j > 0) cum += l[j] / sum; lbt[(dir * DEPTH + j) * 1024 + c] = cum; } } }
    }
    SEAM(0);

#pragma unroll 1
    for (int L = 0; L < DEPTH; ++L) {
#pragma unroll 1
        for (int st = 0; st < 3; ++st) {
            const int pb = 1 + PH_PER_LAYER * L + (st == 0 ? 0 : (st == 1 ? 3 : 10));
            const float* xsrc = (L == 0 && st == 0) ? (const float*)args.in[I_X] : (const float*)out;
            if (EN_NORM && RUN(pb)) {
                PHASE_IDS();
                const float* gain = (const float*)args.in[st == 0 ? I_F1N : (st == 1 ? I_MIXN : I_F2N)] + (size_t)L * D;
                norm_phase(xsrc, gain, H, gw, NGW, lane);
            }
            SEAM(pb);
            int plast;
            if (st != 1) {
                if (EN_GU && RUN(pb + 1)) {
                    const bf16* W = (const bf16*)(ws + WS_WGU + (size_t)(2 * L + (st == 2 ? 1 : 0)) * SZ_WGU);
                    pg8::Gemm g{H, W, M, NGU, D}; pg8::StaticOrder S; S.init(M, NGU, G, bx);
                    pg8::EpiSwiGLU E{ACT, DFF};
                    pg8::gemm_phase<pg8::EpiSwiGLU, pg8::StaticOrder, true, true>(ldsb + RING_OFF, g, S, E);
                }
                SEAM(pb + 1);
                plast = pb + 2;
            } else {
                if (EN_WIN && RUN(pb + 1)) {
                    const bf16* W = (const bf16*)(ws + WS_WIN + (size_t)L * SZ_WIN);
                    pg8::Gemm g{H, W, M, DIN, D}; pg8::StaticOrder S; S.init(M, DIN, G, bx);
                    pg8::EpiBf16 E{P, DIN};
                    pg8::gemm_phase<pg8::EpiBf16, pg8::StaticOrder, true, true>(ldsb + RING_OFF, g, S, E);
                }
                SEAM(pb + 1);
                if (EN_PREP && RUN(pb + 2)) {
                    PHASE_IDS();
                    prep_phase(P, Y, cosT, sinT, (const float*)args.in[I_DAQN] + L * 64, (const float*)args.in[I_DAKN] + L * 64, (const float*)args.in[I_CW] + L * 1536, (const float*)args.in[I_CB] + L * 512,
                               (const float*)args.in[I_CN] + L * 512, gw, NGW, lane);
                }
                SEAM(pb + 2);
                if (EN_SCAN && RUN(pb + 3)) {
                    PHASE_IDS();
                    for (int u = vcu; u < BATCH * 8 * 2; u += G) { const int b = u >> 4, h = (u >> 1) & 7, dir = u & 1;
                        scan_unit_v1(P, lbt + (size_t)(dir * DEPTH + L) * 1024, OF + (size_t)dir * M * 1024, b, h, dir, ldsb + RING_OFF, tid); }
                }
                SEAM(pb + 3);
                if (EN_ATTN && RUN(pb + 4)) {
                    for (int u = vcu; u < BATCH * 4 * 2 * (SEQ / 256); u += G) { const int qb = u & 7, cmb = u >> 3, map = cmb & 1, h = (cmb >> 1) & 3, b = cmb >> 3;
                        const bf16* Pb = P + (size_t)b * SEQ * DIN;
                        __syncthreads();
                        att::attn_unit(Pb + (size_t)(qb * 256) * DIN + C_DAQ + h * 128 + map * 64, Pb + C_DAK + h * 128 + map * 64, Pb + C_DAV + h * 128,
                                       OA + ((size_t)b * SEQ + qb * 256) * 1024 + h * 256 + map * 128, SEQ, (char*)lds + RING_OFF); }
                    __syncthreads();
                }
                SEAM(pb + 4);
                if (EN_COMB && RUN(pb + 5)) {
                    PHASE_IDS();
                    combine_phase(P, OF, OA, Y, (const float*)args.in[I_HGN] + L * 1024, (const float*)args.in[I_DAON] + L * 512, (const float*)args.in[I_LQ1] + L * 64, (const float*)args.in[I_LK1] + L * 64,
                                  (const float*)args.in[I_LQ2] + L * 64, (const float*)args.in[I_LK2] + L * 64, c_lam_init[L], gw, NGW, lane);
                }
                SEAM(pb + 5);
                plast = pb + 6;
            }
            if (EN_RES && RUN(plast)) {
                const bf16* A = (st == 1) ? Y : ACT; const int K = (st == 1) ? D : DFF;
                const bf16* W = (st == 1) ? (const bf16*)(ws + WS_WOUT + (size_t)L * SZ_WOUT) : (const bf16*)(ws + WS_WD + (size_t)(2 * L + (st == 2 ? 1 : 0)) * SZ_WD);
                pg8::Gemm g{A, W, M, D, K}; pg8::StaticOrder S; S.init(M, D, G, bx);
                pg8::EpiResAdd E{xsrc, out, D, (st == 1) ? 1.0f : 0.5f};
                pg8::gemm_phase<pg8::EpiResAdd, pg8::StaticOrder, true, true>(ldsb + RING_OFF, g, S, E);
            }
            if (plast + 1 < NPH) SEAM(plast);
        }
    }
#undef RUN
#undef SEAM
}

#ifndef MK_PER_PHASE
#define MK_PER_PHASE 1
#endif
extern "C" void kernel_launch(void* const* d_in, const int* in_sizes, int n_in, void* d_out, int out_size, void* d_ws, size_t ws_size, hipStream_t stream) {
    static int grid = 0;
    if (grid == 0) {
        if (n_in != N_IN || in_sizes[0] != M * D || out_size != M * D || ws_size < WS_END) {
            fprintf(stderr, "kernel_launch: shape/workspace mismatch: n_in %d in0 %d out %d ws %zu (need %zu); nothing launched\n", n_in, n_in > 0 ? in_sizes[0] : -1, out_size, ws_size, (size_t)WS_END); grid = -1; return; }
        int dev = 0, cus = 0, per_cu = 0;
        if (hipGetDevice(&dev) != hipSuccess || hipDeviceGetAttribute(&cus, hipDeviceAttributeMultiprocessorCount, dev) != hipSuccess) { fprintf(stderr, "kernel_launch: device query failed\n"); grid = -1; return; }
        if (hipFuncSetAttribute((const void*)fwd_kernel, hipFuncAttributeMaxDynamicSharedMemorySize, LDS_BYTES) != hipSuccess) { fprintf(stderr, "kernel_launch: hipFuncSetAttribute failed\n"); grid = -1; return; }
        if (hipOccupancyMaxActiveBlocksPerMultiprocessor(&per_cu, (const void*)fwd_kernel, NWAVES * 64, LDS_BYTES) != hipSuccess || per_cu < 1)
            fprintf(stderr, "kernel_launch: note: occupancy query reports %d workgroups per CU\n", per_cu);
        (void)hipGetLastError();
        grid = cus;
    }
    if (grid < 0) return;
    if (hipMemsetAsync((char*)d_ws + WS_CTL, 0, CTL_ZERO_BYTES, stream) != hipSuccess) { fprintf(stderr, "kernel_launch: memset failed\n"); return; }
    Args a{};
    for (int i = 0; i < N_IN; ++i) a.in[i] = d_in[i];
    a.out = (float*)d_out; a.ws = (unsigned char*)d_ws;
#if MK_PER_PHASE
    for (int p = 0; p < NPH; ++p) { a.ph_lo = p; a.ph_hi = p + 1;
        hipLaunchKernelGGL(fwd_kernel, dim3(grid), dim3(NWAVES * 64), LDS_BYTES, stream, a); }
#else
    a.ph_lo = 0; a.ph_hi = NPH;
    hipLaunchKernelGGL(fwd_kernel, dim3(grid), dim3(NWAVES * 64), LDS_BYTES, stream, a);
#endif
    const hipError_t le = hipPeekAtLastError();
    if (le != hipSuccess) fprintf(stderr, "kernel_launch: launch failed: %s\n", hipGetErrorName(le));
}
```

```cpp
#include <hip/hip_runtime.h>
#include <cstdio>
#include <cstdint>
namespace pg8 {
#define PG8_LAS __attribute__((address_space(3)))
typedef unsigned short bf16_t;
typedef short bf16x8 __attribute__((ext_vector_type(8)));
typedef float f32x4 __attribute__((ext_vector_type(4)));
typedef unsigned u32x4 __attribute__((ext_vector_type(4)));
constexpr int BM = 256, BK = 64, HALF = 128, HTB = HALF * BK * 2  , STAGE_BYTES = 8 * HTB, NXCD = 8, WGM = 8;

__host__ __device__ __forceinline__ int lds_byte(int r, int c) { const int st = (r >> 4) * 2 + (c >> 5), rr = r & 15, cc = c & 31, ob = rr * 64 + cc * 2; return st * 1024 + (ob ^ (((ob >> 9) & 1) << 5)); }
__host__ __device__ __forceinline__ void stage_rc(int b, int& R, int& C) { const int st = b / 1024, sb = b % 1024, swz = sb ^ (((sb >> 9) & 1) << 5); R = (st >> 1) * 16 + swz / 64; C = (st & 1) * 32 + (swz % 64) / 2; }
__host__ __device__ __forceinline__ int perm32(int rho) { const int n = rho >> 4, i = rho & 15; return 8 * (i >> 2) + 4 * n + (i & 3); }

struct Unit { int pm, pn; };
struct Gemm { const bf16_t* A; const bf16_t* Bt; int M, N, K; };

struct StaticOrder {
    int nM, nN, nwg, G, c;
    __host__ __device__ void init(int M, int N, int G_, int c_) { nM = M / BM; nN = N / BM; nwg = nM * nN; G = G_; c = c_; }
    __host__ __device__ bool next(int i, Unit& u) const {
        const long L = (long)i * G + c; if (L >= nwg) return false;
        int wgid = (int)L; { const int q = nwg / NXCD, r = nwg % NXCD, xcd = wgid % NXCD, off = wgid / NXCD; wgid = (xcd < r ? xcd * (q + 1) : r * (q + 1) + (xcd - r) * q) + off; }
        const int nig = WGM * nN, gid = wgid / nig, fm = gid * WGM, gsz = (nM - fm) < WGM ? (nM - fm) : WGM;
        u.pm = fm + ((wgid % nig) % gsz); u.pn = (wgid % nig) / gsz; return true;
    }
    __device__ __forceinline__ void a_ready(const Unit&) const {}
    __device__ __forceinline__ void done(const Unit&) const {}
};

__device__ __forceinline__ unsigned cvt_pk_bf16(float lo, float hi) { unsigned r; asm volatile("v_cvt_pk_bf16_f32 %0, %1, %2" : "=v"(r) : "v"(lo), "v"(hi)); return r; }

struct EpiBf16 {
    static constexpr bool PERM = true, AFTER_DRAIN = false;
    bf16_t* O; int ldc;
    __device__ __forceinline__ void operator()(const f32x4 (&acc)[2][2][4][2], const Unit& u, int wr, int wc, int fr, int fq) const {
        const int row0 = u.pm * BM + wr * 64 + fr, col0 = u.pn * BM + wc * 32 + 8 * fq;
#pragma unroll
        for (int ai = 0; ai < 2; ++ai)
#pragma unroll
            for (int m = 0; m < 4; ++m) { bf16_t* rowp = O + (size_t)(row0 + ai * HALF + m * 16) * ldc + col0;
#pragma unroll
                for (int bj = 0; bj < 2; ++bj) { const f32x4 v0 = acc[ai][bj][m][0], v1 = acc[ai][bj][m][1];
                    u32x4 w; w.x = cvt_pk_bf16(v0[0], v0[1]); w.y = cvt_pk_bf16(v0[2], v0[3]); w.z = cvt_pk_bf16(v1[0], v1[1]); w.w = cvt_pk_bf16(v1[2], v1[3]);
                    *(u32x4*)(rowp + bj * HALF) = w; } }
    }
};
struct EpiSwiGLU {
    static constexpr bool PERM = true, AFTER_DRAIN = false;
    bf16_t* O; int ldc;
    __device__ __forceinline__ float sg(float g, float u) const { const float e = __builtin_amdgcn_exp2f(g * -1.44269504088896341f); return g * __builtin_amdgcn_rcpf(1.0f + e) * u; }
    __device__ __forceinline__ void operator()(const f32x4 (&acc)[2][2][4][2], const Unit& u, int wr, int wc, int fr, int fq) const {
        const int row0 = u.pm * BM + wr * 64 + fr, col0 = u.pn * HALF + wc * 32 + 8 * fq;
#pragma unroll
        for (int ai = 0; ai < 2; ++ai)
#pragma unroll
            for (int m = 0; m < 4; ++m) { bf16_t* rowp = O + (size_t)(row0 + ai * HALF + m * 16) * ldc + col0;
                const f32x4 g0 = acc[ai][0][m][0], g1 = acc[ai][0][m][1], u0 = acc[ai][1][m][0], u1 = acc[ai][1][m][1];
                u32x4 w; w.x = cvt_pk_bf16(sg(g0[0], u0[0]), sg(g0[1], u0[1])); w.y = cvt_pk_bf16(sg(g0[2], u0[2]), sg(g0[3], u0[3]));
                w.z = cvt_pk_bf16(sg(g1[0], u1[0]), sg(g1[1], u1[1])); w.w = cvt_pk_bf16(sg(g1[2], u1[2]), sg(g1[3], u1[3]));
                *(u32x4*)rowp = w; }
    }
};
struct EpiResAdd {
    static constexpr bool PERM = false, AFTER_DRAIN = false;
    const float* base; float* out; int ldc; float scale;
    __device__ __forceinline__ void operator()(const f32x4 (&acc)[2][2][4][2], const Unit& u, int wr, int wc, int fr, int fq) const {
        const int row0 = u.pm * BM + wr * 64 + fr, col0 = u.pn * BM + wc * 32 + 4 * fq;
#pragma unroll
        for (int ai = 0; ai < 2; ++ai)
#pragma unroll
            for (int m = 0; m < 4; ++m) { const size_t off = (size_t)(row0 + ai * HALF + m * 16) * ldc + col0;
#pragma unroll
                for (int bj = 0; bj < 2; ++bj)
#pragma unroll
                    for (int n = 0; n < 2; ++n) { const f32x4 b = *(const f32x4*)(base + off + bj * HALF + n * 16); *(f32x4*)(out + off + bj * HALF + n * 16) = b + acc[ai][bj][m][n] * scale; }
                asm volatile("" ::: "memory"); }
    }
};

template <class Epi, class Sched, bool ALIGN_EPI = false, bool SP2 = false>
__device__ __forceinline__ void gemm_phase(PG8_LAS unsigned char* lds, const Gemm g, const Sched& S, const Epi& E) {
    int tid_ = threadIdx.x; asm volatile("" : "+v"(tid_));
    const int tid = tid_, wid = __builtin_amdgcn_readfirstlane(tid >> 6), lane = tid & 63, wr = wid >> 2, wc = wid & 3, fr = lane & 15, fq = lane >> 4;
    const int K = g.K, nt = K / BK;
    unsigned voffA[2], voffB[2];
#pragma unroll
    for (int i = 0; i < 2; ++i) { int R, C; stage_rc(tid * 16 + i * 8192, R, C); const int Rb = Epi::PERM ? ((R & ~31) + perm32(R & 31)) : R;
        voffA[i] = (unsigned)(R * K + C) * 2u; voffB[i] = (unsigned)(Rb * K + C) * 2u; }
    const size_t kstep = (size_t)(BK * 2);
    const size_t hstep = (size_t)HALF * K * 2;
    const size_t tstep = 2 * hstep;
    const unsigned ldsw = (unsigned)wid * 1024u;
    const int aoff = lds_byte(wr * 64 + fr, fq * 8), boff = lds_byte(wc * 32 + fr, fq * 8);
#define PG8_SA(b, h) (((b) * 2 + (h)) * HTB)
#define PG8_SB(b, h) ((4 + (b) * 2 + (h)) * HTB)
#define PG8_STAGE(bufoff, gbase, voff) do { _Pragma("unroll") for (int _i = 0; _i < 2; ++_i) \
        __builtin_amdgcn_global_load_lds((const unsigned*)((const char*)(gbase) + (voff)[_i]), (PG8_LAS unsigned*)(lds + (bufoff) + ldsw + _i * 8192), 16, 0, 0); } while (0)
#define PG8_LDA(dst, b, h) do { _Pragma("unroll") for (int m = 0; m < 4; ++m) _Pragma("unroll") for (int k = 0; k < 2; ++k) dst[m][k] = *(const PG8_LAS bf16x8*)(lds + PG8_SA(b, h) + aoff + m * 2048 + k * 1024); } while (0)
#define PG8_LDB(dst, b, h) do { _Pragma("unroll") for (int n = 0; n < 2; ++n) _Pragma("unroll") for (int k = 0; k < 2; ++k) dst[n][k] = *(const PG8_LAS bf16x8*)(lds + PG8_SB(b, h) + boff + n * 2048 + k * 1024); } while (0)
#define PG8_MMA(ai, bj, At, Bt) do { __builtin_amdgcn_s_setprio(1); _Pragma("unroll") for (int m = 0; m < 4; ++m) _Pragma("unroll") for (int n = 0; n < 2; ++n) _Pragma("unroll") for (int k = 0; k < 2; ++k) \
        acc[ai][bj][m][n] = __builtin_amdgcn_mfma_f32_16x16x32_bf16(Bt[n][k], At[m][k], acc[ai][bj][m][n], 0, 0, 0); __builtin_amdgcn_s_setprio(0); } while (0)
#define PG8_WAIT_V(n) asm volatile("s_waitcnt vmcnt(" #n ")" ::: "memory")
#define PG8_WAIT_L(n) asm volatile("s_waitcnt lgkmcnt(" #n ")" ::: "memory")
#define PG8_BAR __builtin_amdgcn_s_barrier()
#define PG8_SCHED __builtin_amdgcn_sched_barrier(0)
    Unit cur, nxt; int ui = 0;
    if (!S.next(0, cur)) return;
    f32x4 acc[2][2][4][2];
#pragma unroll
    for (int a = 0; a < 2; ++a)
#pragma unroll
        for (int b = 0; b < 2; ++b)
#pragma unroll
            for (int m = 0; m < 4; ++m)
#pragma unroll
                for (int n = 0; n < 2; ++n) acc[a][b][m][n] = (f32x4){0.f, 0.f, 0.f, 0.f};
    bf16x8 At[4][2], B0[2][2], B1[2][2];
    const char* cA = (const char*)g.A + (size_t)cur.pm * tstep; const char* cB = (const char*)g.Bt + (size_t)cur.pn * tstep;
    S.a_ready(cur);
    if constexpr (SP2) {
        PG8_STAGE(PG8_SB(0, 0), cB, voffB); PG8_STAGE(PG8_SB(0, 1), cB + hstep, voffB); PG8_STAGE(PG8_SA(0, 0), cA, voffA); PG8_STAGE(PG8_SA(0, 1), cA + hstep, voffA);
        if (wr == 1) PG8_BAR;
        PG8_WAIT_V(2); PG8_BAR;
        PG8_STAGE(PG8_SB(1, 0), cB + kstep, voffB); PG8_STAGE(PG8_SA(1, 0), cA + kstep, voffA); PG8_STAGE(PG8_SB(1, 1), cB + hstep + kstep, voffB);
        PG8_WAIT_V(6); PG8_BAR;
    } else {
        PG8_STAGE(PG8_SB(0, 0), cB, voffB); PG8_STAGE(PG8_SA(0, 0), cA, voffA); PG8_STAGE(PG8_SB(0, 1), cB + hstep, voffB); PG8_STAGE(PG8_SA(0, 1), cA + hstep, voffA);
        if (wr == 1) PG8_BAR;
        PG8_WAIT_V(4); PG8_BAR;
        PG8_STAGE(PG8_SB(1, 0), cB + kstep, voffB); PG8_STAGE(PG8_SA(1, 0), cA + kstep, voffA); PG8_STAGE(PG8_SB(1, 1), cB + hstep + kstep, voffB);
        PG8_WAIT_V(6); PG8_BAR;
    }
    for (;;) {
        const bool has_next = S.next(ui + 1, nxt);
        const char* nA = has_next ? (const char*)g.A + (size_t)nxt.pm * tstep : cA; const char* nB = has_next ? (const char*)g.Bt + (size_t)nxt.pn * tstep : cB;
        for (int t = 0; t < nt; t += 2) {
            const bool last = (t == nt - 2);
            const char* a1 = cA + (size_t)(t + 1) * kstep;
            const char* a2 = last ? nA : cA + (size_t)(t + 2) * kstep; const char* b2 = last ? nB : cB + (size_t)(t + 2) * kstep;
            const char* a3 = a2 + kstep; const char* b3 = b2 + kstep;
            if (last && has_next) S.a_ready(nxt);
            if constexpr (SP2) {
            PG8_LDB(B0, 0, 0); PG8_LDB(B1, 0, 1); PG8_SCHED; PG8_LDA(At, 0, 0); PG8_STAGE(PG8_SA(1, 1), a1 + hstep, voffA);
            PG8_WAIT_V(8); PG8_WAIT_L(0); PG8_BAR; PG8_MMA(0, 0, At, B0); PG8_MMA(0, 1, At, B1); PG8_BAR; PG8_SCHED;
            PG8_LDA(At, 0, 1); PG8_STAGE(PG8_SB(0, 0), b2, voffB); PG8_STAGE(PG8_SB(0, 1), b2 + hstep, voffB); PG8_STAGE(PG8_SA(0, 0), a2, voffA);
            PG8_WAIT_V(8); PG8_WAIT_L(0); PG8_BAR; PG8_MMA(1, 0, At, B0); PG8_MMA(1, 1, At, B1); PG8_BAR; PG8_SCHED;
            PG8_LDB(B0, 1, 0); PG8_LDB(B1, 1, 1); PG8_SCHED; PG8_LDA(At, 1, 0); PG8_STAGE(PG8_SA(0, 1), a2 + hstep, voffA);
            PG8_WAIT_V(8); PG8_WAIT_L(0); PG8_BAR; PG8_MMA(0, 0, At, B0); PG8_MMA(0, 1, At, B1); PG8_BAR; PG8_SCHED;
            PG8_LDA(At, 1, 1); PG8_STAGE(PG8_SB(1, 0), b3, voffB); PG8_STAGE(PG8_SB(1, 1), b3 + hstep, voffB); PG8_STAGE(PG8_SA(1, 0), a3, voffA);
            PG8_WAIT_V(8); PG8_WAIT_L(0); PG8_BAR; PG8_MMA(1, 0, At, B0); PG8_MMA(1, 1, At, B1); PG8_BAR; PG8_SCHED;
            } else {
            PG8_LDB(B0, 0, 0); PG8_SCHED; PG8_LDA(At, 0, 0); PG8_STAGE(PG8_SA(1, 1), a1 + hstep, voffA);
            PG8_WAIT_L(8); PG8_BAR; PG8_WAIT_L(0); PG8_MMA(0, 0, At, B0); PG8_BAR; PG8_SCHED;
            PG8_LDB(B1, 0, 1); PG8_STAGE(PG8_SB(0, 0), b2, voffB);
            PG8_BAR; PG8_WAIT_L(0); PG8_MMA(0, 1, At, B1); PG8_BAR;
            PG8_LDA(At, 0, 1); PG8_STAGE(PG8_SA(0, 0), a2, voffA);
            PG8_BAR; PG8_WAIT_L(0); PG8_MMA(1, 0, At, B0); PG8_BAR; PG8_SCHED;
            PG8_STAGE(PG8_SB(0, 1), b2 + hstep, voffB);
            PG8_WAIT_V(6); PG8_BAR; PG8_MMA(1, 1, At, B1); PG8_BAR;
            PG8_LDB(B0, 1, 0); PG8_SCHED; PG8_LDA(At, 1, 0); PG8_STAGE(PG8_SA(0, 1), a2 + hstep, voffA);
            PG8_WAIT_L(8); PG8_BAR; PG8_WAIT_L(0); PG8_MMA(0, 0, At, B0); PG8_BAR; PG8_SCHED;
            PG8_LDB(B1, 1, 1); PG8_STAGE(PG8_SB(1, 0), b3, voffB);
            PG8_BAR; PG8_WAIT_L(0); PG8_MMA(0, 1, At, B1); PG8_BAR;
            PG8_LDA(At, 1, 1); PG8_STAGE(PG8_SA(1, 0), a3, voffA);
            PG8_BAR; PG8_WAIT_L(0); PG8_MMA(1, 0, At, B0); PG8_BAR; PG8_SCHED;
            PG8_STAGE(PG8_SB(1, 1), b3 + hstep, voffB);
            PG8_WAIT_V(6); PG8_BAR; PG8_MMA(1, 1, At, B1); PG8_BAR;
            }
        }
        if constexpr (ALIGN_EPI) { if (wr == 0) PG8_BAR; }
        if constexpr (!Epi::AFTER_DRAIN) { E(acc, cur, wr, wc, fr, fq); S.done(cur); }
        if (!has_next) break;
#pragma unroll
        for (int a = 0; a < 2; ++a)
#pragma unroll
            for (int b = 0; b < 2; ++b)
#pragma unroll
                for (int m = 0; m < 4; ++m)
#pragma unroll
                    for (int n = 0; n < 2; ++n) acc[a][b][m][n] = (f32x4){0.f, 0.f, 0.f, 0.f};
        cur = nxt; cA = nA; cB = nB; ++ui;
        if constexpr (ALIGN_EPI) { if (wr == 1) PG8_BAR; }
    }
    PG8_WAIT_V(0);
    if constexpr (!ALIGN_EPI) { if (wr == 0) PG8_BAR; }
    PG8_BAR;
    if constexpr (Epi::AFTER_DRAIN) { E.fused(acc, cur, wr, wc, fr, fq, lds, wid, lane); S.done(cur); }
#undef PG8_SA
#undef PG8_SB
#undef PG8_STAGE
#undef PG8_LDA
#undef PG8_LDB
#undef PG8_MMA
#undef PG8_WAIT_V
#undef PG8_WAIT_L
#undef PG8_BAR
#undef PG8_SCHED
}
}

#define GAS __attribute__((address_space(1)))
#define LAS __attribute__((address_space(3)))
typedef unsigned short bf16;
typedef unsigned v4u __attribute__((ext_vector_type(4)));
typedef float f32x4 __attribute__((ext_vector_type(4)));
typedef GAS unsigned gu32;
#define LDS_WAIT() asm volatile("s_waitcnt lgkmcnt(0)" ::: "memory")
#define VM_WAIT() asm volatile("s_waitcnt vmcnt(0)" ::: "memory")

#define XB_TMO      128
#define XB_XCNT(j)  (256  + 64 * (j))
#define XB_XSUB(j)  (1280 + 64 * (j))
#define XB_XGEN(j)  (2304 + 64 * (j))
#define XB_TOP      3328
#define XB_TOPGEN   3392
#define XCD_BAR_WORDS 3456
#define XB_SPIN_CAP (1u << 18)

__device__ __forceinline__ unsigned xb_ld(unsigned* p)              { return __hip_atomic_load(p, __ATOMIC_RELAXED, __HIP_MEMORY_SCOPE_AGENT); }
__device__ __forceinline__ unsigned xb_add(unsigned* p, unsigned v) { return __hip_atomic_fetch_add(p, v, __ATOMIC_RELAXED, __HIP_MEMORY_SCOPE_AGENT); }
__device__ __forceinline__ unsigned xb_xcc_id() { return (unsigned)__builtin_amdgcn_s_getreg((3 << 11) | 20) & 0xFu; }
#define XB_SPIN(cond, bar) do { unsigned _sp = 0; while (cond) { __builtin_amdgcn_s_sleep(1); \
    if ((++_sp & 255u) == 0u) { if (xb_ld(&(bar)[XB_TMO])) break; if (_sp > XB_SPIN_CAP) { atomicAdd(&(bar)[XB_TMO], 1u); break; } } } } while (0)

struct XcdBarrier {
    unsigned* bar; unsigned x;
    volatile LAS unsigned* st;
};

__device__ __forceinline__ XcdBarrier xcd_barrier_post(unsigned* bar, volatile LAS unsigned* st) {
    XcdBarrier b; b.bar = bar; b.x = xb_xcc_id(); b.st = st;
    if (threadIdx.x == 0) (void)xb_add(&bar[XB_XCNT(b.x)], 1u);
    return b;
}
__device__ __forceinline__ void xcd_barrier_complete(unsigned* bar, unsigned x, unsigned& nloc, unsigned& nx) {
    const unsigned G = gridDim.x * gridDim.y * gridDim.z;
    unsigned sum, cnt, mine, sp = 0u;
    for (;;) {
        sum = 0u; cnt = 0u; mine = 0u;
#pragma unroll
        for (unsigned j = 0; j < 16; ++j) { const unsigned c = xb_ld(&bar[XB_XCNT(j)]); sum += c; cnt += (c > 0u) ? 1u : 0u; mine = (j == x) ? c : mine; }
        if (sum == G) break;
        __builtin_amdgcn_s_sleep(1);
        if ((++sp & 255u) == 0u) { if (xb_ld(&bar[XB_TMO])) break; if (sp > XB_SPIN_CAP) { atomicAdd(&bar[XB_TMO], 1u); break; } }
    }
    nloc = mine > 0u ? mine : 1u; nx = cnt > 0u ? cnt : 1u;
}

__device__ __forceinline__ void xcd_barrier(const XcdBarrier& b) {
    asm volatile("s_waitcnt vmcnt(0)" ::: "memory");
    __syncthreads();
    if (threadIdx.x == 0) {
        unsigned* bar = b.bar;
        __builtin_amdgcn_s_waitcnt(0);
        unsigned nloc = b.st[0], nx = b.st[1];
        if (nloc == 0u) { xcd_barrier_complete(bar, b.x, nloc, nx); b.st[0] = nloc; b.st[1] = nx; }
        const unsigned old = xb_add(&bar[XB_XSUB(b.x)], 1u);
        const unsigned gen = old / nloc;
        if (old + 1u == (gen + 1u) * nloc) {
            __builtin_amdgcn_fence(__ATOMIC_RELEASE, "agent");
            asm volatile("s_waitcnt vmcnt(0)" ::: "memory");
            const unsigned og = xb_add(&bar[XB_TOP], 1u);
            const unsigned tg = og / nx;
            if (og + 1u == (tg + 1u) * nx) xb_add(&bar[XB_TOPGEN], 1u);
            else XB_SPIN(xb_ld(&bar[XB_TOPGEN]) == tg, bar);
            __builtin_amdgcn_fence(__ATOMIC_ACQUIRE, "agent");
            xb_add(&bar[XB_XGEN(b.x)], 1u);
            asm volatile("s_waitcnt vmcnt(0)" ::: "memory");
        } else {
            XB_SPIN(xb_ld(&bar[XB_XGEN(b.x)]) == gen, bar);
            __builtin_amdgcn_fence(__ATOMIC_ACQUIRE, "agent");
            asm volatile("s_waitcnt vmcnt(0)" ::: "memory");
        }
    }
    __syncthreads();
}

namespace att {
using bf16x8 = __attribute__((ext_vector_type(8))) short;
using s16x4  = __attribute__((ext_vector_type(4))) short;
using f32x16 = __attribute__((ext_vector_type(16))) float;
using u32x4  = __attribute__((ext_vector_type(4))) unsigned;
constexpr int QBLK = 32, KVBLK = 64, NW = 8, DV = 128, DQK = 64;
constexpr float SCALE = 0.125f, THR = 8.f;
constexpr int ATT_LDP = 8192, ATT_LDO = 1024;
constexpr int SHM_V = KVBLK * DV * 2, SHM_K = KVBLK * DQK * 2, SHM_ATTN = 2 * SHM_V + 2 * SHM_K + NW * 64 * 4;
#define ATT_KSWZ(row, colB) ((row) * 128 + ((colB) ^ ((((row) >> 1) & 7) << 4)))
#define ATT_SBAR() __builtin_amdgcn_sched_barrier(0)
__device__ __forceinline__ int crow(int r, int hi) { return (r & 3) + 8 * (r >> 2) + 4 * hi; }
__device__ __forceinline__ unsigned cvtpk(float lo, float hi) { unsigned r; asm volatile("v_cvt_pk_bf16_f32 %0, %1, %2" : "=v"(r) : "v"(lo), "v"(hi)); return r; }

__device__ __forceinline__ void partialSM(f32x16& p0, f32x16& p1, float& m_reg, float& mn, float& alpha) {
  constexpr float C = SCALE * 1.4426950408889634f;
  float pmax = p0[0];
#pragma unroll
  for (int r = 1; r < 16; ++r) pmax = fmaxf(pmax, p0[r]);
#pragma unroll
  for (int r = 0; r < 16; ++r) pmax = fmaxf(pmax, p1[r]);
  { auto rr = __builtin_amdgcn_permlane32_swap(__float_as_uint(pmax), __float_as_uint(pmax), false, false);
    pmax = fmaxf(__uint_as_float(rr[0]), __uint_as_float(rr[1])); }
  if (__builtin_expect(__all(pmax - m_reg <= THR / SCALE), 1)) { mn = m_reg; alpha = 1.f; }
  else { mn = fmaxf(m_reg, pmax); alpha = __builtin_amdgcn_exp2f((m_reg - mn) * C); m_reg = mn; }
  float mnC = -mn * C;
#pragma unroll
  for (int r = 0; r < 16; ++r) p0[r] = fmaf(p0[r], C, mnC);
#pragma unroll
  for (int r = 0; r < 16; ++r) p1[r] = fmaf(p1[r], C, mnC);
#pragma unroll
  for (int r = 0; r < 16; ++r) p0[r] = __builtin_amdgcn_exp2f(p0[r]);
}
__device__ __forceinline__ void finishSM(f32x16& p0, f32x16& p1, float alpha, float& l_reg, bf16x8& pa0, bf16x8& pa1, bf16x8& pa2, bf16x8& pa3) {
#pragma unroll
  for (int r = 0; r < 16; ++r) p1[r] = __builtin_amdgcn_exp2f(p1[r]);
  float ps = 0;
#pragma unroll
  for (int r = 0; r < 16; ++r) ps += p0[r];
#pragma unroll
  for (int r = 0; r < 16; ++r) ps += p1[r];
  { auto rr = __builtin_amdgcn_permlane32_swap(__float_as_uint(ps), __float_as_uint(ps), false, false);
    ps = __uint_as_float(rr[0]) + __uint_as_float(rr[1]); }
  l_reg = l_reg * alpha + ps;
#define ATT_PK4(P, BASE, OUT) do { unsigned a0 = cvtpk(P[BASE + 0], P[BASE + 1]), a1 = cvtpk(P[BASE + 2], P[BASE + 3]);   \
    unsigned b0 = cvtpk(P[BASE + 4], P[BASE + 5]), b1 = cvtpk(P[BASE + 6], P[BASE + 7]);                              \
    auto r0 = __builtin_amdgcn_permlane32_swap(a0, b0, false, false); auto r1 = __builtin_amdgcn_permlane32_swap(a1, b1, false, false); \
    u32x4 w = {r0[0], r1[0], r0[1], r1[1]}; OUT = *reinterpret_cast<bf16x8*>(&w); } while (0)
  ATT_PK4(p0, 0, pa0); ATT_PK4(p0, 8, pa1); ATT_PK4(p1, 0, pa2); ATT_PK4(p1, 8, pa3);
#undef ATT_PK4
}
__device__ __forceinline__ void qkt(f32x16& p0, f32x16& p1, const char* Ks, const bf16x8 (&qr)[4], int r32, int hi) {
  p0 = f32x16{}; p1 = f32x16{};
#pragma unroll
  for (int d0 = 0; d0 < 4; ++d0) { const int cb = (d0 * 16 + hi * 8) * 2;
    bf16x8 b0 = *reinterpret_cast<const bf16x8*>(Ks + ATT_KSWZ(r32, cb));
    bf16x8 b1 = *reinterpret_cast<const bf16x8*>(Ks + ATT_KSWZ(32 + r32, cb));
    p0 = __builtin_amdgcn_mfma_f32_32x32x16_bf16(b0, qr[d0], p0, 0, 0, 0);
    p1 = __builtin_amdgcn_mfma_f32_32x32x16_bf16(b1, qr[d0], p1, 0, 0, 0); }
}
__device__ __forceinline__ int v_st(int k, int c) { const int kk = (k & ~0xC) | ((k & 4) << 1) | ((k & 8) >> 1); return ((kk >> 3) * 4 + (c >> 5)) * 512 + ((kk & 7) * 32 + (c & 31)) * 2; }
__device__ __forceinline__ int v_rd_base(int lane) { return ((lane & 3) << 3) | (((lane >> 2) & 3) << 6) | (((lane >> 4) & 1) << 5) | (((lane >> 5) & 1) << 8); }
constexpr int v_rd_off(int d0, int ks, int half) { return d0 * 512 + ks * 4096 + half * 2048; }
template <int OFF> __device__ __forceinline__ s16x4 tr_read(int vb) {
  s16x4 r; asm volatile("ds_read_b64_tr_b16 %0, %1 offset:%2" : "=&v"(r) : "v"(vb), "i"(OFF) : "memory"); return r;
}
template <int D0> __device__ __forceinline__ void pv_one(f32x16& od, int vb, bf16x8 pa0, bf16x8 pa1, bf16x8 pa2, bf16x8 pa3) {
  const s16x4 l0 = tr_read<v_rd_off(D0, 0, 0)>(vb), h0 = tr_read<v_rd_off(D0, 0, 1)>(vb), l1 = tr_read<v_rd_off(D0, 1, 0)>(vb), h1 = tr_read<v_rd_off(D0, 1, 1)>(vb);
  const s16x4 l2 = tr_read<v_rd_off(D0, 2, 0)>(vb), h2 = tr_read<v_rd_off(D0, 2, 1)>(vb), l3 = tr_read<v_rd_off(D0, 3, 0)>(vb), h3 = tr_read<v_rd_off(D0, 3, 1)>(vb);
  asm volatile("s_waitcnt lgkmcnt(0)" ::: "memory"); ATT_SBAR();
#define ATT_PK(L, H) (bf16x8){L[0], L[1], L[2], L[3], H[0], H[1], H[2], H[3]}
  od = __builtin_amdgcn_mfma_f32_32x32x16_bf16(pa0, ATT_PK(l0, h0), od, 0, 0, 0);
  od = __builtin_amdgcn_mfma_f32_32x32x16_bf16(pa1, ATT_PK(l1, h1), od, 0, 0, 0);
  od = __builtin_amdgcn_mfma_f32_32x32x16_bf16(pa2, ATT_PK(l2, h2), od, 0, 0, 0);
  od = __builtin_amdgcn_mfma_f32_32x32x16_bf16(pa3, ATT_PK(l3, h3), od, 0, 0, 0);
#undef ATT_PK
}
__device__ __forceinline__ void pv_d0(f32x16 (&o)[4], int vb, bf16x8 pa0, bf16x8 pa1, bf16x8 pa2, bf16x8 pa3) {
  pv_one<0>(o[0], vb, pa0, pa1, pa2, pa3); pv_one<1>(o[1], vb, pa0, pa1, pa2, pa3); pv_one<2>(o[2], vb, pa0, pa1, pa2, pa3); pv_one<3>(o[3], vb, pa0, pa1, pa2, pa3);
}
__device__ __forceinline__ unsigned short f2bf(float f) { unsigned u = __builtin_bit_cast(unsigned, f); return (unsigned short)((u + 0x7fffu + ((u >> 16) & 1u)) >> 16); }

__device__ __forceinline__ void attn_unit(const unsigned short* __restrict__ Qb, const unsigned short* __restrict__ Kh, const unsigned short* __restrict__ Vh,
                                          unsigned short* __restrict__ Ob, int seq, char* lds) {
  int tid_ = threadIdx.x; asm volatile("" : "+v"(tid_));
  const int tid = tid_, wid = tid >> 6, lane = tid & 63, r32 = lane & 31, hi = lane >> 5;
  char* V_lds = lds; char* K_lds = lds + 2 * SHM_V;
  float* wsf = (float*)(lds + 2 * SHM_V + 2 * SHM_K) + wid * 64; float* li_l = wsf; float* al_l = wsf + 32;
  float m_reg = -1e30f, l_reg = 0; f32x16 o[4] = {}; bf16x8 qr[4];
  const unsigned short* Qw = Qb + (long)(wid * QBLK + r32) * ATT_LDP + hi * 8;
#pragma unroll
  for (int d0 = 0; d0 < 4; ++d0) qr[d0] = *reinterpret_cast<const bf16x8*>(Qw + d0 * 16);
  const int sr = tid >> 4, sc = (tid & 15) * 8, vst0 = v_st(sr, sc), vst1 = v_st(32 + sr, sc);
  const int kr = tid >> 3, kc = (tid & 7) * 8, kst = ATT_KSWZ(kr, kc * 2);
  const int vb0 = (int)(uintptr_t)V_lds + v_rd_base(lane);
  bf16x8 s_vs0[2], s_vs1[2], s_ks[2];
#define ATT_SLOAD(i, k0) do { s_vs0[i] = *reinterpret_cast<const bf16x8*>(&Vh[(long)((k0) + sr) * ATT_LDP + sc]); s_vs1[i] = *reinterpret_cast<const bf16x8*>(&Vh[(long)((k0) + 32 + sr) * ATT_LDP + sc]); \
    s_ks[i] = *reinterpret_cast<const bf16x8*>(&Kh[(long)((k0) + kr) * ATT_LDP + kc]); } while (0)
#define ATT_SWRITE(b, i) do { *(bf16x8*)(V_lds + (b) * SHM_V + vst0) = s_vs0[i]; *(bf16x8*)(V_lds + (b) * SHM_V + vst1) = s_vs1[i]; \
    *(bf16x8*)(K_lds + (b) * SHM_K + kst) = s_ks[i]; } while (0)
#define ATT_SWAIT() asm volatile("s_waitcnt vmcnt(3)" ::: "memory")
#define ATT_RESC(a) do { if (__any((a) < 1.f)) { if (hi == 0) al_l[r32] = (a); asm volatile("s_waitcnt lgkmcnt(0)" ::: "memory"); \
    _Pragma("unroll") for (int d = 0; d < 4; ++d) _Pragma("unroll") for (int r = 0; r < 16; ++r) o[d][r] *= al_l[crow(r, hi)]; } } while (0)
  f32x16 pA0, pA1, pB0, pB1; float mnA, mnB, alA, alB; bf16x8 pa0, pa1, pa2, pa3; const int NT = seq / KVBLK;
  ATT_SLOAD(0, 0); asm volatile("s_waitcnt vmcnt(0)" ::: "memory"); ATT_SWRITE(0, 0); __syncthreads();
  qkt(pA0, pA1, K_lds, qr, r32, hi); partialSM(pA0, pA1, m_reg, mnA, alA);
  ATT_SLOAD(1, KVBLK); if (2 < NT) ATT_SLOAD(0, 2 * KVBLK);
  ATT_SWAIT(); ATT_SWRITE(1, 1); __syncthreads();
  for (int j = 1; j + 1 < NT; j += 2) {
    ATT_SBAR(); qkt(pB0, pB1, K_lds + SHM_K, qr, r32, hi);
    finishSM(pA0, pA1, alA, l_reg, pa0, pa1, pa2, pa3); ATT_SBAR();
    ATT_SLOAD(1, (j + 2) * KVBLK); ATT_SBAR();
    pv_d0(o, vb0, pa0, pa1, pa2, pa3); partialSM(pB0, pB1, m_reg, mnB, alB);
    __syncthreads(); ATT_SWAIT(); ATT_SWRITE(0, 0);
    ATT_RESC(alB); __syncthreads();
    ATT_SBAR(); qkt(pA0, pA1, K_lds, qr, r32, hi);
    finishSM(pB0, pB1, alB, l_reg, pa0, pa1, pa2, pa3); ATT_SBAR();
    if (j + 3 < NT) ATT_SLOAD(0, (j + 3) * KVBLK); ATT_SBAR();
    pv_d0(o, vb0 + SHM_V, pa0, pa1, pa2, pa3); partialSM(pA0, pA1, m_reg, mnA, alA);
    __syncthreads(); ATT_SWAIT(); ATT_SWRITE(1, 1);
    ATT_RESC(alA); __syncthreads();
  }
  ATT_SBAR(); qkt(pB0, pB1, K_lds + SHM_K, qr, r32, hi);
  finishSM(pA0, pA1, alA, l_reg, pa0, pa1, pa2, pa3); ATT_SBAR();
  pv_d0(o, vb0, pa0, pa1, pa2, pa3); partialSM(pB0, pB1, m_reg, mnB, alB);
  __syncthreads(); ATT_RESC(alB);
  finishSM(pB0, pB1, alB, l_reg, pa0, pa1, pa2, pa3); ATT_SBAR();
  pv_d0(o, vb0 + SHM_V, pa0, pa1, pa2, pa3);
  if (hi == 0) li_l[r32] = l_reg; asm volatile("s_waitcnt lgkmcnt(0)" ::: "memory");
  float rli[16];
#pragma unroll
  for (int r = 0; r < 16; ++r) rli[r] = __builtin_amdgcn_rcpf(li_l[crow(r, hi)]);
  unsigned short* Ow = Ob + (long)(wid * QBLK) * ATT_LDO;
#pragma unroll
  for (int r = 0; r < 16; ++r) { const int orow = crow(r, hi);
#pragma unroll
    for (int d0 = 0; d0 < 4; ++d0) Ow[(long)orow * ATT_LDO + d0 * 32 + r32] = f2bf(o[d0][r] * rli[r]); }
#undef ATT_SLOAD
#undef ATT_SWRITE
#undef ATT_SWAIT
#undef ATT_RESC
}
}

constexpr int NWAVES = 8;
constexpr int D = 2048, BATCH = 16, SEQ = 2048, DEPTH = 4, M = BATCH * SEQ;
constexpr int DFF = 5504, NGU = 2 * DFF, DIN = 8192;
constexpr int C_HGQ = 0, C_HGI = 1024, C_HGZF = 2048, C_HGZB = 3072, C_HGG = 4096, C_DAQ = 5120, C_DAK = 5632, C_DAV = 6144, C_SCB = 6656, C_SCC = 7168, C_SCU = 7680;
constexpr float EPS = 1e-6f;
enum { I_X = 0, I_POS, I_F1N, I_F1G, I_F1U, I_F1D, I_MIXN, I_WIN, I_LB, I_HGN, I_DAQN, I_DAKN, I_LQ1, I_LK1, I_LQ2, I_LK2, I_DAON, I_CW, I_CB, I_CN, I_WOUT, I_F2N, I_F2G, I_F2U, I_F2D, N_IN };

constexpr size_t MiB = 1u << 20;
constexpr size_t WS_CTL = 0, CTL_ZERO_BYTES = 1 * MiB;
constexpr size_t WS_SMALL = 1 * MiB;
constexpr size_t WS_ROPE = 2 * MiB;
constexpr size_t SZ_WGU = (size_t)NGU * D * 2, SZ_WD = (size_t)D * DFF * 2, SZ_WIN = (size_t)DIN * D * 2, SZ_WOUT = (size_t)D * D * 2;
constexpr size_t WS_WGU = 10 * MiB;
constexpr size_t WS_WD = WS_WGU + 8 * SZ_WGU;
constexpr size_t WS_WIN = WS_WD + 8 * SZ_WD;
constexpr size_t WS_WOUT = WS_WIN + 4 * SZ_WIN;
constexpr size_t WS_H = WS_WOUT + 4 * SZ_WOUT;
constexpr size_t WS_P = WS_H + (size_t)M * D * 2;
constexpr size_t WS_OF = WS_P + (size_t)M * DIN * 2;
constexpr size_t WS_OA = WS_OF + (size_t)2 * M * 1024 * 2;
constexpr size_t WS_END = WS_OA + (size_t)M * 1024 * 2;
static_assert(WS_WGU % 256 == 0 && WS_WD % 256 == 0 && WS_WIN % 256 == 0 && WS_H % 256 == 0 && WS_P % 256 == 0 && WS_OF % 256 == 0 && WS_OA % 256 == 0, "ws alignment");
constexpr int CW_BAR = 4096;

constexpr int RING_OFF = 0, RING_BYTES = 131072;
constexpr int LDSCTL_OFF = RING_BYTES, MISC_OFF = LDSCTL_OFF + 320;
constexpr int LDS_BYTES = 147456;
static_assert(MISC_OFF + 128 <= LDS_BYTES, "LDS map");

typedef unsigned v2u __attribute__((ext_vector_type(2)));
typedef float f32x2 __attribute__((ext_vector_type(2)));
__device__ __forceinline__ float wave_sum(float v) {
#pragma unroll
    for (int o = 1; o < 64; o <<= 1) v += __shfl_xor(v, o);
    return v;
}
__device__ __forceinline__ float bflo(unsigned w) { return __builtin_bit_cast(float, w << 16); }
__device__ __forceinline__ float bfhi(unsigned w) { return __builtin_bit_cast(float, w & 0xffff0000u); }
__device__ __forceinline__ void unpack8(const v4u w, float (&x)[8]) { x[0] = bflo(w.x); x[1] = bfhi(w.x); x[2] = bflo(w.y); x[3] = bfhi(w.y); x[4] = bflo(w.z); x[5] = bfhi(w.z); x[6] = bflo(w.w); x[7] = bfhi(w.w); }
__device__ __forceinline__ v4u pack8(const float (&x)[8]) { v4u w; w.x = pg8::cvt_pk_bf16(x[0], x[1]); w.y = pg8::cvt_pk_bf16(x[2], x[3]); w.z = pg8::cvt_pk_bf16(x[4], x[5]); w.w = pg8::cvt_pk_bf16(x[6], x[7]); return w; }

__constant__ double c_inv_freq[32] = {1.0, 0.7498942093324559, 0.5623413251903491, 0.4216965034285822, 0.31622776601683794, 0.23713737056616552, 0.1778279410038923, 0.1333521432163324, 0.1, 0.07498942093324558, 0.05623413251903491,
    0.042169650342858224, 0.03162277660168379, 0.023713737056616554, 0.01778279410038923, 0.01333521432163324, 0.01, 0.007498942093324558, 0.005623413251903491, 0.004216965034285823, 0.0031622776601683794, 0.0023713737056616554,
    0.0017782794100389228, 0.001333521432163324, 0.001, 0.0007498942093324559, 0.0005623413251903491, 0.00042169650342858224, 0.00031622776601683794, 0.00023713737056616554, 0.00017782794100389227, 0.0001333521432163324};
__constant__ float c_lam_init[4] = {0.20000000000000007f, 0.35550906759096934f, 0.4707130183435842f, 0.5560582041556406f};

__device__ __forceinline__ void p0_transpose_item(const float* W, int K, int N, bf16* WT, int gu, LAS float* scr, int item, int lane) {
    const int nblk = N / 32, kb = item / nblk, nb = item % nblk, k0 = 64 * kb, n0 = 32 * nb;
#pragma unroll
    for (int i = 0; i < 8; ++i) { const int kk = 8 * i + (lane >> 3), n4 = (lane & 7) * 4;
        const f32x4 v = *(const GAS f32x4*)(W + (size_t)(k0 + kk) * N + n0 + n4);
        LAS float* d = scr + kk * 33 + n4; d[0] = v.x; d[1] = v.y; d[2] = v.z; d[3] = v.w; }
    LDS_WAIT(); asm volatile("" ::: "memory");
    const int c = lane & 7;
#pragma unroll
    for (int j = 0; j < 4; ++j) { const int n = (lane >> 3) + 8 * j; const LAS float* s = scr + (8 * c) * 33 + n;
        v4u o; o.x = pg8::cvt_pk_bf16(s[0 * 33], s[1 * 33]); o.y = pg8::cvt_pk_bf16(s[2 * 33], s[3 * 33]); o.z = pg8::cvt_pk_bf16(s[4 * 33], s[5 * 33]); o.w = pg8::cvt_pk_bf16(s[6 * 33], s[7 * 33]);
        const int ns = n0 + n; const int dr = gu ? ((ns >> 7) * 256 + (gu - 1) * 128 + (ns & 127)) : ns;
        *(GAS v4u*)(WT + (size_t)dr * K + k0 + 8 * c) = o; }
    LDS_WAIT(); asm volatile("" ::: "memory");
}

__device__ __forceinline__ void norm_phase(const float* x, const float* gain, bf16* H, int gw, int NGW, int lane) {
    f32x4 g[8];
#pragma unroll
    for (int j = 0; j < 8; ++j) g[j] = ((const GAS f32x4*)gain)[lane + 64 * j];
    for (int m = gw; m < M; m += NGW) {
        const GAS f32x4* xr = (const GAS f32x4*)(x + (size_t)m * D) + lane;
        f32x4 v[8]; float s = 0.f;
#pragma unroll
        for (int j = 0; j < 8; ++j) { v[j] = xr[64 * j]; s += (v[j].x * v[j].x + v[j].y * v[j].y) + (v[j].z * v[j].z + v[j].w * v[j].w); }
        const float rstd = 1.0f / sqrtf(wave_sum(s) * (1.0f / D) + EPS);
        GAS v2u* o8 = (GAS v2u*)(H + (size_t)m * D) + lane;
#pragma unroll
        for (int j = 0; j < 8; ++j) { v2u w; w.x = pg8::cvt_pk_bf16(v[j].x * rstd * g[j].x, v[j].y * rstd * g[j].y); w.y = pg8::cvt_pk_bf16(v[j].z * rstd * g[j].z, v[j].w * rstd * g[j].w); o8[64 * j] = w; }
    }
}

__device__ __forceinline__ void prep_phase(bf16* P, bf16* Y, const float* cosT, const float* sinT, const float* qg, const float* kg, const float* cw, const float* cb, const float* cn, int gw, int NGW, int lane) {
    const int grp = lane >> 2, sub = lane & 3;
    float ga1[8], ga2[8];
    { const float* gp = (grp < 8 ? qg : kg);
#pragma unroll
      for (int e = 0; e < 8; ++e) { ga1[e] = gp[sub * 8 + e]; ga2[e] = gp[32 + sub * 8 + e]; } }
    const int c0 = lane * 8;
    float w0[8], w1[8], w2[8], bb[8], gn[8];
#pragma unroll
    for (int e = 0; e < 8; ++e) { w0[e] = cw[c0 + e]; w1[e] = cw[512 + c0 + e]; w2[e] = cw[1024 + c0 + e]; bb[e] = cb[c0 + e]; gn[e] = cn[c0 + e]; }
    for (int m = gw; m < M; m += NGW) {
        bf16* row = P + (size_t)m * DIN;
        {
            bf16* p1 = row + C_DAQ + grp * 64 + sub * 8; bf16* p2 = p1 + 32;
            const v4u a = *(const GAS v4u*)p1, b = *(const GAS v4u*)p2;
            float x1[8], x2[8]; unpack8(a, x1); unpack8(b, x2);
            float ss = 0.f;
#pragma unroll
            for (int e = 0; e < 8; ++e) ss += x1[e] * x1[e] + x2[e] * x2[e];
            ss += __shfl_xor(ss, 1); ss += __shfl_xor(ss, 2);
            const float rstd = 1.0f / sqrtf(ss * (1.0f / 64.0f) + EPS);
            const GAS f32x4* cp = (const GAS f32x4*)(cosT + (size_t)m * 32 + sub * 8); const GAS f32x4* sp = (const GAS f32x4*)(sinT + (size_t)m * 32 + sub * 8);
            const f32x4 cA = cp[0], cB = cp[1], sA = sp[0], sB = sp[1];
            const float cs[8] = {cA.x, cA.y, cA.z, cA.w, cB.x, cB.y, cB.z, cB.w}, sn[8] = {sA.x, sA.y, sA.z, sA.w, sB.x, sB.y, sB.z, sB.w};
            float o1[8], o2[8];
#pragma unroll
            for (int e = 0; e < 8; ++e) { const float y1 = x1[e] * rstd * ga1[e], y2 = x2[e] * rstd * ga2[e]; o1[e] = y1 * cs[e] - y2 * sn[e]; o2[e] = y2 * cs[e] + y1 * sn[e]; }
            *(GAS v4u*)p1 = pack8(o1); *(GAS v4u*)p2 = pack8(o2);
        }
        {
            const int s = m & (SEQ - 1);
            float vc[8], vp[8], vn[8], bg[8], t1[8], t2[8];
            unpack8(*(const GAS v4u*)(row + C_SCC + c0), t1); unpack8(*(const GAS v4u*)(row + C_SCU + c0), t2);
#pragma unroll
            for (int e = 0; e < 8; ++e) vc[e] = t1[e] * t2[e];
            if (s > 0) { unpack8(*(const GAS v4u*)(row - DIN + C_SCC + c0), t1); unpack8(*(const GAS v4u*)(row - DIN + C_SCU + c0), t2);
#pragma unroll
                for (int e = 0; e < 8; ++e) vp[e] = t1[e] * t2[e]; }
            else {
#pragma unroll
                for (int e = 0; e < 8; ++e) vp[e] = 0.f; }
            if (s < SEQ - 1) { unpack8(*(const GAS v4u*)(row + DIN + C_SCC + c0), t1); unpack8(*(const GAS v4u*)(row + DIN + C_SCU + c0), t2);
#pragma unroll
                for (int e = 0; e < 8; ++e) vn[e] = t1[e] * t2[e]; }
            else {
#pragma unroll
                for (int e = 0; e < 8; ++e) vn[e] = 0.f; }
            unpack8(*(const GAS v4u*)(row + C_SCB + c0), bg);
            float y[8]; float ss = 0.f;
#pragma unroll
            for (int e = 0; e < 8; ++e) { y[e] = (bb[e] + w0[e] * vp[e] + w1[e] * vc[e] + w2[e] * vn[e]) * bg[e]; ss += y[e] * y[e]; }
            ss += __shfl_xor(ss, 1); ss += __shfl_xor(ss, 2); ss += __shfl_xor(ss, 4); ss += __shfl_xor(ss, 8);
            const float rstd = 1.0f / sqrtf(ss * (1.0f / 128.0f) + EPS);
#pragma unroll
            for (int e = 0; e < 8; ++e) y[e] = y[e] * rstd * gn[e];
            *(GAS v4u*)(Y + (size_t)m * D + 1536 + c0) = pack8(y);
        }
    }
}

__device__ __forceinline__ void combine_phase(const bf16* P, const bf16* OF, const bf16* OA, bf16* Y, const float* hgn, const float* daon, const float* lq1, const float* lk1, const float* lq2, const float* lk2, float lam_init,
                                              int gw, int NGW, int lane) {
    const float d1 = wave_sum(lq1[lane] * lk1[lane]), d2 = wave_sum(lq2[lane] * lk2[lane]);
    const float lam = expf(d1) - expf(d2) + lam_init;
    const int ca = lane * 16, cbk = lane * 8;
    float ga[16], gb[8];
#pragma unroll
    for (int e = 0; e < 16; ++e) ga[e] = hgn[ca + e];
#pragma unroll
    for (int e = 0; e < 8; ++e) gb[e] = daon[cbk + e] * (1.0f - lam_init);
    for (int m = gw; m < M; m += NGW) {
        {
            const bf16* f0 = OF + (size_t)m * 1024 + ca; const bf16* f1 = OF + ((size_t)M + m) * 1024 + ca; const bf16* gp = P + (size_t)m * DIN + C_HGG + ca;
            float a[16], b[16], g[16];
            { float t[8]; unpack8(*(const GAS v4u*)f0, t);
#pragma unroll
              for (int e = 0; e < 8; ++e) a[e] = t[e];
              unpack8(*(const GAS v4u*)(f0 + 8), t);
#pragma unroll
              for (int e = 0; e < 8; ++e) a[8 + e] = t[e];
              unpack8(*(const GAS v4u*)f1, t);
#pragma unroll
              for (int e = 0; e < 8; ++e) b[e] = t[e];
              unpack8(*(const GAS v4u*)(f1 + 8), t);
#pragma unroll
              for (int e = 0; e < 8; ++e) b[8 + e] = t[e];
              unpack8(*(const GAS v4u*)gp, t);
#pragma unroll
              for (int e = 0; e < 8; ++e) g[e] = t[e];
              unpack8(*(const GAS v4u*)(gp + 8), t);
#pragma unroll
              for (int e = 0; e < 8; ++e) g[8 + e] = t[e]; }
            float ss = 0.f;
#pragma unroll
            for (int e = 0; e < 16; ++e) { a[e] += b[e]; ss += a[e] * a[e]; }
            ss += __shfl_xor(ss, 1); ss += __shfl_xor(ss, 2); ss += __shfl_xor(ss, 4);
            const float rstd = 1.0f / sqrtf(ss * (1.0f / 128.0f) + EPS);
            float o0[8], o1[8];
#pragma unroll
            for (int e = 0; e < 8; ++e) { const float g0 = g[e], g1 = g[8 + e];
                o0[e] = a[e] * rstd * ga[e] * (g0 / (1.0f + __expf(-g0))); o1[e] = a[8 + e] * rstd * ga[8 + e] * (g1 / (1.0f + __expf(-g1))); }
            GAS v4u* yp = (GAS v4u*)(Y + (size_t)m * D + ca); yp[0] = pack8(o0); yp[1] = pack8(o1);
        }
        {
            const int head = lane >> 4, v0 = (lane & 15) * 8;
            const bf16* ap = OA + (size_t)m * 1024 + head * 256 + v0;
            float a0[8], a1[8]; unpack8(*(const GAS v4u*)ap, a0); unpack8(*(const GAS v4u*)(ap + 128), a1);
            float ss = 0.f;
#pragma unroll
            for (int e = 0; e < 8; ++e) { a0[e] = a0[e] - lam * a1[e]; ss += a0[e] * a0[e]; }
            ss += __shfl_xor(ss, 1); ss += __shfl_xor(ss, 2); ss += __shfl_xor(ss, 4); ss += __shfl_xor(ss, 8);
            const float rstd = 1.0f / sqrtf(ss * (1.0f / 128.0f) + EPS);
#pragma unroll
            for (int e = 0; e < 8; ++e) a0[e] = a0[e] * rstd * gb[e];
            *(GAS v4u*)(Y + (size_t)m * D + 1024 + cbk) = pack8(a0);
        }
    }
}

__device__ __forceinline__ void scan_unit_v1(const bf16* P, const float* lbt, bf16* OFd, int b, int h, int dir, LAS unsigned char* ldsb, int tid) {
    LAS float* Fs = (LAS float*)ldsb; LAS float* Ks = Fs + 4096; LAS float* Qs = Ks + 4096; LAS float* Vs = Qs + 4096; LAS float* Os = Vs + 4096;
    const int lane = tid & 63, wv = tid >> 6, v = wv * 16 + (lane & 15), kq = lane >> 4;
    const int tok = tid >> 4, ch0 = (tid & 15) * 8;
    float lbv[8];
#pragma unroll
    for (int e = 0; e < 8; ++e) lbv[e] = lbt[h * 128 + ch0 + e];
    float S[32];
#pragma unroll
    for (int j = 0; j < 32; ++j) S[j] = 0.f;
    const int zc = (dir ? C_HGZB : C_HGZF) + h * 128 + ch0;
    for (int blk = 0; blk < SEQ / 32; ++blk) {
        const int tau = blk * 32 + tok, s = dir ? (SEQ - 1 - tau) : tau; const size_t m = (size_t)b * SEQ + s;
        const bf16* row = P + m * DIN;
        { float q[8], iv[8], z[8], f[8], kk[8];
          unpack8(*(const GAS v4u*)(row + C_HGQ + h * 128 + ch0), q); unpack8(*(const GAS v4u*)(row + C_HGI + h * 128 + ch0), iv); unpack8(*(const GAS v4u*)(row + zc), z);
#pragma unroll
          for (int e = 0; e < 8; ++e) { const float ex = __expf(-z[e]); const float sg = 1.0f / (1.0f + ex); const float om = 1.0f - lbv[e]; f[e] = lbv[e] + om * sg; kk[e] = om * (ex * sg); }
          LAS f32x4* d;
          d = (LAS f32x4*)(Fs + tok * 128 + ch0); d[0] = (f32x4){f[0], f[1], f[2], f[3]}; d[1] = (f32x4){f[4], f[5], f[6], f[7]};
          d = (LAS f32x4*)(Ks + tok * 128 + ch0); d[0] = (f32x4){kk[0], kk[1], kk[2], kk[3]}; d[1] = (f32x4){kk[4], kk[5], kk[6], kk[7]};
          d = (LAS f32x4*)(Qs + tok * 128 + ch0); d[0] = (f32x4){q[0], q[1], q[2], q[3]}; d[1] = (f32x4){q[4], q[5], q[6], q[7]};
          d = (LAS f32x4*)(Vs + tok * 128 + ch0); d[0] = (f32x4){iv[0], iv[1], iv[2], iv[3]}; d[1] = (f32x4){iv[4], iv[5], iv[6], iv[7]}; }
        __syncthreads();
#pragma unroll 1
        for (int t = 0; t < 32; ++t) {
            const float vv = Vs[t * 128 + v]; float acc = 0.f;
            const LAS f32x4* fp = (const LAS f32x4*)(Fs + t * 128 + kq * 32); const LAS f32x4* kp = (const LAS f32x4*)(Ks + t * 128 + kq * 32); const LAS f32x4* qp = (const LAS f32x4*)(Qs + t * 128 + kq * 32);
#pragma unroll
            for (int j4 = 0; j4 < 8; ++j4) { const f32x4 f4 = fp[j4], k4 = kp[j4], q4 = qp[j4];
                S[4 * j4 + 0] = f4.x * S[4 * j4 + 0] + k4.x * vv; acc += S[4 * j4 + 0] * q4.x;
                S[4 * j4 + 1] = f4.y * S[4 * j4 + 1] + k4.y * vv; acc += S[4 * j4 + 1] * q4.y;
                S[4 * j4 + 2] = f4.z * S[4 * j4 + 2] + k4.z * vv; acc += S[4 * j4 + 2] * q4.z;
                S[4 * j4 + 3] = f4.w * S[4 * j4 + 3] + k4.w * vv; acc += S[4 * j4 + 3] * q4.w; }
            acc += __shfl_xor(acc, 16); acc += __shfl_xor(acc, 32);
            if (kq == 0) Os[t * 128 + v] = acc;
        }
        __syncthreads();
        { const LAS f32x4* op = (const LAS f32x4*)(Os + tok * 128 + ch0); const f32x4 oA = op[0], oB = op[1];
          const float o8[8] = {oA.x, oA.y, oA.z, oA.w, oB.x, oB.y, oB.z, oB.w};
          *(GAS v4u*)(OFd + m * 1024 + h * 128 + ch0) = pack8(o8); }
    }
    __syncthreads();
}


namespace sc2 {
typedef short bf16x8 __attribute__((ext_vector_type(8)));
typedef float f32x4 __attribute__((ext_vector_type(4)));
typedef float f32x2 __attribute__((ext_vector_type(2)));
typedef unsigned u32x2 __attribute__((ext_vector_type(2)));
typedef unsigned u32x4 __attribute__((ext_vector_type(4)));
constexpr int CH = 32;
constexpr int RS_RAW = 256;
constexpr int O_RZ = 0, O_RQ = 8192, O_RV = 16384, O_TOT = 24576;
constexpr int RS_QI = 272;
constexpr int O_QI = 28672, O_KI = O_QI + 32 * RS_QI;
constexpr int RS_T = 80;
constexpr int O_KHT = O_KI + 32 * RS_QI, O_VT = O_KHT + 128 * RS_T;
constexpr int O_DK = O_VT + 128 * RS_T;
constexpr int RS_OB = 528;
constexpr int O_OB = O_DK + 512;
constexpr int LDS_END = O_OB + 32 * RS_OB;
static_assert(LDS_END <= 131072 && O_QI % 16 == 0 && O_KHT % 16 == 0 && O_DK % 16 == 0 && O_OB % 16 == 0, "scan LDS map");
typedef __bf16 bf16v2 __attribute__((ext_vector_type(2)));
__device__ __forceinline__ unsigned pk(float lo, float hi) { const f32x2 v = {lo, hi}; return __builtin_bit_cast(unsigned, __builtin_convertvector(v, bf16v2)); }
__device__ __forceinline__ bf16x8 mk8(u32x2 a, u32x2 b) { u32x4 w = {a.x, a.y, b.x, b.y}; return __builtin_bit_cast(bf16x8, w); }
#define SC2_MFMA(a, b, c) __builtin_amdgcn_mfma_f32_16x16x32_bf16((a), (b), (c), 0, 0, 0)

__device__ __forceinline__ void scan_unit(const unsigned short* P, const float* lbt, unsigned short* OFd, int b, int h, int dir, LAS unsigned char* L, int tid_in) {
    int tid = tid_in; asm volatile("" : "+v"(tid));
    const int lane = tid & 63, w = __builtin_amdgcn_readfirstlane(tid >> 6), c16 = lane & 15, g = lane >> 4;
    const int tok = tid >> 4, ch0 = (tid & 15) * 8;
    const int kp = lane;
    const float lb0 = lbt[h * 128 + 2 * kp], lb1 = lbt[h * 128 + 2 * kp + 1];
    const float om0 = 1.0f - lb0, om1 = 1.0f - lb1;
    const int zc = (dir ? C_HGZB : C_HGZF) + h * 128 + ch0;
    f32x4 S[8];
#pragma unroll
    for (int i = 0; i < 8; ++i) S[i] = (f32x4){0.f, 0.f, 0.f, 0.f};
    v4u rq, rz, rv;
    { const int s = dir ? (SEQ - 1 - tok) : tok; const unsigned short* row = P + ((size_t)b * SEQ + s) * DIN;
      rq = *(const GAS v4u*)(row + C_HGQ + h * 128 + ch0); rv = *(const GAS v4u*)(row + C_HGI + h * 128 + ch0); rz = *(const GAS v4u*)(row + zc); }
    *(LAS v4u*)(L + O_RQ + tok * RS_RAW + ch0 * 2) = rq; *(LAS v4u*)(L + O_RV + tok * RS_RAW + ch0 * 2) = rv; *(LAS v4u*)(L + O_RZ + tok * RS_RAW + ch0 * 2) = rz;
    __syncthreads();
#pragma unroll 1
    for (int c = 0; c < SEQ / CH; ++c) {
        if (c > 0) { const int tau = (c - 1) * CH + tok, s = dir ? (SEQ - 1 - tau) : tau;
            const LAS f32x4* op = (const LAS f32x4*)(L + O_OB + tok * RS_OB + ch0 * 4); const f32x4 oA = op[0], oB = op[1];
            v4u o; o.x = pk(oA.x, oA.y); o.y = pk(oA.z, oA.w); o.z = pk(oB.x, oB.y); o.w = pk(oB.z, oB.w);
            *(GAS v4u*)(OFd + ((size_t)b * SEQ + s) * 1024 + h * 128 + ch0) = o; }
        if (c + 1 < SEQ / CH) { const int tau = (c + 1) * CH + tok, s = dir ? (SEQ - 1 - tau) : tau; const unsigned short* row = P + ((size_t)b * SEQ + s) * DIN;
            rq = *(const GAS v4u*)(row + C_HGQ + h * 128 + ch0); rv = *(const GAS v4u*)(row + C_HGI + h * 128 + ch0); rz = *(const GAS v4u*)(row + zc); }
        float c0[4], c1[4], kk0[4], kk1[4];
        { float a0 = 0.f, a1 = 0.f;
#pragma unroll
          for (int i = 0; i < 4; ++i) { const unsigned zw = *(const LAS unsigned*)(L + O_RZ + (4 * w + i) * RS_RAW + kp * 4);
              const float z0 = fminf(fmaxf(bflo(zw), -30.f), 30.f), z1 = fminf(fmaxf(bfhi(zw), -30.f), 30.f);
              const float e0 = __expf(-z0), e1 = __expf(-z1); const float s0 = __builtin_amdgcn_rcpf(1.0f + e0), s1 = __builtin_amdgcn_rcpf(1.0f + e1);
              const float f0 = lb0 + om0 * s0, f1 = lb1 + om1 * s1; kk0[i] = om0 * (e0 * s0); kk1[i] = om1 * (e1 * s1);
              a0 += __logf(f0); a1 += __logf(f1); c0[i] = a0; c1[i] = a1; }
          *(LAS f32x2*)(L + O_TOT + (w * 128 + 2 * kp) * 4) = (f32x2){a0, a1}; }
        __syncthreads();
        { float off0 = 0.f, off1 = 0.f, end0 = 0.f, end1 = 0.f;
#pragma unroll
          for (int ww = 0; ww < 8; ++ww) { const f32x2 t = *(const LAS f32x2*)(L + O_TOT + (ww * 128 + 2 * kp) * 4); end0 += t.x; end1 += t.y; if (ww < w) { off0 += t.x; off1 += t.y; } }
          float kh0[4], kh1[4]; unsigned vw[4];
#pragma unroll
          for (int i = 0; i < 4; ++i) { const int tau = 4 * w + i;
              const unsigned qw = *(const LAS unsigned*)(L + O_RQ + tau * RS_RAW + kp * 4); vw[i] = *(const LAS unsigned*)(L + O_RV + tau * RS_RAW + kp * 4);
              const float cu0 = off0 + c0[i], cu1 = off1 + c1[i];
              const float eq0 = __expf(cu0), eq1 = __expf(cu1), ek0 = __expf(fminf(-cu0, 60.f)), ek1 = __expf(fminf(-cu1, 60.f));
              kh0[i] = kk0[i] * __expf(end0 - cu0); kh1[i] = kk1[i] * __expf(end1 - cu1);
              *(LAS unsigned*)(L + O_QI + tau * RS_QI + kp * 4) = pk(bflo(qw) * eq0, bfhi(qw) * eq1);
              *(LAS unsigned*)(L + O_KI + tau * RS_QI + kp * 4) = pk(kk0[i] * ek0, kk1[i] * ek1); }
          *(LAS u32x2*)(L + O_KHT + (2 * kp) * RS_T + 8 * w) = (u32x2){pk(kh0[0], kh0[1]), pk(kh0[2], kh0[3])};
          *(LAS u32x2*)(L + O_KHT + (2 * kp + 1) * RS_T + 8 * w) = (u32x2){pk(kh1[0], kh1[1]), pk(kh1[2], kh1[3])};
          *(LAS u32x2*)(L + O_VT + (2 * kp) * RS_T + 8 * w) = (u32x2){(vw[0] & 0xffffu) | (vw[1] << 16), (vw[2] & 0xffffu) | (vw[3] << 16)};
          *(LAS u32x2*)(L + O_VT + (2 * kp + 1) * RS_T + 8 * w) = (u32x2){(vw[0] >> 16) | (vw[1] & 0xffff0000u), (vw[2] >> 16) | (vw[3] & 0xffff0000u)};
          if (w == 0) *(LAS f32x2*)(L + O_DK + 2 * kp * 4) = (f32x2){__expf(end0), __expf(end1)}; }
        __syncthreads();
        { const bf16x8 vf = mk8(*(const LAS u32x2*)(L + O_VT + (16 * w + c16) * RS_T + 8 * g), *(const LAS u32x2*)(L + O_VT + (16 * w + c16) * RS_T + 32 + 8 * g));
          bf16x8 qf[2][4], kf[2][4];
#pragma unroll
          for (int tb = 0; tb < 2; ++tb)
#pragma unroll
              for (int ks = 0; ks < 4; ++ks) { const int ro = (16 * tb + c16) * RS_QI + (32 * ks + 4 * g) * 2;
                  qf[tb][ks] = mk8(*(const LAS u32x2*)(L + O_QI + ro), *(const LAS u32x2*)(L + O_QI + ro + 32));
                  kf[tb][ks] = mk8(*(const LAS u32x2*)(L + O_KI + ro), *(const LAS u32x2*)(L + O_KI + ro + 32)); }
          f32x4 p00 = {0.f, 0.f, 0.f, 0.f}, p01 = p00, p11 = p00;
#pragma unroll
          for (int ks = 0; ks < 4; ++ks) { p00 = SC2_MFMA(kf[0][ks], qf[0][ks], p00); p01 = SC2_MFMA(kf[0][ks], qf[1][ks], p01); p11 = SC2_MFMA(kf[1][ks], qf[1][ks], p11); }
#pragma unroll
          for (int r = 0; r < 4; ++r) { const bool keep = (4 * g + r) <= c16; p00[r] = keep ? p00[r] : 0.f; p11[r] = keep ? p11[r] : 0.f; }
          const bf16x8 pa0 = mk8((u32x2){pk(p00[0], p00[1]), pk(p00[2], p00[3])}, (u32x2){0u, 0u});
          const bf16x8 pa1 = mk8((u32x2){pk(p01[0], p01[1]), pk(p01[2], p01[3])}, (u32x2){pk(p11[0], p11[1]), pk(p11[2], p11[3])});
          f32x4 o0 = {0.f, 0.f, 0.f, 0.f}, o1 = o0;
          o0 = SC2_MFMA(pa0, vf, o0); o1 = SC2_MFMA(pa1, vf, o1);
#pragma unroll
          for (int ks = 0; ks < 4; ++ks) { const bf16x8 sf = mk8((u32x2){pk(S[2 * ks][0], S[2 * ks][1]), pk(S[2 * ks][2], S[2 * ks][3])}, (u32x2){pk(S[2 * ks + 1][0], S[2 * ks + 1][1]), pk(S[2 * ks + 1][2], S[2 * ks + 1][3])});
              o0 = SC2_MFMA(qf[0][ks], sf, o0); o1 = SC2_MFMA(qf[1][ks], sf, o1); }
#pragma unroll
          for (int kb = 0; kb < 8; ++kb) { const int ro = (16 * kb + c16) * RS_T + 8 * g;
              const bf16x8 hf = mk8(*(const LAS u32x2*)(L + O_KHT + ro), *(const LAS u32x2*)(L + O_KHT + ro + 32));
              const f32x4 dv = *(const LAS f32x4*)(L + O_DK + (16 * kb + 4 * g) * 4);
              S[kb] = S[kb] * dv; S[kb] = SC2_MFMA(hf, vf, S[kb]); }
#pragma unroll
          for (int r = 0; r < 4; ++r) { *(LAS float*)(L + O_OB + (4 * g + r) * RS_OB + (16 * w + c16) * 4) = o0[r]; *(LAS float*)(L + O_OB + (16 + 4 * g + r) * RS_OB + (16 * w + c16) * 4) = o1[r]; } }
        if (c + 1 < SEQ / CH) { *(LAS v4u*)(L + O_RQ + tok * RS_RAW + ch0 * 2) = rq; *(LAS v4u*)(L + O_RV + tok * RS_RAW + ch0 * 2) = rv; *(LAS v4u*)(L + O_RZ + tok * RS_RAW + ch0 * 2) = rz; }
        __syncthreads();
    }
    { const int tau = (SEQ / CH - 1) * CH + tok, s = dir ? (SEQ - 1 - tau) : tau;
      const LAS f32x4* op = (const LAS f32x4*)(L + O_OB + tok * RS_OB + ch0 * 4); const f32x4 oA = op[0], oB = op[1];
      v4u o; o.x = pk(oA.x, oA.y); o.y = pk(oA.z, oA.w); o.z = pk(oB.x, oB.y); o.w = pk(oB.z, oB.w);
      *(GAS v4u*)(OFd + ((size_t)b * SEQ + s) * 1024 + h * 128 + ch0) = o; }
    __syncthreads();
}
#undef SC2_MFMA
}

#ifndef DUP_MASK
#define DUP_MASK 0
#endif
#define REPS(b) ((((DUP_MASK) >> (b)) & 1) + 1)
#ifndef EN_P0
#define EN_P0 1
#endif
#ifndef EN_NORM
#define EN_NORM 1
#endif
#ifndef EN_GU
#define EN_GU 1
#endif
#ifndef EN_WIN
#define EN_WIN 1
#endif
#ifndef EN_PREP
#define EN_PREP 1
#endif
#ifndef EN_SCAN
#define EN_SCAN 1
#endif
#ifndef EN_ATTN
#define EN_ATTN 1
#endif
#ifndef EN_COMB
#define EN_COMB 1
#endif
#ifndef EN_RES
#define EN_RES 1
#endif
struct Args { const void* in[N_IN]; float* out; unsigned char* ws; int ph_lo, ph_hi; };
constexpr int PH_PER_LAYER = 13, NPH = 1 + DEPTH * PH_PER_LAYER;

__global__ void __launch_bounds__(NWAVES * 64, 2) fwd_kernel(Args args) {
    extern __shared__ __attribute__((aligned(16))) unsigned char lds[];
    LAS unsigned char* ldsb = (LAS unsigned char*)lds;
    volatile LAS unsigned* MISC = (volatile LAS unsigned*)(ldsb + MISC_OFF);
    const int tid0 = threadIdx.x;
    const int G = gridDim.x; const int bx = blockIdx.x; const int vcu = (G % 8 == 0) ? (bx % 8) * (G / 8) + bx / 8 : bx;
    const int NGW = G * NWAVES;
#define PHASE_IDS() int tid = threadIdx.x; asm volatile("" : "+v"(tid)); const int lane = tid & 63, wave = __builtin_amdgcn_readfirstlane(tid >> 6), gw = vcu * NWAVES + wave; (void)lane; (void)gw
    unsigned char* ws = args.ws;
    gu32* ctl = (gu32*)(ws + WS_CTL);
    for (int u = tid0; u < (LDS_BYTES - LDSCTL_OFF) / 4; u += NWAVES * 64) ((LAS unsigned*)(ldsb + LDSCTL_OFF))[u] = 0u;
    __syncthreads();
    const int lo = args.ph_lo, hi = args.ph_hi;
    const bool multi = (hi - lo) > 1;
    XcdBarrier bar; bar.bar = (unsigned*)(ctl + CW_BAR); bar.x = 0; bar.st = nullptr;
    if (multi) bar = xcd_barrier_post((unsigned*)(ctl + CW_BAR), MISC + 8);
#define RUN(k) (lo <= (k) && (k) < hi)
#define SEAM(k) do { if (RUN(k) && RUN((k) + 1)) xcd_barrier(bar); } while (0)

    float* out = args.out;
    bf16* H = (bf16*)(ws + WS_H); bf16* Y = H; bf16* P = (bf16*)(ws + WS_P); bf16* ACT = P; bf16* OF = (bf16*)(ws + WS_OF); bf16* OA = (bf16*)(ws + WS_OA);
    float* lbt = (float*)(ws + WS_SMALL); float* cosT = (float*)(ws + WS_ROPE); float* sinT = cosT + (size_t)M * 32;

    if (EN_P0 && RUN(0)) {
        PHASE_IDS();
        for (int rep = 0; rep < REPS(7); ++rep) {
        LAS float* scr = (LAS float*)(ldsb + RING_OFF + wave * 16384);
        constexpr int I_GU = (D / 64) * (DFF / 32), I_DN = (DFF / 64) * (D / 32), I_IN = (D / 64) * (DIN / 32), I_OUT = (D / 64) * (D / 32);
        constexpr int PER_LAYER = 2 * (2 * I_GU + I_DN) + I_IN + I_OUT, NITEMS = DEPTH * PER_LAYER;
        for (int it = gw; it < NITEMS; it += NGW) {
            const int L = it / PER_LAYER; int r = it % PER_LAYER;
            const size_t oGU = (size_t)L * D * DFF;
            if (r < I_GU) { p0_transpose_item((const float*)args.in[I_F1G] + oGU, D, DFF, (bf16*)(ws + WS_WGU + (size_t)(2 * L) * SZ_WGU), 1, scr, r, lane); continue; } r -= I_GU;
            if (r < I_GU) { p0_transpose_item((const float*)args.in[I_F1U] + oGU, D, DFF, (bf16*)(ws + WS_WGU + (size_t)(2 * L) * SZ_WGU), 2, scr, r, lane); continue; } r -= I_GU;
            if (r < I_DN) { p0_transpose_item((const float*)args.in[I_F1D] + oGU, DFF, D, (bf16*)(ws + WS_WD + (size_t)(2 * L) * SZ_WD), 0, scr, r, lane); continue; } r -= I_DN;
            if (r < I_GU) { p0_transpose_item((const float*)args.in[I_F2G] + oGU, D, DFF, (bf16*)(ws + WS_WGU + (size_t)(2 * L + 1) * SZ_WGU), 1, scr, r, lane); continue; } r -= I_GU;
            if (r < I_GU) { p0_transpose_item((const float*)args.in[I_F2U] + oGU, D, DFF, (bf16*)(ws + WS_WGU + (size_t)(2 * L + 1) * SZ_WGU), 2, scr, r, lane); continue; } r -= I_GU;
            if (r < I_DN) { p0_transpose_item((const float*)args.in[I_F2D] + oGU, DFF, D, (bf16*)(ws + WS_WD + (size_t)(2 * L + 1) * SZ_WD), 0, scr, r, lane); continue; } r -= I_DN;
            if (r < I_IN) { p0_transpose_item((const float*)args.in[I_WIN] + (size_t)L * D * DIN, D, DIN, (bf16*)(ws + WS_WIN + (size_t)L * SZ_WIN), 0, scr, r, lane); continue; } r -= I_IN;
            p0_transpose_item((const float*)args.in[I_WOUT] + (size_t)L * D * D, D, D, (bf16*)(ws + WS_WOUT + (size_t)L * SZ_WOUT), 0, scr, r, lane);
        }
        { const int* pos = (const int*)args.in[I_POS];
          for (int i = (vcu * NWAVES * 64 + tid); i < M * 32; i += G * NWAVES * 64) { const int m = i >> 5, j = i & 31;
              const double ang = (double)(float)((float)pos[m] * (float)c_inv_freq[j]);
              double rev = ang * 0.15915494309189533577; rev -= __builtin_rint(rev);
              const float rf = (float)rev; cosT[i] = __builtin_amdgcn_cosf(rf); sinT[i] = __builtin_amdgcn_sinf(rf); } }
        { const float* lg = (const float*)args.in[I_LB];
          for (int i = (vcu * NWAVES * 64 + tid); i < 2 * 1024; i += G * NWAVES * 64) { const int dir = i >> 10, c = i & 1023;
              float l[DEPTH], mx = -1e30f;
#pragma unroll
              for (int j = 0; j < DEPTH; ++j) { l[j] = lg[(dir * DEPTH + j) * 1024 + c]; mx = fmaxf(mx, l[j]); }
              float sum = 0.f;
#pragma unroll
              for (int j = 0; j < DEPTH; ++j) { l[j] = expf(l[j] - mx); sum += l[j]; }
              float cum = 0.f;
#pragma unroll
              for (int j = 0; j < DEPTH; ++j) { if (j > 0) cum += l[j] / sum; lbt[(dir * DEPTH + j) * 1024 + c] = cum; } } }
        }
    }
    SEAM(0);

#pragma unroll 1
    for (int L = 0; L < DEPTH; ++L) {
#pragma unroll 1
        for (int st = 0; st < 3; ++st) {
            const int pb = 1 + PH_PER_LAYER * L + (st == 0 ? 0 : (st == 1 ? 3 : 10));
            const float* xsrc = (L == 0 && st == 0) ? (const float*)args.in[I_X] : (const float*)out;
            if (EN_NORM && RUN(pb)) {
                PHASE_IDS();
                const float* gain = (const float*)args.in[st == 0 ? I_F1N : (st == 1 ? I_MIXN : I_F2N)] + (size_t)L * D;
                for (int rep = 0; rep < REPS(6); ++rep) norm_phase(xsrc, gain, H, gw, NGW, lane);
            }
            SEAM(pb);
            int plast;
            if (st != 1) {
                if (EN_GU && RUN(pb + 1)) {
                    const bf16* W = (const bf16*)(ws + WS_WGU + (size_t)(2 * L + (st == 2 ? 1 : 0)) * SZ_WGU);
                    pg8::Gemm g{H, W, M, NGU, D}; pg8::StaticOrder S; S.init(M, NGU, G, bx);
                    pg8::EpiSwiGLU E{ACT, DFF};
                    for (int rep = 0; rep < REPS(0); ++rep) pg8::gemm_phase<pg8::EpiSwiGLU, pg8::StaticOrder, true, true>(ldsb + RING_OFF, g, S, E);
                }
                SEAM(pb + 1);
                plast = pb + 2;
            } else {
                if (EN_WIN && RUN(pb + 1)) {
                    const bf16* W = (const bf16*)(ws + WS_WIN + (size_t)L * SZ_WIN);
                    pg8::Gemm g{H, W, M, DIN, D}; pg8::StaticOrder S; S.init(M, DIN, G, bx);
                    pg8::EpiBf16 E{P, DIN};
                    for (int rep = 0; rep < REPS(2); ++rep) pg8::gemm_phase<pg8::EpiBf16, pg8::StaticOrder, true, true>(ldsb + RING_OFF, g, S, E);
                }
                SEAM(pb + 1);
                if (EN_PREP && RUN(pb + 2)) {
                    PHASE_IDS();
                    prep_phase(P, Y, cosT, sinT, (const float*)args.in[I_DAQN] + L * 64, (const float*)args.in[I_DAKN] + L * 64, (const float*)args.in[I_CW] + L * 1536, (const float*)args.in[I_CB] + L * 512,
                               (const float*)args.in[I_CN] + L * 512, gw, NGW, lane);
                }
                SEAM(pb + 2);
                if (EN_SCAN && RUN(pb + 3)) {
                    PHASE_IDS();
                    for (int rep = 0; rep < REPS(4); ++rep)
                    for (int u = vcu; u < BATCH * 8 * 2; u += G) { const int b = u >> 4, h = (u >> 1) & 7, dir = u & 1;
                        sc2::scan_unit(P, lbt + (size_t)(dir * DEPTH + L) * 1024, OF + (size_t)dir * M * 1024, b, h, dir, ldsb + RING_OFF, tid); }
                }
                SEAM(pb + 3);
                if (EN_ATTN && RUN(pb + 4)) {
                    for (int rep = 0; rep < REPS(5); ++rep)
                    for (int u = vcu; u < BATCH * 4 * 2 * (SEQ / 256); u += G) { const int qb = u & 7, cmb = u >> 3, map = cmb & 1, h = (cmb >> 1) & 3, b = cmb >> 3;
                        const bf16* Pb = P + (size_t)b * SEQ * DIN;
                        __syncthreads();
                        att::attn_unit(Pb + (size_t)(qb * 256) * DIN + C_DAQ + h * 128 + map * 64, Pb + C_DAK + h * 128 + map * 64, Pb + C_DAV + h * 128,
                                       OA + ((size_t)b * SEQ + qb * 256) * 1024 + h * 256 + map * 128, SEQ, (char*)lds + RING_OFF); }
                    __syncthreads();
                }
                SEAM(pb + 4);
                if (EN_COMB && RUN(pb + 5)) {
                    PHASE_IDS();
                    for (int rep = 0; rep < REPS(8); ++rep) combine_phase(P, OF, OA, Y, (const float*)args.in[I_HGN] + L * 1024, (const float*)args.in[I_DAON] + L * 512, (const float*)args.in[I_LQ1] + L * 64, (const float*)args.in[I_LK1] + L * 64,
                                  (const float*)args.in[I_LQ2] + L * 64, (const float*)args.in[I_LK2] + L * 64, c_lam_init[L], gw, NGW, lane);
                }
                SEAM(pb + 5);
                plast = pb + 6;
            }
            if (EN_RES && RUN(plast)) {
                const bf16* A = (st == 1) ? Y : ACT; const int K = (st == 1) ? D : DFF;
                const bf16* W = (st == 1) ? (const bf16*)(ws + WS_WOUT + (size_t)L * SZ_WOUT) : (const bf16*)(ws + WS_WD + (size_t)(2 * L + (st == 2 ? 1 : 0)) * SZ_WD);
                pg8::Gemm g{A, W, M, D, K}; pg8::StaticOrder S; S.init(M, D, G, bx);
                const int nrep = (st == 1) ? REPS(3) : REPS(1);
                for (int rep = 0; rep < nrep; ++rep) { const bool real = (rep == nrep - 1);
                    pg8::EpiResAdd E{real ? xsrc : (const float*)out, out, D, real ? ((st == 1) ? 1.0f : 0.5f) : 0.0f};
                    pg8::gemm_phase<pg8::EpiResAdd, pg8::StaticOrder, true, true>(ldsb + RING_OFF, g, S, E); }
            }
            if (plast + 1 < NPH) SEAM(plast);
        }
    }
#undef RUN
#undef SEAM
}

#ifndef MK_PER_PHASE
#define MK_PER_PHASE 0
#endif
extern "C" void kernel_launch(void* const* d_in, const int* in_sizes, int n_in, void* d_out, int out_size, void* d_ws, size_t ws_size, hipStream_t stream) {
    static int grid = 0;
    if (grid == 0) {
        if (n_in != N_IN || in_sizes[0] != M * D || out_size != M * D || ws_size < WS_END) {
            fprintf(stderr, "kernel_launch: shape/workspace mismatch: n_in %d in0 %d out %d ws %zu (need %zu); nothing launched\n", n_in, n_in > 0 ? in_sizes[0] : -1, out_size, ws_size, (size_t)WS_END); grid = -1; return; }
        int dev = 0, cus = 0, per_cu = 0;
        if (hipGetDevice(&dev) != hipSuccess || hipDeviceGetAttribute(&cus, hipDeviceAttributeMultiprocessorCount, dev) != hipSuccess) { fprintf(stderr, "kernel_launch: device query failed\n"); grid = -1; return; }
        if (hipFuncSetAttribute((const void*)fwd_kernel, hipFuncAttributeMaxDynamicSharedMemorySize, LDS_BYTES) != hipSuccess) { fprintf(stderr, "kernel_launch: hipFuncSetAttribute failed\n"); grid = -1; return; }
        if (hipOccupancyMaxActiveBlocksPerMultiprocessor(&per_cu, (const void*)fwd_kernel, NWAVES * 64, LDS_BYTES) != hipSuccess || per_cu < 1)
            fprintf(stderr, "kernel_launch: note: occupancy query reports %d workgroups per CU\n", per_cu);
        (void)hipGetLastError();
        grid = cus;
    }
    if (grid < 0) return;
    if (hipMemsetAsync((char*)d_ws + WS_CTL, 0, CTL_ZERO_BYTES, stream) != hipSuccess) { fprintf(stderr, "kernel_launch: memset failed\n"); return; }
    Args a{};
    for (int i = 0; i < N_IN; ++i) a.in[i] = d_in[i];
    a.out = (float*)d_out; a.ws = (unsigned char*)d_ws;
#if MK_PER_PHASE
    for (int p = 0; p < NPH; ++p) { a.ph_lo = p; a.ph_hi = p + 1;
        hipLaunchKernelGGL(fwd_kernel, dim3(grid), dim3(NWAVES * 64), LDS_BYTES, stream, a); }
#else
    a.ph_lo = 0; a.ph_hi = NPH;
    hipLaunchKernelGGL(fwd_kernel, dim3(grid), dim3(NWAVES * 64), LDS_BYTES, stream, a);
#endif
    const hipError_t le = hipPeekAtLastError();
    if (le != hipSuccess) fprintf(stderr, "kernel_launch: launch failed: %s\n", hipGetErrorName(le));
}
```

```cpp
#include <hip/hip_runtime.h>
#include <cstdio>
#include <cstdint>
namespace pg8 {
#define PG8_LAS __attribute__((address_space(3)))
typedef unsigned short bf16_t;
typedef short bf16x8 __attribute__((ext_vector_type(8)));
typedef float f32x4 __attribute__((ext_vector_type(4)));
typedef unsigned u32x4 __attribute__((ext_vector_type(4)));
constexpr int BM = 256, BK = 64, HALF = 128, HTB = HALF * BK * 2  , STAGE_BYTES = 8 * HTB, NXCD = 8, WGM = 8;

__host__ __device__ __forceinline__ int lds_byte(int r, int c) { const int st = (r >> 4) * 2 + (c >> 5), rr = r & 15, cc = c & 31, ob = rr * 64 + cc * 2; return st * 1024 + (ob ^ (((ob >> 9) & 1) << 5)); }
__host__ __device__ __forceinline__ void stage_rc(int b, int& R, int& C) { const int st = b / 1024, sb = b % 1024, swz = sb ^ (((sb >> 9) & 1) << 5); R = (st >> 1) * 16 + swz / 64; C = (st & 1) * 32 + (swz % 64) / 2; }
__host__ __device__ __forceinline__ int perm32(int rho) { const int n = rho >> 4, i = rho & 15; return 8 * (i >> 2) + 4 * n + (i & 3); }

struct Unit { int pm, pn; };
struct Gemm { const bf16_t* A; const bf16_t* Bt; int M, N, K; };

struct StaticOrder {
    int nM, nN, nwg, G, c;
    __host__ __device__ void init(int M, int N, int G_, int c_) { nM = M / BM; nN = N / BM; nwg = nM * nN; G = G_; c = c_; }
    __host__ __device__ bool next(int i, Unit& u) const {
        const long L = (long)i * G + c; if (L >= nwg) return false;
        int wgid = (int)L; { const int q = nwg / NXCD, r = nwg % NXCD, xcd = wgid % NXCD, off = wgid / NXCD; wgid = (xcd < r ? xcd * (q + 1) : r * (q + 1) + (xcd - r) * q) + off; }
        const int nig = WGM * nN, gid = wgid / nig, fm = gid * WGM, gsz = (nM - fm) < WGM ? (nM - fm) : WGM;
        u.pm = fm + ((wgid % nig) % gsz); u.pn = (wgid % nig) / gsz; return true;
    }
    __device__ __forceinline__ void a_ready(const Unit&) const {}
    __device__ __forceinline__ void done(const Unit&) const {}
};

__device__ __forceinline__ unsigned cvt_pk_bf16(float lo, float hi) { unsigned r; asm volatile("v_cvt_pk_bf16_f32 %0, %1, %2" : "=v"(r) : "v"(lo), "v"(hi)); return r; }

__device__ __forceinline__ u32x4 lane_xpose(u32x4 w, int srcaddr) {
    u32x4 r; r.x = (unsigned)__builtin_amdgcn_ds_bpermute(srcaddr, (int)w.x); r.y = (unsigned)__builtin_amdgcn_ds_bpermute(srcaddr, (int)w.y);
    r.z = (unsigned)__builtin_amdgcn_ds_bpermute(srcaddr, (int)w.z); r.w = (unsigned)__builtin_amdgcn_ds_bpermute(srcaddr, (int)w.w); return r; }

constexpr float RSQ_SCALE = 4096.0f;
struct NoPre {};
struct RsqPre { unsigned q[2][4]; };
__device__ __forceinline__ void prefetch_rsq(RsqPre& p, const unsigned* rowsq, const Unit& u, int wr, int fr) {
#pragma unroll
    for (int ai = 0; ai < 2; ++ai)
#pragma unroll
        for (int m = 0; m < 4; ++m) p.q[ai][m] = rowsq[u.pm * BM + ai * HALF + wr * 64 + m * 16 + fr];
}
__device__ __forceinline__ float rstd_of(unsigned q) { return __builtin_amdgcn_rsqf((float)q * (1.0f / (RSQ_SCALE * 2048.0f)) + 1e-6f); }
#ifndef EPI_STORE_MODE
#define EPI_STORE_MODE 0
#endif
__device__ __forceinline__ void epi_store16(void* p, u32x4 v) {
#if EPI_STORE_MODE == 1
    asm volatile("global_store_dwordx4 %0, %1, off sc1\n\ts_nop 2" :: "v"(p), "v"(v) : "memory");
#elif EPI_STORE_MODE == 2
    asm volatile("global_store_dwordx4 %0, %1, off nt\n\ts_nop 2" :: "v"(p), "v"(v) : "memory");
#elif EPI_STORE_MODE == 3
    asm volatile("global_store_dwordx4 %0, %1, off sc0 sc1\n\ts_nop 2" :: "v"(p), "v"(v) : "memory");
#else
    *(u32x4*)p = v;
#endif
}
struct EpiBf16 {
    static constexpr bool PERM = true, AFTER_DRAIN = false;
    bf16_t* O; int ldc; const unsigned* rowsq;
    typedef RsqPre Pre;
    __device__ __forceinline__ void prefetch(Pre& p, const Unit& u, int wr, int fr) const { prefetch_rsq(p, rowsq, u, wr, fr); }
    __device__ __forceinline__ void operator()(const f32x4 (&acc)[2][2][4][2], const Unit& u, int wr, int wc, int fr, int fq, const Pre& p) const {
        const int lane = fr + 16 * fq, pr = lane >> 2, pc = lane & 3, sa = (pr + 16 * pc) * 4;
        const int row0 = u.pm * BM + wr * 64 + pr, col0 = u.pn * BM + wc * 32 + 8 * pc;
        float rs[2][4];
#pragma unroll
        for (int ai = 0; ai < 2; ++ai)
#pragma unroll
            for (int m = 0; m < 4; ++m) rs[ai][m] = rstd_of(p.q[ai][m]);
#pragma unroll
        for (int ai = 0; ai < 2; ++ai)
#pragma unroll
            for (int m = 0; m < 4; ++m) { bf16_t* rowp = O + (size_t)(row0 + ai * HALF + m * 16) * ldc + col0;
#pragma unroll
                for (int bj = 0; bj < 2; ++bj) { const f32x4 v0 = acc[ai][bj][m][0] * rs[ai][m], v1 = acc[ai][bj][m][1] * rs[ai][m];
                    u32x4 w; w.x = cvt_pk_bf16(v0[0], v0[1]); w.y = cvt_pk_bf16(v0[2], v0[3]); w.z = cvt_pk_bf16(v1[0], v1[1]); w.w = cvt_pk_bf16(v1[2], v1[3]);
                    epi_store16(rowp + bj * HALF, lane_xpose(w, sa)); } }
    }
};
struct EpiSwiGLU {
    static constexpr bool PERM = true, AFTER_DRAIN = false;
    bf16_t* O; int ldc; const unsigned* rowsq;
    typedef RsqPre Pre;
    __device__ __forceinline__ void prefetch(Pre& p, const Unit& u, int wr, int fr) const { prefetch_rsq(p, rowsq, u, wr, fr); }
    __device__ __forceinline__ float sg(float g, float u) const { const float e = __builtin_amdgcn_exp2f(g * -1.44269504088896341f); return g * __builtin_amdgcn_rcpf(1.0f + e) * u; }
    __device__ __forceinline__ void operator()(const f32x4 (&acc)[2][2][4][2], const Unit& u, int wr, int wc, int fr, int fq, const Pre& p) const {
        const int lane = fr + 16 * fq, pr = lane >> 2, pc = lane & 3, sa = (pr + 16 * pc) * 4;
        const int row0 = u.pm * BM + wr * 64 + pr, col0 = u.pn * HALF + wc * 32 + 8 * pc;
        float rs[2][4];
#pragma unroll
        for (int ai = 0; ai < 2; ++ai)
#pragma unroll
            for (int m = 0; m < 4; ++m) rs[ai][m] = rstd_of(p.q[ai][m]);
#pragma unroll
        for (int ai = 0; ai < 2; ++ai)
#pragma unroll
            for (int m = 0; m < 4; ++m) { bf16_t* rowp = O + (size_t)(row0 + ai * HALF + m * 16) * ldc + col0; const float r = rs[ai][m];
                const f32x4 g0 = acc[ai][0][m][0] * r, g1 = acc[ai][0][m][1] * r, u0 = acc[ai][1][m][0] * r, u1 = acc[ai][1][m][1] * r;
                u32x4 w; w.x = cvt_pk_bf16(sg(g0[0], u0[0]), sg(g0[1], u0[1])); w.y = cvt_pk_bf16(sg(g0[2], u0[2]), sg(g0[3], u0[3]));
                w.z = cvt_pk_bf16(sg(g1[0], u1[0]), sg(g1[1], u1[1])); w.w = cvt_pk_bf16(sg(g1[2], u1[2]), sg(g1[3], u1[3]));
                epi_store16(rowp, lane_xpose(w, sa)); }
    }
};
template <bool FINAL> struct EpiResAdd {
    static constexpr bool PERM = true, AFTER_DRAIN = false;
    bf16_t* xb; float* out; unsigned* rowsq_out; int ldc; float scale;
    typedef NoPre Pre;
    __device__ __forceinline__ void prefetch(Pre&, const Unit&, int, int) const {}
    __device__ __forceinline__ void operator()(const f32x4 (&acc)[2][2][4][2], const Unit& u, int wr, int wc, int fr, int fq, const Pre&) const {
        const int lane = fr + 16 * fq, pr = lane >> 2, pc = lane & 3, sa = (pr + 16 * pc) * 4;
        const int row0 = u.pm * BM + wr * 64 + pr, col0 = u.pn * BM + wc * 32 + 8 * pc;
#pragma unroll
        for (int ai = 0; ai < 2; ++ai) {
            u32x4 b[4][2];
#pragma unroll
            for (int m = 0; m < 4; ++m) { const size_t off = (size_t)(row0 + ai * HALF + m * 16) * ldc + col0;
#pragma unroll
                for (int bj = 0; bj < 2; ++bj) b[m][bj] = *(const u32x4*)(xb + off + bj * HALF); }
#pragma unroll
            for (int m = 0; m < 4; ++m) { const int row = row0 + ai * HALF + m * 16; const size_t off = (size_t)row * ldc + col0; float ss = 0.f;
#pragma unroll
                for (int bj = 0; bj < 2; ++bj) {
                    const f32x4 a0 = acc[ai][bj][m][0] * scale, a1 = acc[ai][bj][m][1] * scale;
                    const u32x4 bw = b[m][bj];
                    const f32x4 r0 = {__builtin_bit_cast(float, bw.x << 16), __builtin_bit_cast(float, bw.x & 0xffff0000u), __builtin_bit_cast(float, bw.y << 16), __builtin_bit_cast(float, bw.y & 0xffff0000u)};
                    const f32x4 r1 = {__builtin_bit_cast(float, bw.z << 16), __builtin_bit_cast(float, bw.z & 0xffff0000u), __builtin_bit_cast(float, bw.w << 16), __builtin_bit_cast(float, bw.w & 0xffff0000u)};
                    const f32x4 x0 = r0 + __builtin_bit_cast(f32x4, lane_xpose(__builtin_bit_cast(u32x4, a0), sa)), x1 = r1 + __builtin_bit_cast(f32x4, lane_xpose(__builtin_bit_cast(u32x4, a1), sa));
                    if constexpr (FINAL) { epi_store16(out + off + bj * HALF, __builtin_bit_cast(u32x4, x0)); epi_store16(out + off + bj * HALF + 4, __builtin_bit_cast(u32x4, x1)); }
                    else { u32x4 w; w.x = cvt_pk_bf16(x0[0], x0[1]); w.y = cvt_pk_bf16(x0[2], x0[3]); w.z = cvt_pk_bf16(x1[0], x1[1]); w.w = cvt_pk_bf16(x1[2], x1[3]);
                        epi_store16(xb + off + bj * HALF, w);
                        ss += (x0[0] * x0[0] + x0[1] * x0[1]) + (x0[2] * x0[2] + x0[3] * x0[3]) + (x1[0] * x1[0] + x1[1] * x1[1]) + (x1[2] * x1[2] + x1[3] * x1[3]); } }
                if constexpr (!FINAL) { ss += __shfl_xor(ss, 1); ss += __shfl_xor(ss, 2);
                    if (pc == 0) __hip_atomic_fetch_add(rowsq_out + row, (unsigned)(ss * RSQ_SCALE), __ATOMIC_RELAXED, __HIP_MEMORY_SCOPE_AGENT); } }
            asm volatile("" ::: "memory"); }
    }
};

template <int MODE> struct EpiBf16Probe {
    static constexpr bool PERM = true, AFTER_DRAIN = false;
    bf16_t* O; int ldc;
    typedef NoPre Pre;
    __device__ __forceinline__ void prefetch(Pre&, const Unit&, int, int) const {}
    __device__ __forceinline__ void operator()(const f32x4 (&acc)[2][2][4][2], const Unit& u, int wr, int wc, int fr, int fq, const Pre&) const {
        const int lane = fr + 16 * fq, pr = lane >> 2, pc = lane & 3, sa = (pr + 16 * pc) * 4;
        const int row0 = wr * 64 + pr, col0 = wc * 32 + 8 * pc;
        bf16_t* Ob = O + (size_t)blockIdx.x * 65536;
#pragma unroll
        for (int ai = 0; ai < 2; ++ai)
#pragma unroll
            for (int m = 0; m < 4; ++m) { bf16_t* rowp = Ob + (size_t)(row0 + ai * HALF + m * 16) * 256 + col0;
#pragma unroll
                for (int bj = 0; bj < 2; ++bj) { const f32x4 v0 = acc[ai][bj][m][0], v1 = acc[ai][bj][m][1];
                    u32x4 w; w.x = cvt_pk_bf16(v0[0], v0[1]); w.y = cvt_pk_bf16(v0[2], v0[3]); w.z = cvt_pk_bf16(v1[0], v1[1]); w.w = cvt_pk_bf16(v1[2], v1[3]);
                    const u32x4 t = lane_xpose(w, sa);
                    if (MODE == 1 || t.x == 0x12345678u) *(u32x4*)(rowp + bj * HALF) = t; } }
    }
};
struct EpiNone {
    static constexpr bool PERM = true, AFTER_DRAIN = false;
    float* sink;
    typedef NoPre Pre;
    __device__ __forceinline__ void prefetch(Pre&, const Unit&, int, int) const {}
    __device__ __forceinline__ void operator()(const f32x4 (&acc)[2][2][4][2], const Unit& u, int wr, int wc, int fr, int fq, const Pre&) const {
        float s = 0.f;
#pragma unroll
        for (int ai = 0; ai < 2; ++ai)
#pragma unroll
            for (int bj = 0; bj < 2; ++bj)
#pragma unroll
                for (int m = 0; m < 4; ++m)
#pragma unroll
                    for (int n = 0; n < 2; ++n) s += acc[ai][bj][m][n][0] + acc[ai][bj][m][n][1] + acc[ai][bj][m][n][2] + acc[ai][bj][m][n][3];
        if (s == 123456.789f) sink[u.pm + wr + wc + fr + fq] = s;
    }
};

template <class Epi, class Sched, bool ALIGN_EPI = false, bool SP2 = false>
__device__ __forceinline__ void gemm_phase(PG8_LAS unsigned char* lds, const Gemm g, const Sched& S, const Epi& E) {
    int tid_ = threadIdx.x; asm volatile("" : "+v"(tid_));
    const int tid = tid_, wid = __builtin_amdgcn_readfirstlane(tid >> 6), lane = tid & 63, wr = wid >> 2, wc = wid & 3, fr = lane & 15, fq = lane >> 4;
    const int K = g.K, nt = K / BK;
    unsigned voffA[2], voffB[2];
#pragma unroll
    for (int i = 0; i < 2; ++i) { int R, C; stage_rc(tid * 16 + i * 8192, R, C); const int Rb = Epi::PERM ? ((R & ~31) + perm32(R & 31)) : R;
        voffA[i] = (unsigned)(R * K + C) * 2u; voffB[i] = (unsigned)(Rb * K + C) * 2u; }
    const size_t kstep = (size_t)(BK * 2);
    const size_t hstep = (size_t)HALF * K * 2;
    const size_t tstep = 2 * hstep;
    const unsigned ldsw = (unsigned)wid * 1024u;
    const int aoff = lds_byte(wr * 64 + fr, fq * 8), boff = lds_byte(wc * 32 + fr, fq * 8);
#define PG8_SA(b, h) (((b) * 2 + (h)) * HTB)
#define PG8_SB(b, h) ((4 + (b) * 2 + (h)) * HTB)
#define PG8_STAGE(bufoff, gbase, voff) do { _Pragma("unroll") for (int _i = 0; _i < 2; ++_i) \
        __builtin_amdgcn_global_load_lds((const unsigned*)((const char*)(gbase) + (voff)[_i]), (PG8_LAS unsigned*)(lds + (bufoff) + ldsw + _i * 8192), 16, 0, 0); } while (0)
#define PG8_LDA(dst, b, h) do { _Pragma("unroll") for (int m = 0; m < 4; ++m) _Pragma("unroll") for (int k = 0; k < 2; ++k) dst[m][k] = *(const PG8_LAS bf16x8*)(lds + PG8_SA(b, h) + aoff + m * 2048 + k * 1024); } while (0)
#define PG8_LDB(dst, b, h) do { _Pragma("unroll") for (int n = 0; n < 2; ++n) _Pragma("unroll") for (int k = 0; k < 2; ++k) dst[n][k] = *(const PG8_LAS bf16x8*)(lds + PG8_SB(b, h) + boff + n * 2048 + k * 1024); } while (0)
#define PG8_MMA(ai, bj, At, Bt) do { __builtin_amdgcn_s_setprio(1); _Pragma("unroll") for (int m = 0; m < 4; ++m) _Pragma("unroll") for (int n = 0; n < 2; ++n) _Pragma("unroll") for (int k = 0; k < 2; ++k) \
        acc[ai][bj][m][n] = __builtin_amdgcn_mfma_f32_16x16x32_bf16(Bt[n][k], At[m][k], acc[ai][bj][m][n], 0, 0, 0); __builtin_amdgcn_s_setprio(0); } while (0)
#define PG8_WAIT_V(n) asm volatile("s_waitcnt vmcnt(" #n ")" ::: "memory")
#define PG8_WAIT_L(n) asm volatile("s_waitcnt lgkmcnt(" #n ")" ::: "memory")
#define PG8_BAR __builtin_amdgcn_s_barrier()
#define PG8_SCHED __builtin_amdgcn_sched_barrier(0)
    Unit cur, nxt; int ui = 0;
    if (!S.next(0, cur)) return;
    f32x4 acc[2][2][4][2];
#pragma unroll
    for (int a = 0; a < 2; ++a)
#pragma unroll
        for (int b = 0; b < 2; ++b)
#pragma unroll
            for (int m = 0; m < 4; ++m)
#pragma unroll
                for (int n = 0; n < 2; ++n) acc[a][b][m][n] = (f32x4){0.f, 0.f, 0.f, 0.f};
    bf16x8 At[4][2], B0[2][2], B1[2][2];
    const char* cA = (const char*)g.A + (size_t)cur.pm * tstep; const char* cB = (const char*)g.Bt + (size_t)cur.pn * tstep;
    S.a_ready(cur);
    typename Epi::Pre pre; E.prefetch(pre, cur, wr, fr);
    if constexpr (SP2) {
        PG8_STAGE(PG8_SB(0, 0), cB, voffB); PG8_STAGE(PG8_SB(0, 1), cB + hstep, voffB); PG8_STAGE(PG8_SA(0, 0), cA, voffA); PG8_STAGE(PG8_SA(0, 1), cA + hstep, voffA);
        if (wr == 1) PG8_BAR;
        PG8_WAIT_V(2); PG8_BAR;
        PG8_STAGE(PG8_SB(1, 0), cB + kstep, voffB); PG8_STAGE(PG8_SA(1, 0), cA + kstep, voffA); PG8_STAGE(PG8_SB(1, 1), cB + hstep + kstep, voffB);
        PG8_WAIT_V(6); PG8_BAR;
    } else {
        PG8_STAGE(PG8_SB(0, 0), cB, voffB); PG8_STAGE(PG8_SA(0, 0), cA, voffA); PG8_STAGE(PG8_SB(0, 1), cB + hstep, voffB); PG8_STAGE(PG8_SA(0, 1), cA + hstep, voffA);
        if (wr == 1) PG8_BAR;
        PG8_WAIT_V(4); PG8_BAR;
        PG8_STAGE(PG8_SB(1, 0), cB + kstep, voffB); PG8_STAGE(PG8_SA(1, 0), cA + kstep, voffA); PG8_STAGE(PG8_SB(1, 1), cB + hstep + kstep, voffB);
        PG8_WAIT_V(6); PG8_BAR;
    }
    for (;;) {
        const bool has_next = S.next(ui + 1, nxt);
        const char* nA = has_next ? (const char*)g.A + (size_t)nxt.pm * tstep : cA; const char* nB = has_next ? (const char*)g.Bt + (size_t)nxt.pn * tstep : cB;
        for (int t = 0; t < nt; t += 2) {
            const bool last = (t == nt - 2);
            const char* a1 = cA + (size_t)(t + 1) * kstep;
            const char* a2 = last ? nA : cA + (size_t)(t + 2) * kstep; const char* b2 = last ? nB : cB + (size_t)(t + 2) * kstep;
            const char* a3 = a2 + kstep; const char* b3 = b2 + kstep;
            if (last && has_next) S.a_ready(nxt);
            if constexpr (SP2) {
            PG8_LDB(B0, 0, 0); PG8_LDB(B1, 0, 1); PG8_SCHED; PG8_LDA(At, 0, 0); PG8_STAGE(PG8_SA(1, 1), a1 + hstep, voffA);
            PG8_WAIT_V(8); PG8_WAIT_L(0); PG8_BAR; PG8_MMA(0, 0, At, B0); PG8_MMA(0, 1, At, B1); PG8_BAR; PG8_SCHED;
            PG8_LDA(At, 0, 1); PG8_STAGE(PG8_SB(0, 0), b2, voffB); PG8_STAGE(PG8_SB(0, 1), b2 + hstep, voffB); PG8_STAGE(PG8_SA(0, 0), a2, voffA);
            PG8_WAIT_V(8); PG8_WAIT_L(0); PG8_BAR; PG8_MMA(1, 0, At, B0); PG8_MMA(1, 1, At, B1); PG8_BAR; PG8_SCHED;
            PG8_LDB(B0, 1, 0); PG8_LDB(B1, 1, 1); PG8_SCHED; PG8_LDA(At, 1, 0); PG8_STAGE(PG8_SA(0, 1), a2 + hstep, voffA);
            PG8_WAIT_V(8); PG8_WAIT_L(0); PG8_BAR; PG8_MMA(0, 0, At, B0); PG8_MMA(0, 1, At, B1); PG8_BAR; PG8_SCHED;
            PG8_LDA(At, 1, 1); PG8_STAGE(PG8_SB(1, 0), b3, voffB); PG8_STAGE(PG8_SB(1, 1), b3 + hstep, voffB); PG8_STAGE(PG8_SA(1, 0), a3, voffA);
            PG8_WAIT_V(8); PG8_WAIT_L(0); PG8_BAR; PG8_MMA(1, 0, At, B0); PG8_MMA(1, 1, At, B1); PG8_BAR; PG8_SCHED;
            } else {
            PG8_LDB(B0, 0, 0); PG8_SCHED; PG8_LDA(At, 0, 0); PG8_STAGE(PG8_SA(1, 1), a1 + hstep, voffA);
            PG8_WAIT_L(8); PG8_BAR; PG8_WAIT_L(0); PG8_MMA(0, 0, At, B0); PG8_BAR; PG8_SCHED;
            PG8_LDB(B1, 0, 1); PG8_STAGE(PG8_SB(0, 0), b2, voffB);
            PG8_BAR; PG8_WAIT_L(0); PG8_MMA(0, 1, At, B1); PG8_BAR;
            PG8_LDA(At, 0, 1); PG8_STAGE(PG8_SA(0, 0), a2, voffA);
            PG8_BAR; PG8_WAIT_L(0); PG8_MMA(1, 0, At, B0); PG8_BAR; PG8_SCHED;
            PG8_STAGE(PG8_SB(0, 1), b2 + hstep, voffB);
            PG8_WAIT_V(6); PG8_BAR; PG8_MMA(1, 1, At, B1); PG8_BAR;
            PG8_LDB(B0, 1, 0); PG8_SCHED; PG8_LDA(At, 1, 0); PG8_STAGE(PG8_SA(0, 1), a2 + hstep, voffA);
            PG8_WAIT_L(8); PG8_BAR; PG8_WAIT_L(0); PG8_MMA(0, 0, At, B0); PG8_BAR; PG8_SCHED;
            PG8_LDB(B1, 1, 1); PG8_STAGE(PG8_SB(1, 0), b3, voffB);
            PG8_BAR; PG8_WAIT_L(0); PG8_MMA(0, 1, At, B1); PG8_BAR;
            PG8_LDA(At, 1, 1); PG8_STAGE(PG8_SA(1, 0), a3, voffA);
            PG8_BAR; PG8_WAIT_L(0); PG8_MMA(1, 0, At, B0); PG8_BAR; PG8_SCHED;
            PG8_STAGE(PG8_SB(1, 1), b3 + hstep, voffB);
            PG8_WAIT_V(6); PG8_BAR; PG8_MMA(1, 1, At, B1); PG8_BAR;
            }
        }
        if constexpr (ALIGN_EPI) { if (wr == 0) PG8_BAR; }
        if constexpr (!Epi::AFTER_DRAIN) { E(acc, cur, wr, wc, fr, fq, pre); S.done(cur); }
        if (!has_next) break;
#pragma unroll
        for (int a = 0; a < 2; ++a)
#pragma unroll
            for (int b = 0; b < 2; ++b)
#pragma unroll
                for (int m = 0; m < 4; ++m)
#pragma unroll
                    for (int n = 0; n < 2; ++n) acc[a][b][m][n] = (f32x4){0.f, 0.f, 0.f, 0.f};
        cur = nxt; cA = nA; cB = nB; ++ui;
        E.prefetch(pre, cur, wr, fr);
        if constexpr (ALIGN_EPI) { if (wr == 1) PG8_BAR; }
    }
    PG8_WAIT_V(0);
    if constexpr (!ALIGN_EPI) { if (wr == 0) PG8_BAR; }
    PG8_BAR;
    if constexpr (Epi::AFTER_DRAIN) { E.fused(acc, cur, wr, wc, fr, fq, lds, wid, lane); S.done(cur); }
#undef PG8_SA
#undef PG8_SB
#undef PG8_STAGE
#undef PG8_LDA
#undef PG8_LDB
#undef PG8_MMA
#undef PG8_WAIT_V
#undef PG8_WAIT_L
#undef PG8_BAR
#undef PG8_SCHED
}
}

#define GAS __attribute__((address_space(1)))
#define LAS __attribute__((address_space(3)))
typedef unsigned short bf16;
typedef unsigned v4u __attribute__((ext_vector_type(4)));
typedef float f32x4 __attribute__((ext_vector_type(4)));
typedef GAS unsigned gu32;
#define LDS_WAIT() asm volatile("s_waitcnt lgkmcnt(0)" ::: "memory")
#define VM_WAIT() asm volatile("s_waitcnt vmcnt(0)" ::: "memory")

#define XB_TMO      128
#define XB_XCNT(j)  (256  + 64 * (j))
#define XB_XSUB(j)  (1280 + 64 * (j))
#define XB_XGEN(j)  (2304 + 64 * (j))
#define XB_TOP      3328
#define XB_TOPGEN   3392
#define XCD_BAR_WORDS 3456
#define XB_SPIN_CAP (1u << 18)

__device__ __forceinline__ unsigned xb_ld(unsigned* p)              { return __hip_atomic_load(p, __ATOMIC_RELAXED, __HIP_MEMORY_SCOPE_AGENT); }
__device__ __forceinline__ unsigned xb_add(unsigned* p, unsigned v) { return __hip_atomic_fetch_add(p, v, __ATOMIC_RELAXED, __HIP_MEMORY_SCOPE_AGENT); }
__device__ __forceinline__ unsigned xb_xcc_id() { return (unsigned)__builtin_amdgcn_s_getreg((3 << 11) | 20) & 0xFu; }
#define XB_SPIN(cond, bar) do { unsigned _sp = 0; while (cond) { __builtin_amdgcn_s_sleep(1); \
    if ((++_sp & 255u) == 0u) { if (xb_ld(&(bar)[XB_TMO])) break; if (_sp > XB_SPIN_CAP) { atomicAdd(&(bar)[XB_TMO], 1u); break; } } } } while (0)

struct XcdBarrier {
    unsigned* bar; unsigned x;
    volatile LAS unsigned* st;
};

__device__ __forceinline__ XcdBarrier xcd_barrier_post(unsigned* bar, volatile LAS unsigned* st) {
    XcdBarrier b; b.bar = bar; b.x = xb_xcc_id(); b.st = st;
    if (threadIdx.x == 0) (void)xb_add(&bar[XB_XCNT(b.x)], 1u);
    return b;
}
__device__ __forceinline__ void xcd_barrier_complete(unsigned* bar, unsigned x, unsigned& nloc, unsigned& nx) {
    const unsigned G = gridDim.x * gridDim.y * gridDim.z;
    unsigned sum, cnt, mine, sp = 0u;
    for (;;) {
        sum = 0u; cnt = 0u; mine = 0u;
#pragma unroll
        for (unsigned j = 0; j < 16; ++j) { const unsigned c = xb_ld(&bar[XB_XCNT(j)]); sum += c; cnt += (c > 0u) ? 1u : 0u; mine = (j == x) ? c : mine; }
        if (sum == G) break;
        __builtin_amdgcn_s_sleep(1);
        if ((++sp & 255u) == 0u) { if (xb_ld(&bar[XB_TMO])) break; if (sp > XB_SPIN_CAP) { atomicAdd(&bar[XB_TMO], 1u); break; } }
    }
    nloc = mine > 0u ? mine : 1u; nx = cnt > 0u ? cnt : 1u;
}

__device__ __forceinline__ void xcd_barrier(const XcdBarrier& b) {
    asm volatile("s_waitcnt vmcnt(0)" ::: "memory");
    __syncthreads();
    if (threadIdx.x == 0) {
        unsigned* bar = b.bar;
        __builtin_amdgcn_s_waitcnt(0);
        unsigned nloc = b.st[0], nx = b.st[1];
        if (nloc == 0u) { xcd_barrier_complete(bar, b.x, nloc, nx); b.st[0] = nloc; b.st[1] = nx; }
        const unsigned old = xb_add(&bar[XB_XSUB(b.x)], 1u);
        const unsigned gen = old / nloc;
        if (old + 1u == (gen + 1u) * nloc) {
            __builtin_amdgcn_fence(__ATOMIC_RELEASE, "agent");
            asm volatile("s_waitcnt vmcnt(0)" ::: "memory");
            const unsigned og = xb_add(&bar[XB_TOP], 1u);
            const unsigned tg = og / nx;
            if (og + 1u == (tg + 1u) * nx) xb_add(&bar[XB_TOPGEN], 1u);
            else XB_SPIN(xb_ld(&bar[XB_TOPGEN]) == tg, bar);
            __builtin_amdgcn_fence(__ATOMIC_ACQUIRE, "agent");
            xb_add(&bar[XB_XGEN(b.x)], 1u);
            asm volatile("s_waitcnt vmcnt(0)" ::: "memory");
        } else {
            XB_SPIN(xb_ld(&bar[XB_XGEN(b.x)]) == gen, bar);
            __builtin_amdgcn_fence(__ATOMIC_ACQUIRE, "agent");
            asm volatile("s_waitcnt vmcnt(0)" ::: "memory");
        }
    }
    __syncthreads();
}

namespace att {
using bf16x8 = __attribute__((ext_vector_type(8))) short;
using s16x4  = __attribute__((ext_vector_type(4))) short;
using f32x16 = __attribute__((ext_vector_type(16))) float;
using u32x4  = __attribute__((ext_vector_type(4))) unsigned;
constexpr int QBLK = 32, KVBLK = 64, NW = 8, DV = 128, DQK = 64;
constexpr float SCALE = 0.125f, THR = 8.f;
constexpr int ATT_LDP = 8192, ATT_LDO = 1024;
constexpr int SHM_V = KVBLK * DV * 2, SHM_K = KVBLK * DQK * 2, SHM_ATTN = 2 * SHM_V + 2 * SHM_K + NW * 64 * 4;
#define ATT_KSWZ(row, colB) ((row) * 128 + ((colB) ^ ((((row) >> 1) & 7) << 4)))
#define ATT_SBAR() __builtin_amdgcn_sched_barrier(0)
__device__ __forceinline__ int crow(int r, int hi) { return (r & 3) + 8 * (r >> 2) + 4 * hi; }
__device__ __forceinline__ unsigned cvtpk(float lo, float hi) { unsigned r; asm volatile("v_cvt_pk_bf16_f32 %0, %1, %2" : "=v"(r) : "v"(lo), "v"(hi)); return r; }

__device__ __forceinline__ void partialSM(f32x16& p0, f32x16& p1, float& m_reg, float& mn, float& alpha) {
  constexpr float C = SCALE * 1.4426950408889634f;
  float pmax = p0[0];
#pragma unroll
  for (int r = 1; r < 16; ++r) pmax = fmaxf(pmax, p0[r]);
#pragma unroll
  for (int r = 0; r < 16; ++r) pmax = fmaxf(pmax, p1[r]);
  { auto rr = __builtin_amdgcn_permlane32_swap(__float_as_uint(pmax), __float_as_uint(pmax), false, false);
    pmax = fmaxf(__uint_as_float(rr[0]), __uint_as_float(rr[1])); }
  if (__builtin_expect(__all(pmax - m_reg <= THR / SCALE), 1)) { mn = m_reg; alpha = 1.f; }
  else { mn = fmaxf(m_reg, pmax); alpha = __builtin_amdgcn_exp2f((m_reg - mn) * C); m_reg = mn; }
  float mnC = -mn * C;
#pragma unroll
  for (int r = 0; r < 16; ++r) p0[r] = fmaf(p0[r], C, mnC);
#pragma unroll
  for (int r = 0; r < 16; ++r) p1[r] = fmaf(p1[r], C, mnC);
#pragma unroll
  for (int r = 0; r < 16; ++r) p0[r] = __builtin_amdgcn_exp2f(p0[r]);
}
__device__ __forceinline__ void finishSM(f32x16& p0, f32x16& p1, float alpha, float& l_reg, bf16x8& pa0, bf16x8& pa1, bf16x8& pa2, bf16x8& pa3) {
#pragma unroll
  for (int r = 0; r < 16; ++r) p1[r] = __builtin_amdgcn_exp2f(p1[r]);
  float ps = 0;
#pragma unroll
  for (int r = 0; r < 16; ++r) ps += p0[r];
#pragma unroll
  for (int r = 0; r < 16; ++r) ps += p1[r];
  { auto rr = __builtin_amdgcn_permlane32_swap(__float_as_uint(ps), __float_as_uint(ps), false, false);
    ps = __uint_as_float(rr[0]) + __uint_as_float(rr[1]); }
  l_reg = l_reg * alpha + ps;
#define ATT_PK4(P, BASE, OUT) do { unsigned a0 = cvtpk(P[BASE + 0], P[BASE + 1]), a1 = cvtpk(P[BASE + 2], P[BASE + 3]);   \
    unsigned b0 = cvtpk(P[BASE + 4], P[BASE + 5]), b1 = cvtpk(P[BASE + 6], P[BASE + 7]);                              \
    auto r0 = __builtin_amdgcn_permlane32_swap(a0, b0, false, false); auto r1 = __builtin_amdgcn_permlane32_swap(a1, b1, false, false); \
    u32x4 w = {r0[0], r1[0], r0[1], r1[1]}; OUT = *reinterpret_cast<bf16x8*>(&w); } while (0)
  ATT_PK4(p0, 0, pa0); ATT_PK4(p0, 8, pa1); ATT_PK4(p1, 0, pa2); ATT_PK4(p1, 8, pa3);
#undef ATT_PK4
}
__device__ __forceinline__ void qkt(f32x16& p0, f32x16& p1, const char* Ks, const bf16x8 (&qr)[4], int r32, int hi) {
  p0 = f32x16{}; p1 = f32x16{};
#pragma unroll
  for (int d0 = 0; d0 < 4; ++d0) { const int cb = (d0 * 16 + hi * 8) * 2;
    bf16x8 b0 = *reinterpret_cast<const bf16x8*>(Ks + ATT_KSWZ(r32, cb));
    bf16x8 b1 = *reinterpret_cast<const bf16x8*>(Ks + ATT_KSWZ(32 + r32, cb));
    p0 = __builtin_amdgcn_mfma_f32_32x32x16_bf16(b0, qr[d0], p0, 0, 0, 0);
    p1 = __builtin_amdgcn_mfma_f32_32x32x16_bf16(b1, qr[d0], p1, 0, 0, 0); }
}
__device__ __forceinline__ int v_st(int k, int c) { const int kk = (k & ~0xC) | ((k & 4) << 1) | ((k & 8) >> 1); return ((kk >> 3) * 4 + (c >> 5)) * 512 + ((kk & 7) * 32 + (c & 31)) * 2; }
__device__ __forceinline__ int v_rd_base(int lane) { return ((lane & 3) << 3) | (((lane >> 2) & 3) << 6) | (((lane >> 4) & 1) << 5) | (((lane >> 5) & 1) << 8); }
constexpr int v_rd_off(int d0, int ks, int half) { return d0 * 512 + ks * 4096 + half * 2048; }
template <int OFF> __device__ __forceinline__ s16x4 tr_read(int vb) {
  s16x4 r; asm volatile("ds_read_b64_tr_b16 %0, %1 offset:%2" : "=&v"(r) : "v"(vb), "i"(OFF) : "memory"); return r;
}
template <int D0> __device__ __forceinline__ void pv_one(f32x16& od, int vb, bf16x8 pa0, bf16x8 pa1, bf16x8 pa2, bf16x8 pa3) {
  const s16x4 l0 = tr_read<v_rd_off(D0, 0, 0)>(vb), h0 = tr_read<v_rd_off(D0, 0, 1)>(vb), l1 = tr_read<v_rd_off(D0, 1, 0)>(vb), h1 = tr_read<v_rd_off(D0, 1, 1)>(vb);
  const s16x4 l2 = tr_read<v_rd_off(D0, 2, 0)>(vb), h2 = tr_read<v_rd_off(D0, 2, 1)>(vb), l3 = tr_read<v_rd_off(D0, 3, 0)>(vb), h3 = tr_read<v_rd_off(D0, 3, 1)>(vb);
  asm volatile("s_waitcnt lgkmcnt(0)" ::: "memory"); ATT_SBAR();
#define ATT_PK(L, H) (bf16x8){L[0], L[1], L[2], L[3], H[0], H[1], H[2], H[3]}
  od = __builtin_amdgcn_mfma_f32_32x32x16_bf16(pa0, ATT_PK(l0, h0), od, 0, 0, 0);
  od = __builtin_amdgcn_mfma_f32_32x32x16_bf16(pa1, ATT_PK(l1, h1), od, 0, 0, 0);
  od = __builtin_amdgcn_mfma_f32_32x32x16_bf16(pa2, ATT_PK(l2, h2), od, 0, 0, 0);
  od = __builtin_amdgcn_mfma_f32_32x32x16_bf16(pa3, ATT_PK(l3, h3), od, 0, 0, 0);
#undef ATT_PK
}
__device__ __forceinline__ void pv_d0(f32x16 (&o)[4], int vb, bf16x8 pa0, bf16x8 pa1, bf16x8 pa2, bf16x8 pa3) {
  pv_one<0>(o[0], vb, pa0, pa1, pa2, pa3); pv_one<1>(o[1], vb, pa0, pa1, pa2, pa3); pv_one<2>(o[2], vb, pa0, pa1, pa2, pa3); pv_one<3>(o[3], vb, pa0, pa1, pa2, pa3);
}
__device__ __forceinline__ unsigned short f2bf(float f) { unsigned u = __builtin_bit_cast(unsigned, f); return (unsigned short)((u + 0x7fffu + ((u >> 16) & 1u)) >> 16); }

__device__ __forceinline__ void attn_unit(const unsigned short* __restrict__ Qb, const unsigned short* __restrict__ Kh, const unsigned short* __restrict__ Vh,
                                          unsigned short* __restrict__ Ob, int seq, char* lds) {
  int tid_ = threadIdx.x; asm volatile("" : "+v"(tid_));
  const int tid = tid_, wid = tid >> 6, lane = tid & 63, r32 = lane & 31, hi = lane >> 5;
  char* V_lds = lds; char* K_lds = lds + 2 * SHM_V;
  float* wsf = (float*)(lds + 2 * SHM_V + 2 * SHM_K) + wid * 64; float* li_l = wsf; float* al_l = wsf + 32;
  float m_reg = -1e30f, l_reg = 0; f32x16 o[4] = {}; bf16x8 qr[4];
  const unsigned short* Qw = Qb + (long)(wid * QBLK + r32) * ATT_LDP + hi * 8;
#pragma unroll
  for (int d0 = 0; d0 < 4; ++d0) qr[d0] = *reinterpret_cast<const bf16x8*>(Qw + d0 * 16);
  const int sr = tid >> 4, sc = (tid & 15) * 8, vst0 = v_st(sr, sc), vst1 = v_st(32 + sr, sc);
  const int kr = tid >> 3, kc = (tid & 7) * 8, kst = ATT_KSWZ(kr, kc * 2);
  const int vb0 = (int)(uintptr_t)V_lds + v_rd_base(lane);
  bf16x8 s_vs0[2], s_vs1[2], s_ks[2];
#define ATT_SLOAD(i, k0) do { s_vs0[i] = *reinterpret_cast<const bf16x8*>(&Vh[(long)((k0) + sr) * ATT_LDP + sc]); s_vs1[i] = *reinterpret_cast<const bf16x8*>(&Vh[(long)((k0) + 32 + sr) * ATT_LDP + sc]); \
    s_ks[i] = *reinterpret_cast<const bf16x8*>(&Kh[(long)((k0) + kr) * ATT_LDP + kc]); } while (0)
#define ATT_SWRITE(b, i) do { *(bf16x8*)(V_lds + (b) * SHM_V + vst0) = s_vs0[i]; *(bf16x8*)(V_lds + (b) * SHM_V + vst1) = s_vs1[i]; \
    *(bf16x8*)(K_lds + (b) * SHM_K + kst) = s_ks[i]; } while (0)
#define ATT_SWAIT() asm volatile("s_waitcnt vmcnt(3)" ::: "memory")
#define ATT_RESC(a) do { if (__any((a) < 1.f)) { if (hi == 0) al_l[r32] = (a); asm volatile("s_waitcnt lgkmcnt(0)" ::: "memory"); \
    _Pragma("unroll") for (int d = 0; d < 4; ++d) _Pragma("unroll") for (int r = 0; r < 16; ++r) o[d][r] *= al_l[crow(r, hi)]; } } while (0)
  f32x16 pA0, pA1, pB0, pB1; float mnA, mnB, alA, alB; bf16x8 pa0, pa1, pa2, pa3; const int NT = seq / KVBLK;
  ATT_SLOAD(0, 0); asm volatile("s_waitcnt vmcnt(0)" ::: "memory"); ATT_SWRITE(0, 0); __syncthreads();
  qkt(pA0, pA1, K_lds, qr, r32, hi); partialSM(pA0, pA1, m_reg, mnA, alA);
  ATT_SLOAD(1, KVBLK); if (2 < NT) ATT_SLOAD(0, 2 * KVBLK);
  ATT_SWAIT(); ATT_SWRITE(1, 1); __syncthreads();
  for (int j = 1; j + 1 < NT; j += 2) {
    ATT_SBAR(); qkt(pB0, pB1, K_lds + SHM_K, qr, r32, hi);
    finishSM(pA0, pA1, alA, l_reg, pa0, pa1, pa2, pa3); ATT_SBAR();
    ATT_SLOAD(1, (j + 2) * KVBLK); ATT_SBAR();
    pv_d0(o, vb0, pa0, pa1, pa2, pa3); partialSM(pB0, pB1, m_reg, mnB, alB);
    __syncthreads(); ATT_SWAIT(); ATT_SWRITE(0, 0);
    ATT_RESC(alB); __syncthreads();
    ATT_SBAR(); qkt(pA0, pA1, K_lds, qr, r32, hi);
    finishSM(pB0, pB1, alB, l_reg, pa0, pa1, pa2, pa3); ATT_SBAR();
    if (j + 3 < NT) ATT_SLOAD(0, (j + 3) * KVBLK); ATT_SBAR();
    pv_d0(o, vb0 + SHM_V, pa0, pa1, pa2, pa3); partialSM(pA0, pA1, m_reg, mnA, alA);
    __syncthreads(); ATT_SWAIT(); ATT_SWRITE(1, 1);
    ATT_RESC(alA); __syncthreads();
  }
  ATT_SBAR(); qkt(pB0, pB1, K_lds + SHM_K, qr, r32, hi);
  finishSM(pA0, pA1, alA, l_reg, pa0, pa1, pa2, pa3); ATT_SBAR();
  pv_d0(o, vb0, pa0, pa1, pa2, pa3); partialSM(pB0, pB1, m_reg, mnB, alB);
  __syncthreads(); ATT_RESC(alB);
  finishSM(pB0, pB1, alB, l_reg, pa0, pa1, pa2, pa3); ATT_SBAR();
  pv_d0(o, vb0 + SHM_V, pa0, pa1, pa2, pa3);
  if (hi == 0) li_l[r32] = l_reg; asm volatile("s_waitcnt lgkmcnt(0)" ::: "memory");
  float rli[16];
#pragma unroll
  for (int r = 0; r < 16; ++r) rli[r] = __builtin_amdgcn_rcpf(li_l[crow(r, hi)]);
  unsigned short* Ow = Ob + (long)(wid * QBLK) * ATT_LDO;
#pragma unroll
  for (int r = 0; r < 16; ++r) { const int orow = crow(r, hi);
#pragma unroll
    for (int d0 = 0; d0 < 4; ++d0) Ow[(long)orow * ATT_LDO + d0 * 32 + r32] = f2bf(o[d0][r] * rli[r]); }
#undef ATT_SLOAD
#undef ATT_SWRITE
#undef ATT_SWAIT
#undef ATT_RESC
}
}

constexpr int NWAVES = 8;
constexpr int D = 2048, BATCH = 16, SEQ = 2048, DEPTH = 4, M = BATCH * SEQ;
constexpr int DFF = 5504, NGU = 2 * DFF, DIN = 8192;
constexpr int C_HGQ = 0, C_HGI = 1024, C_HGZF = 2048, C_HGZB = 3072, C_HGG = 4096, C_DAQ = 5120, C_DAK = 5632, C_DAV = 6144, C_SCB = 6656, C_SCC = 7168, C_SCU = 7680;
constexpr float EPS = 1e-6f;
enum { I_X = 0, I_POS, I_F1N, I_F1G, I_F1U, I_F1D, I_MIXN, I_WIN, I_LB, I_HGN, I_DAQN, I_DAKN, I_LQ1, I_LK1, I_LQ2, I_LK2, I_DAON, I_CW, I_CB, I_CN, I_WOUT, I_F2N, I_F2G, I_F2U, I_F2D, N_IN };

constexpr size_t MiB = 1u << 20;
constexpr size_t WS_CTL = 0, CTL_ZERO_BYTES = 5 * MiB;
constexpr size_t WS_ROWSQ = 1 * MiB;
constexpr size_t WS_SMALL = 5 * MiB;
constexpr size_t WS_ROPE = 6 * MiB;
constexpr size_t SZ_WGU = (size_t)NGU * D * 2, SZ_WD = (size_t)D * DFF * 2, SZ_WIN = (size_t)DIN * D * 2, SZ_WOUT = (size_t)D * D * 2;
constexpr size_t WS_WGU = 14 * MiB;
constexpr size_t WS_WD = WS_WGU + 8 * SZ_WGU;
constexpr size_t WS_WIN = WS_WD + 8 * SZ_WD;
constexpr size_t WS_WOUT = WS_WIN + 4 * SZ_WIN;
constexpr size_t WS_H = WS_WOUT + 4 * SZ_WOUT;
constexpr size_t WS_P = WS_H + (size_t)M * D * 2;
constexpr size_t WS_OF = WS_P + (size_t)M * DIN * 2;
constexpr size_t WS_OA = WS_OF + (size_t)2 * M * 1024 * 2;
constexpr size_t WS_END = WS_OA + (size_t)M * 1024 * 2;
static_assert(WS_WGU % 256 == 0 && WS_WD % 256 == 0 && WS_WIN % 256 == 0 && WS_H % 256 == 0 && WS_P % 256 == 0 && WS_OF % 256 == 0 && WS_OA % 256 == 0, "ws alignment");
static_assert(WS_ROWSQ + (size_t)13 * M * 4 <= CTL_ZERO_BYTES, "rowsq slots inside the per-call memset");
constexpr int CW_BAR = 4096;

constexpr int RING_OFF = 0, RING_BYTES = 131072;
constexpr int LDSCTL_OFF = RING_BYTES, MISC_OFF = LDSCTL_OFF + 320;
constexpr int LDS_BYTES = 147456;
static_assert(MISC_OFF + 128 <= LDS_BYTES, "LDS map");

typedef unsigned v2u __attribute__((ext_vector_type(2)));
typedef float f32x2 __attribute__((ext_vector_type(2)));
__device__ __forceinline__ float wave_sum(float v) {
#pragma unroll
    for (int o = 1; o < 64; o <<= 1) v += __shfl_xor(v, o);
    return v;
}
__device__ __forceinline__ float bflo(unsigned w) { return __builtin_bit_cast(float, w << 16); }
__device__ __forceinline__ float bfhi(unsigned w) { return __builtin_bit_cast(float, w & 0xffff0000u); }
__device__ __forceinline__ void unpack8(const v4u w, float (&x)[8]) { x[0] = bflo(w.x); x[1] = bfhi(w.x); x[2] = bflo(w.y); x[3] = bfhi(w.y); x[4] = bflo(w.z); x[5] = bfhi(w.z); x[6] = bflo(w.w); x[7] = bfhi(w.w); }
__device__ __forceinline__ v4u pack8(const float (&x)[8]) { v4u w; w.x = pg8::cvt_pk_bf16(x[0], x[1]); w.y = pg8::cvt_pk_bf16(x[2], x[3]); w.z = pg8::cvt_pk_bf16(x[4], x[5]); w.w = pg8::cvt_pk_bf16(x[6], x[7]); return w; }

__constant__ double c_inv_freq[32] = {1.0, 0.7498942093324559, 0.5623413251903491, 0.4216965034285822, 0.31622776601683794, 0.23713737056616552, 0.1778279410038923, 0.1333521432163324, 0.1, 0.07498942093324558, 0.05623413251903491,
    0.042169650342858224, 0.03162277660168379, 0.023713737056616554, 0.01778279410038923, 0.01333521432163324, 0.01, 0.007498942093324558, 0.005623413251903491, 0.004216965034285823, 0.0031622776601683794, 0.0023713737056616554,
    0.0017782794100389228, 0.001333521432163324, 0.001, 0.0007498942093324559, 0.0005623413251903491, 0.00042169650342858224, 0.00031622776601683794, 0.00023713737056616554, 0.00017782794100389227, 0.0001333521432163324};
__constant__ float c_lam_init[4] = {0.20000000000000007f, 0.35550906759096934f, 0.4707130183435842f, 0.5560582041556406f};

__device__ __forceinline__ void p0_transpose_item(const float* W, int K, int N, bf16* WT, int gu, const float* gain, LAS float* scr, int item, int lane) {
    const int nblk = N / 32, kb = item / nblk, nb = item % nblk, k0 = 64 * kb, n0 = 32 * nb;
#pragma unroll
    for (int i = 0; i < 8; ++i) { const int kk = 8 * i + (lane >> 3), n4 = (lane & 7) * 4;
        f32x4 v = *(const GAS f32x4*)(W + (size_t)(k0 + kk) * N + n0 + n4); if (gain) v = v * gain[k0 + kk];
        LAS float* d = scr + kk * 33 + n4; d[0] = v.x; d[1] = v.y; d[2] = v.z; d[3] = v.w; }
    LDS_WAIT(); asm volatile("" ::: "memory");
    const int c = lane & 7;
#pragma unroll
    for (int j = 0; j < 4; ++j) { const int n = (lane >> 3) + 8 * j; const LAS float* s = scr + (8 * c) * 33 + n;
        v4u o; o.x = pg8::cvt_pk_bf16(s[0 * 33], s[1 * 33]); o.y = pg8::cvt_pk_bf16(s[2 * 33], s[3 * 33]); o.z = pg8::cvt_pk_bf16(s[4 * 33], s[5 * 33]); o.w = pg8::cvt_pk_bf16(s[6 * 33], s[7 * 33]);
        const int ns = n0 + n; const int dr = gu ? ((ns >> 7) * 256 + (gu - 1) * 128 + (ns & 127)) : ns;
        *(GAS v4u*)(WT + (size_t)dr * K + k0 + 8 * c) = o; }
    LDS_WAIT(); asm volatile("" ::: "memory");
}

__device__ __forceinline__ void xcopy_phase(const float* x, bf16* XB, unsigned* rowsq, int gw, int NGW, int lane) {
    for (int m = gw; m < M; m += NGW) {
        const GAS f32x4* xr = (const GAS f32x4*)(x + (size_t)m * D) + lane;
        f32x4 v[8]; float s = 0.f;
#pragma unroll
        for (int j = 0; j < 8; ++j) { v[j] = xr[64 * j]; s += (v[j].x * v[j].x + v[j].y * v[j].y) + (v[j].z * v[j].z + v[j].w * v[j].w); }
        s = wave_sum(s);
        GAS v2u* o8 = (GAS v2u*)(XB + (size_t)m * D) + lane;
#pragma unroll
        for (int j = 0; j < 8; ++j) { v2u w; w.x = pg8::cvt_pk_bf16(v[j].x, v[j].y); w.y = pg8::cvt_pk_bf16(v[j].z, v[j].w); o8[64 * j] = w; }
        if (lane == 0) rowsq[m] = (unsigned)(s * pg8::RSQ_SCALE);
    }
}

__device__ __forceinline__ void prep_phase(bf16* P, const float* cosT, const float* sinT, const float* qg, const float* kg, int gw, int NGW, int lane) {
    const int grp = lane >> 2, sub = lane & 3;
    float ga1[8], ga2[8];
    { const float* gp = (grp < 8 ? qg : kg);
#pragma unroll
      for (int e = 0; e < 8; ++e) { ga1[e] = gp[sub * 8 + e]; ga2[e] = gp[32 + sub * 8 + e]; } }
    for (int m = gw; m < M; m += NGW) {
        bf16* row = P + (size_t)m * DIN;
        bf16* p1 = row + C_DAQ + grp * 64 + sub * 8; bf16* p2 = p1 + 32;
        const v4u a = *(const GAS v4u*)p1, b = *(const GAS v4u*)p2;
        const GAS f32x4* cp = (const GAS f32x4*)(cosT + (size_t)m * 32 + sub * 8); const GAS f32x4* sp = (const GAS f32x4*)(sinT + (size_t)m * 32 + sub * 8);
        const f32x4 cA = cp[0], cB = cp[1], sA = sp[0], sB = sp[1];
        float x1[8], x2[8]; unpack8(a, x1); unpack8(b, x2);
        float ss = 0.f;
#pragma unroll
        for (int e = 0; e < 8; ++e) ss += x1[e] * x1[e] + x2[e] * x2[e];
        ss += __shfl_xor(ss, 1); ss += __shfl_xor(ss, 2);
        const float rstd = 1.0f / sqrtf(ss * (1.0f / 64.0f) + EPS);
        const float cs[8] = {cA.x, cA.y, cA.z, cA.w, cB.x, cB.y, cB.z, cB.w}, sn[8] = {sA.x, sA.y, sA.z, sA.w, sB.x, sB.y, sB.z, sB.w};
        float o1[8], o2[8];
#pragma unroll
        for (int e = 0; e < 8; ++e) { const float y1 = x1[e] * rstd * ga1[e], y2 = x2[e] * rstd * ga2[e]; o1[e] = y1 * cs[e] - y2 * sn[e]; o2[e] = y2 * cs[e] + y1 * sn[e]; }
        *(GAS v4u*)p1 = pack8(o1); *(GAS v4u*)p2 = pack8(o2);
    }
}

__device__ __forceinline__ void combine_phase(const bf16* P, const bf16* OA, bf16* Y, const float* hgn, const float* daon, const float* lq1, const float* lk1, const float* lq2, const float* lk2, float lam_init,
                                              const float* cw, const float* cb, const float* cn, int gw, int NGW, int lane) {
    const float d1 = wave_sum(lq1[lane] * lk1[lane]), d2 = wave_sum(lq2[lane] * lk2[lane]);
    const float lam = expf(d1) - expf(d2) + lam_init;
    const int ca = lane * 16, c8 = lane * 8;
    const int head = lane >> 4, v0 = (lane & 15) * 8;
    float ga[16], gb[8], w0[8], w1[8], w2[8], bb[8], gn[8];
#pragma unroll
    for (int e = 0; e < 16; ++e) ga[e] = hgn[ca + e];
#pragma unroll
    for (int e = 0; e < 8; ++e) { gb[e] = daon[c8 + e] * (1.0f - lam_init); w0[e] = cw[c8 + e]; w1[e] = cw[512 + c8 + e]; w2[e] = cw[1024 + c8 + e]; bb[e] = cb[c8 + e]; gn[e] = cn[c8 + e]; }
    for (int m = gw; m < M; m += NGW) {
        const int s = m & (SEQ - 1);
        const bf16* row = P + (size_t)m * DIN;
        const bf16* rowp = (s > 0) ? row - DIN : row; const bf16* rown = (s < SEQ - 1) ? row + DIN : row;
        const float fp = (s > 0) ? 1.f : 0.f, fn = (s < SEQ - 1) ? 1.f : 0.f;
        const bf16* f0 = row + C_HGZF + ca; const bf16* f1 = row + C_HGZB + ca; const bf16* gp = row + C_HGG + ca;
        const bf16* ap = OA + (size_t)m * 1024 + head * 256 + v0;
        const v4u L0 = *(const GAS v4u*)f0, L1 = *(const GAS v4u*)(f0 + 8), L2 = *(const GAS v4u*)f1, L3 = *(const GAS v4u*)(f1 + 8), L4 = *(const GAS v4u*)gp, L5 = *(const GAS v4u*)(gp + 8);
        const v4u L6 = *(const GAS v4u*)ap, L7 = *(const GAS v4u*)(ap + 128);
        const v4u L8 = *(const GAS v4u*)(row + C_SCC + c8), L9 = *(const GAS v4u*)(row + C_SCU + c8), L10 = *(const GAS v4u*)(rowp + C_SCC + c8), L11 = *(const GAS v4u*)(rowp + C_SCU + c8);
        const v4u L12 = *(const GAS v4u*)(rown + C_SCC + c8), L13 = *(const GAS v4u*)(rown + C_SCU + c8), L14 = *(const GAS v4u*)(row + C_SCB + c8);
        {
            float a[16], b[16], g[16]; float t[8];
            unpack8(L0, t);
#pragma unroll
            for (int e = 0; e < 8; ++e) a[e] = t[e];
            unpack8(L1, t);
#pragma unroll
            for (int e = 0; e < 8; ++e) a[8 + e] = t[e];
            unpack8(L2, t);
#pragma unroll
            for (int e = 0; e < 8; ++e) b[e] = t[e];
            unpack8(L3, t);
#pragma unroll
            for (int e = 0; e < 8; ++e) b[8 + e] = t[e];
            unpack8(L4, t);
#pragma unroll
            for (int e = 0; e < 8; ++e) g[e] = t[e];
            unpack8(L5, t);
#pragma unroll
            for (int e = 0; e < 8; ++e) g[8 + e] = t[e];
            float ss = 0.f;
#pragma unroll
            for (int e = 0; e < 16; ++e) { a[e] += b[e]; ss += a[e] * a[e]; }
            ss += __shfl_xor(ss, 1); ss += __shfl_xor(ss, 2); ss += __shfl_xor(ss, 4);
            const float rstd = 1.0f / sqrtf(ss * (1.0f / 128.0f) + EPS);
            float o0[8], o1[8];
#pragma unroll
            for (int e = 0; e < 8; ++e) { const float g0 = g[e], g1 = g[8 + e];
                o0[e] = a[e] * rstd * ga[e] * (g0 * __builtin_amdgcn_rcpf(1.0f + __expf(-g0))); o1[e] = a[8 + e] * rstd * ga[8 + e] * (g1 * __builtin_amdgcn_rcpf(1.0f + __expf(-g1))); }
            GAS v4u* yp = (GAS v4u*)(Y + (size_t)m * D + ca); yp[0] = pack8(o0); yp[1] = pack8(o1);
        }
        {
            float a0[8], a1[8]; unpack8(L6, a0); unpack8(L7, a1);
            float ss = 0.f;
#pragma unroll
            for (int e = 0; e < 8; ++e) { a0[e] = a0[e] - lam * a1[e]; ss += a0[e] * a0[e]; }
            ss += __shfl_xor(ss, 1); ss += __shfl_xor(ss, 2); ss += __shfl_xor(ss, 4); ss += __shfl_xor(ss, 8);
            const float rstd = 1.0f / sqrtf(ss * (1.0f / 128.0f) + EPS);
#pragma unroll
            for (int e = 0; e < 8; ++e) a0[e] = a0[e] * rstd * gb[e];
            *(GAS v4u*)(Y + (size_t)m * D + 1024 + c8) = pack8(a0);
        }
        {
            float cc[8], uc[8], cpv[8], upv[8], cnx[8], unx[8], bg[8];
            unpack8(L8, cc); unpack8(L9, uc); unpack8(L10, cpv); unpack8(L11, upv); unpack8(L12, cnx); unpack8(L13, unx); unpack8(L14, bg);
            float y[8]; float ss = 0.f;
#pragma unroll
            for (int e = 0; e < 8; ++e) { y[e] = (bb[e] + w0[e] * (cpv[e] * upv[e] * fp) + w1[e] * (cc[e] * uc[e]) + w2[e] * (cnx[e] * unx[e] * fn)) * bg[e]; ss += y[e] * y[e]; }
            ss += __shfl_xor(ss, 1); ss += __shfl_xor(ss, 2); ss += __shfl_xor(ss, 4); ss += __shfl_xor(ss, 8);
            const float rstd = 1.0f / sqrtf(ss * (1.0f / 128.0f) + EPS);
#pragma unroll
            for (int e = 0; e < 8; ++e) y[e] = y[e] * rstd * gn[e];
            *(GAS v4u*)(Y + (size_t)m * D + 1536 + c8) = pack8(y);
        }
    }
}

__device__ __forceinline__ void scan_unit_v1(const bf16* P, const float* lbt, bf16* OFd, int b, int h, int dir, LAS unsigned char* ldsb, int tid) {
    LAS float* Fs = (LAS float*)ldsb; LAS float* Ks = Fs + 4096; LAS float* Qs = Ks + 4096; LAS float* Vs = Qs + 4096; LAS float* Os = Vs + 4096;
    const int lane = tid & 63, wv = tid >> 6, v = wv * 16 + (lane & 15), kq = lane >> 4;
    const int tok = tid >> 4, ch0 = (tid & 15) * 8;
    float lbv[8];
#pragma unroll
    for (int e = 0; e < 8; ++e) lbv[e] = lbt[h * 128 + ch0 + e];
    float S[32];
#pragma unroll
    for (int j = 0; j < 32; ++j) S[j] = 0.f;
    const int zc = (dir ? C_HGZB : C_HGZF) + h * 128 + ch0;
    for (int blk = 0; blk < SEQ / 32; ++blk) {
        const int tau = blk * 32 + tok, s = dir ? (SEQ - 1 - tau) : tau; const size_t m = (size_t)b * SEQ + s;
        const bf16* row = P + m * DIN;
        { float q[8], iv[8], z[8], f[8], kk[8];
          unpack8(*(const GAS v4u*)(row + C_HGQ + h * 128 + ch0), q); unpack8(*(const GAS v4u*)(row + C_HGI + h * 128 + ch0), iv); unpack8(*(const GAS v4u*)(row + zc), z);
#pragma unroll
          for (int e = 0; e < 8; ++e) { const float ex = __expf(-z[e]); const float sg = 1.0f / (1.0f + ex); const float om = 1.0f - lbv[e]; f[e] = lbv[e] + om * sg; kk[e] = om * (ex * sg); }
          LAS f32x4* d;
          d = (LAS f32x4*)(Fs + tok * 128 + ch0); d[0] = (f32x4){f[0], f[1], f[2], f[3]}; d[1] = (f32x4){f[4], f[5], f[6], f[7]};
          d = (LAS f32x4*)(Ks + tok * 128 + ch0); d[0] = (f32x4){kk[0], kk[1], kk[2], kk[3]}; d[1] = (f32x4){kk[4], kk[5], kk[6], kk[7]};
          d = (LAS f32x4*)(Qs + tok * 128 + ch0); d[0] = (f32x4){q[0], q[1], q[2], q[3]}; d[1] = (f32x4){q[4], q[5], q[6], q[7]};
          d = (LAS f32x4*)(Vs + tok * 128 + ch0); d[0] = (f32x4){iv[0], iv[1], iv[2], iv[3]}; d[1] = (f32x4){iv[4], iv[5], iv[6], iv[7]}; }
        __syncthreads();
#pragma unroll 1
        for (int t = 0; t < 32; ++t) {
            const float vv = Vs[t * 128 + v]; float acc = 0.f;
            const LAS f32x4* fp = (const LAS f32x4*)(Fs + t * 128 + kq * 32); const LAS f32x4* kp = (const LAS f32x4*)(Ks + t * 128 + kq * 32); const LAS f32x4* qp = (const LAS f32x4*)(Qs + t * 128 + kq * 32);
#pragma unroll
            for (int j4 = 0; j4 < 8; ++j4) { const f32x4 f4 = fp[j4], k4 = kp[j4], q4 = qp[j4];
                S[4 * j4 + 0] = f4.x * S[4 * j4 + 0] + k4.x * vv; acc += S[4 * j4 + 0] * q4.x;
                S[4 * j4 + 1] = f4.y * S[4 * j4 + 1] + k4.y * vv; acc += S[4 * j4 + 1] * q4.y;
                S[4 * j4 + 2] = f4.z * S[4 * j4 + 2] + k4.z * vv; acc += S[4 * j4 + 2] * q4.z;
                S[4 * j4 + 3] = f4.w * S[4 * j4 + 3] + k4.w * vv; acc += S[4 * j4 + 3] * q4.w; }
            acc += __shfl_xor(acc, 16); acc += __shfl_xor(acc, 32);
            if (kq == 0) Os[t * 128 + v] = acc;
        }
        __syncthreads();
        { const LAS f32x4* op = (const LAS f32x4*)(Os + tok * 128 + ch0); const f32x4 oA = op[0], oB = op[1];
          const float o8[8] = {oA.x, oA.y, oA.z, oA.w, oB.x, oB.y, oB.z, oB.w};
          *(GAS v4u*)(OFd + m * 1024 + h * 128 + ch0) = pack8(o8); }
    }
    __syncthreads();
}


namespace sc2 {
typedef short bf16x8 __attribute__((ext_vector_type(8)));
typedef float f32x4 __attribute__((ext_vector_type(4)));
typedef float f32x2 __attribute__((ext_vector_type(2)));
typedef unsigned u32x2 __attribute__((ext_vector_type(2)));
typedef unsigned u32x4 __attribute__((ext_vector_type(4)));
constexpr int CH = 32;
constexpr int RS_RAW = 256;
constexpr int O_RZ = 0, O_RQ = 8192, O_RV = 16384, O_TOT = 24576;
constexpr int RS_QI = 272;
constexpr int O_QI = 28672, O_KI = O_QI + 32 * RS_QI;
constexpr int RS_T = 80;
constexpr int O_KHT = O_KI + 32 * RS_QI, O_VT = O_KHT + 128 * RS_T;
constexpr int O_DK = O_VT + 128 * RS_T;
constexpr int RS_OB = 528;
constexpr int O_OB = O_DK + 512;
constexpr int LDS_END = O_OB + 32 * RS_OB;
static_assert(LDS_END <= 131072 && O_QI % 16 == 0 && O_KHT % 16 == 0 && O_DK % 16 == 0 && O_OB % 16 == 0, "scan LDS map");
typedef __bf16 bf16v2 __attribute__((ext_vector_type(2)));
__device__ __forceinline__ unsigned pk(float lo, float hi) { const f32x2 v = {lo, hi}; return __builtin_bit_cast(unsigned, __builtin_convertvector(v, bf16v2)); }
__device__ __forceinline__ bf16x8 mk8(u32x2 a, u32x2 b) { u32x4 w = {a.x, a.y, b.x, b.y}; return __builtin_bit_cast(bf16x8, w); }
#define SC2_MFMA(a, b, c) __builtin_amdgcn_mfma_f32_16x16x32_bf16((a), (b), (c), 0, 0, 0)

__device__ __forceinline__ void scan_unit(unsigned short* P, const float* lbt, int b, int h, int dir, LAS unsigned char* L, int tid_in) {
    int tid = tid_in; asm volatile("" : "+v"(tid));
    const int lane = tid & 63, w = __builtin_amdgcn_readfirstlane(tid >> 6), c16 = lane & 15, g = lane >> 4;
    const int tok = tid >> 4, ch0 = (tid & 15) * 8;
    const int kp = lane;
    const float lb0 = lbt[h * 128 + 2 * kp], lb1 = lbt[h * 128 + 2 * kp + 1];
    const float om0 = 1.0f - lb0, om1 = 1.0f - lb1;
    const int zc = (dir ? C_HGZB : C_HGZF) + h * 128 + ch0;
    f32x4 S[8];
#pragma unroll
    for (int i = 0; i < 8; ++i) S[i] = (f32x4){0.f, 0.f, 0.f, 0.f};
    v4u rq, rz, rv;
    { const int s = dir ? (SEQ - 1 - tok) : tok; const unsigned short* row = P + ((size_t)b * SEQ + s) * DIN;
      rq = *(const GAS v4u*)(row + C_HGQ + h * 128 + ch0); rv = *(const GAS v4u*)(row + C_HGI + h * 128 + ch0); rz = *(const GAS v4u*)(row + zc); }
    *(LAS v4u*)(L + O_RQ + tok * RS_RAW + ch0 * 2) = rq; *(LAS v4u*)(L + O_RV + tok * RS_RAW + ch0 * 2) = rv; *(LAS v4u*)(L + O_RZ + tok * RS_RAW + ch0 * 2) = rz;
    __syncthreads();
#pragma unroll 1
    for (int c = 0; c < SEQ / CH; ++c) {
        if (c > 0) { const int tau = (c - 1) * CH + tok, s = dir ? (SEQ - 1 - tau) : tau;
            const LAS f32x4* op = (const LAS f32x4*)(L + O_OB + tok * RS_OB + ch0 * 4); const f32x4 oA = op[0], oB = op[1];
            v4u o; o.x = pk(oA.x, oA.y); o.y = pk(oA.z, oA.w); o.z = pk(oB.x, oB.y); o.w = pk(oB.z, oB.w);
            *(GAS v4u*)(P + ((size_t)b * SEQ + s) * DIN + zc) = o; }
        if (c + 1 < SEQ / CH) { const int tau = (c + 1) * CH + tok, s = dir ? (SEQ - 1 - tau) : tau; const unsigned short* row = P + ((size_t)b * SEQ + s) * DIN;
            rq = *(const GAS v4u*)(row + C_HGQ + h * 128 + ch0); rv = *(const GAS v4u*)(row + C_HGI + h * 128 + ch0); rz = *(const GAS v4u*)(row + zc); }
        float c0[4], c1[4], kk0[4], kk1[4];
        { float a0 = 0.f, a1 = 0.f;
#pragma unroll
          for (int i = 0; i < 4; ++i) { const unsigned zw = *(const LAS unsigned*)(L + O_RZ + (4 * w + i) * RS_RAW + kp * 4);
              const float z0 = fminf(fmaxf(bflo(zw), -30.f), 30.f), z1 = fminf(fmaxf(bfhi(zw), -30.f), 30.f);
              const float e0 = __expf(-z0), e1 = __expf(-z1); const float s0 = __builtin_amdgcn_rcpf(1.0f + e0), s1 = __builtin_amdgcn_rcpf(1.0f + e1);
              const float f0 = lb0 + om0 * s0, f1 = lb1 + om1 * s1; kk0[i] = om0 * (e0 * s0); kk1[i] = om1 * (e1 * s1);
              a0 += __logf(f0); a1 += __logf(f1); c0[i] = a0; c1[i] = a1; }
          *(LAS f32x2*)(L + O_TOT + (w * 128 + 2 * kp) * 4) = (f32x2){a0, a1}; }
        __syncthreads();
        { float off0 = 0.f, off1 = 0.f, end0 = 0.f, end1 = 0.f;
#pragma unroll
          for (int ww = 0; ww < 8; ++ww) { const f32x2 t = *(const LAS f32x2*)(L + O_TOT + (ww * 128 + 2 * kp) * 4); end0 += t.x; end1 += t.y; if (ww < w) { off0 += t.x; off1 += t.y; } }
          float kh0[4], kh1[4]; unsigned vw[4];
#pragma unroll
          for (int i = 0; i < 4; ++i) { const int tau = 4 * w + i;
              const unsigned qw = *(const LAS unsigned*)(L + O_RQ + tau * RS_RAW + kp * 4); vw[i] = *(const LAS unsigned*)(L + O_RV + tau * RS_RAW + kp * 4);
              const float cu0 = off0 + c0[i], cu1 = off1 + c1[i];
              const float eq0 = __expf(cu0), eq1 = __expf(cu1), ek0 = __expf(fminf(-cu0, 60.f)), ek1 = __expf(fminf(-cu1, 60.f));
              kh0[i] = kk0[i] * __expf(end0 - cu0); kh1[i] = kk1[i] * __expf(end1 - cu1);
              *(LAS unsigned*)(L + O_QI + tau * RS_QI + kp * 4) = pk(bflo(qw) * eq0, bfhi(qw) * eq1);
              *(LAS unsigned*)(L + O_KI + tau * RS_QI + kp * 4) = pk(kk0[i] * ek0, kk1[i] * ek1); }
          *(LAS u32x2*)(L + O_KHT + (2 * kp) * RS_T + 8 * w) = (u32x2){pk(kh0[0], kh0[1]), pk(kh0[2], kh0[3])};
          *(LAS u32x2*)(L + O_KHT + (2 * kp + 1) * RS_T + 8 * w) = (u32x2){pk(kh1[0], kh1[1]), pk(kh1[2], kh1[3])};
          *(LAS u32x2*)(L + O_VT + (2 * kp) * RS_T + 8 * w) = (u32x2){(vw[0] & 0xffffu) | (vw[1] << 16), (vw[2] & 0xffffu) | (vw[3] << 16)};
          *(LAS u32x2*)(L + O_VT + (2 * kp + 1) * RS_T + 8 * w) = (u32x2){(vw[0] >> 16) | (vw[1] & 0xffff0000u), (vw[2] >> 16) | (vw[3] & 0xffff0000u)};
          if (w == 0) *(LAS f32x2*)(L + O_DK + 2 * kp * 4) = (f32x2){__expf(end0), __expf(end1)}; }
        __syncthreads();
        { const bf16x8 vf = mk8(*(const LAS u32x2*)(L + O_VT + (16 * w + c16) * RS_T + 8 * g), *(const LAS u32x2*)(L + O_VT + (16 * w + c16) * RS_T + 32 + 8 * g));
          bf16x8 qf[2][4], kf[2][4];
#pragma unroll
          for (int tb = 0; tb < 2; ++tb)
#pragma unroll
              for (int ks = 0; ks < 4; ++ks) { const int ro = (16 * tb + c16) * RS_QI + (32 * ks + 4 * g) * 2;
                  qf[tb][ks] = mk8(*(const LAS u32x2*)(L + O_QI + ro), *(const LAS u32x2*)(L + O_QI + ro + 32));
                  kf[tb][ks] = mk8(*(const LAS u32x2*)(L + O_KI + ro), *(const LAS u32x2*)(L + O_KI + ro + 32)); }
          f32x4 p00 = {0.f, 0.f, 0.f, 0.f}, p01 = p00, p11 = p00;
#pragma unroll
          for (int ks = 0; ks < 4; ++ks) { p00 = SC2_MFMA(kf[0][ks], qf[0][ks], p00); p01 = SC2_MFMA(kf[0][ks], qf[1][ks], p01); p11 = SC2_MFMA(kf[1][ks], qf[1][ks], p11); }
#pragma unroll
          for (int r = 0; r < 4; ++r) { const bool keep = (4 * g + r) <= c16; p00[r] = keep ? p00[r] : 0.f; p11[r] = keep ? p11[r] : 0.f; }
          const bf16x8 pa0 = mk8((u32x2){pk(p00[0], p00[1]), pk(p00[2], p00[3])}, (u32x2){0u, 0u});
          const bf16x8 pa1 = mk8((u32x2){pk(p01[0], p01[1]), pk(p01[2], p01[3])}, (u32x2){pk(p11[0], p11[1]), pk(p11[2], p11[3])});
          f32x4 o0 = {0.f, 0.f, 0.f, 0.f}, o1 = o0;
          o0 = SC2_MFMA(pa0, vf, o0); o1 = SC2_MFMA(pa1, vf, o1);
#pragma unroll
          for (int ks = 0; ks < 4; ++ks) { const bf16x8 sf = mk8((u32x2){pk(S[2 * ks][0], S[2 * ks][1]), pk(S[2 * ks][2], S[2 * ks][3])}, (u32x2){pk(S[2 * ks + 1][0], S[2 * ks + 1][1]), pk(S[2 * ks + 1][2], S[2 * ks + 1][3])});
              o0 = SC2_MFMA(qf[0][ks], sf, o0); o1 = SC2_MFMA(qf[1][ks], sf, o1); }
#pragma unroll
          for (int kb = 0; kb < 8; ++kb) { const int ro = (16 * kb + c16) * RS_T + 8 * g;
              const bf16x8 hf = mk8(*(const LAS u32x2*)(L + O_KHT + ro), *(const LAS u32x2*)(L + O_KHT + ro + 32));
              const f32x4 dv = *(const LAS f32x4*)(L + O_DK + (16 * kb + 4 * g) * 4);
              S[kb] = S[kb] * dv; S[kb] = SC2_MFMA(hf, vf, S[kb]); }
#pragma unroll
          for (int r = 0; r < 4; ++r) { *(LAS float*)(L + O_OB + (4 * g + r) * RS_OB + (16 * w + c16) * 4) = o0[r]; *(LAS float*)(L + O_OB + (16 + 4 * g + r) * RS_OB + (16 * w + c16) * 4) = o1[r]; } }
        if (c + 1 < SEQ / CH) { *(LAS v4u*)(L + O_RQ + tok * RS_RAW + ch0 * 2) = rq; *(LAS v4u*)(L + O_RV + tok * RS_RAW + ch0 * 2) = rv; *(LAS v4u*)(L + O_RZ + tok * RS_RAW + ch0 * 2) = rz; }
        __syncthreads();
    }
    { const int tau = (SEQ / CH - 1) * CH + tok, s = dir ? (SEQ - 1 - tau) : tau;
      const LAS f32x4* op = (const LAS f32x4*)(L + O_OB + tok * RS_OB + ch0 * 4); const f32x4 oA = op[0], oB = op[1];
      v4u o; o.x = pk(oA.x, oA.y); o.y = pk(oA.z, oA.w); o.z = pk(oB.x, oB.y); o.w = pk(oB.z, oB.w);
      *(GAS v4u*)(P + ((size_t)b * SEQ + s) * DIN + zc) = o; }
    __syncthreads();
}
#undef SC2_MFMA
}

#ifndef WIN_STAGGER_TICKS
#define WIN_STAGGER_TICKS 0
#endif
#ifndef GU_STAGGER_TICKS
#define GU_STAGGER_TICKS 0
#endif
#ifndef DUP_MASK
#define DUP_MASK 0
#endif
#define REPS(b) ((((DUP_MASK) >> (b)) & 1) + 1)
#ifndef EN_P0
#define EN_P0 1
#endif
#ifndef EN_NORM
#define EN_NORM 1
#endif
#ifndef EN_GU
#define EN_GU 1
#endif
#ifndef EN_WIN
#define EN_WIN 1
#endif
#ifndef EN_PREP
#define EN_PREP 1
#endif
#ifndef EN_SCAN
#define EN_SCAN 1
#endif
#ifndef EN_ATTN
#define EN_ATTN 1
#endif
#ifndef EN_COMB
#define EN_COMB 1
#endif
#ifndef EN_RES
#define EN_RES 1
#endif
struct Args { const void* in[N_IN]; float* out; unsigned char* ws; int ph_lo, ph_hi; };
constexpr int PH_PER_LAYER = 9, NPH = 1 + DEPTH * PH_PER_LAYER;

__global__ void __launch_bounds__(NWAVES * 64, 2) fwd_kernel(Args args) {
    extern __shared__ __attribute__((aligned(16))) unsigned char lds[];
    LAS unsigned char* ldsb = (LAS unsigned char*)lds;
    volatile LAS unsigned* MISC = (volatile LAS unsigned*)(ldsb + MISC_OFF);
    const int tid0 = threadIdx.x;
    const int G = gridDim.x; const int bx = blockIdx.x; const int vcu = (G % 8 == 0) ? (bx % 8) * (G / 8) + bx / 8 : bx;
    const int NGW = G * NWAVES;
#define PHASE_IDS() int tid = threadIdx.x; asm volatile("" : "+v"(tid)); const int lane = tid & 63, wave = __builtin_amdgcn_readfirstlane(tid >> 6), gw = vcu * NWAVES + wave; (void)lane; (void)gw
    unsigned char* ws = args.ws;
    gu32* ctl = (gu32*)(ws + WS_CTL);
    for (int u = tid0; u < (LDS_BYTES - LDSCTL_OFF) / 4; u += NWAVES * 64) ((LAS unsigned*)(ldsb + LDSCTL_OFF))[u] = 0u;
    __syncthreads();
    const int lo = args.ph_lo, hi = args.ph_hi;
    const bool multi = (hi - lo) > 1;
    XcdBarrier bar; bar.bar = (unsigned*)(ctl + CW_BAR); bar.x = 0; bar.st = nullptr;
    if (multi) bar = xcd_barrier_post((unsigned*)(ctl + CW_BAR), MISC + 8);
#define RUN(k) (lo <= (k) && (k) < hi)
#define SEAM(k) do { if (RUN(k) && RUN((k) + 1)) { xcd_barrier(bar); if (DUP_MASK & 4096) xcd_barrier(bar); } } while (0)

    float* out = args.out;
    bf16* Y = (bf16*)(ws + WS_H); bf16* P = (bf16*)(ws + WS_P); bf16* ACT = P; bf16* XB = (bf16*)(ws + WS_OF); bf16* OA = (bf16*)(ws + WS_OA);
    unsigned* rowsq = (unsigned*)(ws + WS_ROWSQ);
    float* lbt = (float*)(ws + WS_SMALL); float* cosT = (float*)(ws + WS_ROPE); float* sinT = cosT + (size_t)M * 32;

    if (EN_P0 && RUN(0)) {
        PHASE_IDS();
        for (int rep = 0; rep < REPS(7); ++rep) {
        LAS float* scr = (LAS float*)(ldsb + RING_OFF + wave * 16384);
        constexpr int I_GU = (D / 64) * (DFF / 32), I_DN = (DFF / 64) * (D / 32), I_IN = (D / 64) * (DIN / 32), I_OUT = (D / 64) * (D / 32);
        constexpr int PER_LAYER = 2 * (2 * I_GU + I_DN) + I_IN + I_OUT, NITEMS = DEPTH * PER_LAYER;
        for (int it = gw; it < NITEMS; it += NGW) {
            const int L = it / PER_LAYER; int r = it % PER_LAYER;
            const size_t oGU = (size_t)L * D * DFF;
            if (r < I_GU) { p0_transpose_item((const float*)args.in[I_F1G] + oGU, D, DFF, (bf16*)(ws + WS_WGU + (size_t)(2 * L) * SZ_WGU), 1, (const float*)args.in[I_F1N] + (size_t)L * D, scr, r, lane); continue; } r -= I_GU;
            if (r < I_GU) { p0_transpose_item((const float*)args.in[I_F1U] + oGU, D, DFF, (bf16*)(ws + WS_WGU + (size_t)(2 * L) * SZ_WGU), 2, (const float*)args.in[I_F1N] + (size_t)L * D, scr, r, lane); continue; } r -= I_GU;
            if (r < I_DN) { p0_transpose_item((const float*)args.in[I_F1D] + oGU, DFF, D, (bf16*)(ws + WS_WD + (size_t)(2 * L) * SZ_WD), 0, nullptr, scr, r, lane); continue; } r -= I_DN;
            if (r < I_GU) { p0_transpose_item((const float*)args.in[I_F2G] + oGU, D, DFF, (bf16*)(ws + WS_WGU + (size_t)(2 * L + 1) * SZ_WGU), 1, (const float*)args.in[I_F2N] + (size_t)L * D, scr, r, lane); continue; } r -= I_GU;
            if (r < I_GU) { p0_transpose_item((const float*)args.in[I_F2U] + oGU, D, DFF, (bf16*)(ws + WS_WGU + (size_t)(2 * L + 1) * SZ_WGU), 2, (const float*)args.in[I_F2N] + (size_t)L * D, scr, r, lane); continue; } r -= I_GU;
            if (r < I_DN) { p0_transpose_item((const float*)args.in[I_F2D] + oGU, DFF, D, (bf16*)(ws + WS_WD + (size_t)(2 * L + 1) * SZ_WD), 0, nullptr, scr, r, lane); continue; } r -= I_DN;
            if (r < I_IN) { p0_transpose_item((const float*)args.in[I_WIN] + (size_t)L * D * DIN, D, DIN, (bf16*)(ws + WS_WIN + (size_t)L * SZ_WIN), 0, (const float*)args.in[I_MIXN] + (size_t)L * D, scr, r, lane); continue; } r -= I_IN;
            p0_transpose_item((const float*)args.in[I_WOUT] + (size_t)L * D * D, D, D, (bf16*)(ws + WS_WOUT + (size_t)L * SZ_WOUT), 0, nullptr, scr, r, lane);
        }
        xcopy_phase((const float*)args.in[I_X], XB, rowsq, gw, NGW, lane);
        { const int* pos = (const int*)args.in[I_POS];
          for (int i = (vcu * NWAVES * 64 + tid); i < M * 32; i += G * NWAVES * 64) { const int m = i >> 5, j = i & 31;
              const double ang = (double)(float)((float)pos[m] * (float)c_inv_freq[j]);
              double rev = ang * 0.15915494309189533577; rev -= __builtin_rint(rev);
              const float rf = (float)rev; cosT[i] = __builtin_amdgcn_cosf(rf); sinT[i] = __builtin_amdgcn_sinf(rf); } }
        { const float* lg = (const float*)args.in[I_LB];
          for (int i = (vcu * NWAVES * 64 + tid); i < 2 * 1024; i += G * NWAVES * 64) { const int dir = i >> 10, c = i & 1023;
              float l[DEPTH], mx = -1e30f;
#pragma unroll
              for (int j = 0; j < DEPTH; ++j) { l[j] = lg[(dir * DEPTH + j) * 1024 + c]; mx = fmaxf(mx, l[j]); }
              float sum = 0.f;
#pragma unroll
              for (int j = 0; j < DEPTH; ++j) { l[j] = expf(l[j] - mx); sum += l[j]; }
              float cum = 0.f;
#pragma unroll
              for (int j = 0; j < DEPTH; ++j) { if (j > 0) cum += l[j] / sum; lbt[(dir * DEPTH + j) * 1024 + c] = cum; } } }
        }
    }
    SEAM(0);

#pragma unroll 1
    for (int L = 0; L < DEPTH; ++L) {
#pragma unroll 1
        for (int st = 0; st < 3; ++st) {
            const int pb = 1 + PH_PER_LAYER * L + (st == 0 ? 0 : (st == 1 ? 2 : 7));
            const unsigned* rsq_in = rowsq + (size_t)(3 * L + st) * M;
            int plast;
            if (st != 1) {
                if (EN_GU && RUN(pb)) {
                    const bf16* W = (const bf16*)(ws + WS_WGU + (size_t)(2 * L + (st == 2 ? 1 : 0)) * SZ_WGU);
                    pg8::Gemm g{XB, W, M, NGU, D}; pg8::StaticOrder S; S.init(M, NGU, G, bx);
                    pg8::EpiSwiGLU E{ACT, DFF, rsq_in};
#if DUP_MASK & 512
                    { pg8::EpiNone EN{(float*)(ws + WS_SMALL + 65536)}; pg8::gemm_phase<pg8::EpiNone, pg8::StaticOrder, true, true>(ldsb + RING_OFF, g, S, EN); }
#endif
                    for (int rep = 0; rep < REPS(0); ++rep) pg8::gemm_phase<pg8::EpiSwiGLU, pg8::StaticOrder, true, true>(ldsb + RING_OFF, g, S, E);
                }
                SEAM(pb);
                plast = pb + 1;
            } else {
                if (EN_WIN && RUN(pb)) {
                    const bf16* W = (const bf16*)(ws + WS_WIN + (size_t)L * SZ_WIN);
                    pg8::Gemm g{XB, W, M, DIN, D}; pg8::StaticOrder S; S.init(M, DIN, G, bx);
                    pg8::EpiBf16 E{P, DIN, rsq_in};
#if DUP_MASK & 2048
                    { pg8::EpiNone EN{(float*)(ws + WS_SMALL + 65536)}; pg8::gemm_phase<pg8::EpiNone, pg8::StaticOrder, true, true>(ldsb + RING_OFF, g, S, EN); }
#endif
                    for (int rep = 0; rep < REPS(2); ++rep) pg8::gemm_phase<pg8::EpiBf16, pg8::StaticOrder, true, true>(ldsb + RING_OFF, g, S, E);
                }
                SEAM(pb);
                if (RUN(pb + 1)) {
                    PHASE_IDS();
                    if (EN_PREP) prep_phase(P, cosT, sinT, (const float*)args.in[I_DAQN] + L * 64, (const float*)args.in[I_DAKN] + L * 64, gw, NGW, lane);
                    if (EN_SCAN) for (int rep = 0; rep < REPS(4); ++rep)
                    for (int u = vcu; u < BATCH * 8 * 2; u += G) { const int b = u >> 4, h = (u >> 1) & 7, dir = u & 1;
                        sc2::scan_unit(P, lbt + (size_t)(dir * DEPTH + L) * 1024, b, h, dir, ldsb + RING_OFF, tid); }
                }
                SEAM(pb + 1);
                if (EN_ATTN && RUN(pb + 2)) {
                    for (int rep = 0; rep < REPS(5); ++rep)
                    for (int u = vcu; u < BATCH * 4 * 2 * (SEQ / 256); u += G) { const int qb = u & 7, cmb = u >> 3, map = cmb & 1, h = (cmb >> 1) & 3, b = cmb >> 3;
                        const bf16* Pb = P + (size_t)b * SEQ * DIN;
                        __syncthreads();
                        att::attn_unit(Pb + (size_t)(qb * 256) * DIN + C_DAQ + h * 128 + map * 64, Pb + C_DAK + h * 128 + map * 64, Pb + C_DAV + h * 128,
                                       OA + ((size_t)b * SEQ + qb * 256) * 1024 + h * 256 + map * 128, SEQ, (char*)lds + RING_OFF); }
                    __syncthreads();
                }
                SEAM(pb + 2);
                if (EN_COMB && RUN(pb + 3)) {
                    PHASE_IDS();
                    for (int rep = 0; rep < REPS(8); ++rep) combine_phase(P, OA, Y, (const float*)args.in[I_HGN] + L * 1024, (const float*)args.in[I_DAON] + L * 512, (const float*)args.in[I_LQ1] + L * 64, (const float*)args.in[I_LK1] + L * 64,
                                  (const float*)args.in[I_LQ2] + L * 64, (const float*)args.in[I_LK2] + L * 64, c_lam_init[L], (const float*)args.in[I_CW] + L * 1536, (const float*)args.in[I_CB] + L * 512,
                                  (const float*)args.in[I_CN] + L * 512, gw, NGW, lane);
                }
                SEAM(pb + 3);
                plast = pb + 4;
            }
            if (EN_RES && RUN(plast)) {
                const bf16* A = (st == 1) ? Y : ACT; const int K = (st == 1) ? D : DFF;
                const bf16* W = (st == 1) ? (const bf16*)(ws + WS_WOUT + (size_t)L * SZ_WOUT) : (const bf16*)(ws + WS_WD + (size_t)(2 * L + (st == 2 ? 1 : 0)) * SZ_WD);
                pg8::Gemm g{A, W, M, D, K}; pg8::StaticOrder S; S.init(M, D, G, bx);
#if DUP_MASK & 1024
                if (st != 1) { pg8::EpiNone EN{(float*)(ws + WS_SMALL + 65536)}; pg8::gemm_phase<pg8::EpiNone, pg8::StaticOrder, true, true>(ldsb + RING_OFF, g, S, EN); }
#endif
                const float scale = (st == 1) ? 1.0f : 0.5f;
                if (L == DEPTH - 1 && st == 2) { pg8::EpiResAdd<true> E{XB, out, nullptr, D, scale}; pg8::gemm_phase<pg8::EpiResAdd<true>, pg8::StaticOrder, true, true>(ldsb + RING_OFF, g, S, E); }
                else { pg8::EpiResAdd<false> E{XB, out, rowsq + (size_t)(3 * L + st + 1) * M, D, scale}; pg8::gemm_phase<pg8::EpiResAdd<false>, pg8::StaticOrder, true, true>(ldsb + RING_OFF, g, S, E); }
            }
            SEAM(plast);
        }
    }
#undef RUN
#undef SEAM
}

#ifndef MK_PER_PHASE
#define MK_PER_PHASE 0
#endif
extern "C" void kernel_launch(void* const* d_in, const int* in_sizes, int n_in, void* d_out, int out_size, void* d_ws, size_t ws_size, hipStream_t stream) {
    static int grid = 0;
    if (grid == 0) {
        if (n_in != N_IN || in_sizes[0] != M * D || out_size != M * D || ws_size < WS_END) {
            fprintf(stderr, "kernel_launch: shape/workspace mismatch: n_in %d in0 %d out %d ws %zu (need %zu); nothing launched\n", n_in, n_in > 0 ? in_sizes[0] : -1, out_size, ws_size, (size_t)WS_END); grid = -1; return; }
        int dev = 0, cus = 0, per_cu = 0;
        if (hipGetDevice(&dev) != hipSuccess || hipDeviceGetAttribute(&cus, hipDeviceAttributeMultiprocessorCount, dev) != hipSuccess) { fprintf(stderr, "kernel_launch: device query failed\n"); grid = -1; return; }
        if (hipFuncSetAttribute((const void*)fwd_kernel, hipFuncAttributeMaxDynamicSharedMemorySize, LDS_BYTES) != hipSuccess) { fprintf(stderr, "kernel_launch: hipFuncSetAttribute failed\n"); grid = -1; return; }
        if (hipOccupancyMaxActiveBlocksPerMultiprocessor(&per_cu, (const void*)fwd_kernel, NWAVES * 64, LDS_BYTES) != hipSuccess || per_cu < 1)
            fprintf(stderr, "kernel_launch: note: occupancy query reports %d workgroups per CU\n", per_cu);
        (void)hipGetLastError();
        grid = cus;
    }
    if (grid < 0) return;
    if (hipMemsetAsync((char*)d_ws + WS_CTL, 0, CTL_ZERO_BYTES, stream) != hipSuccess) { fprintf(stderr, "kernel_launch: memset failed\n"); return; }
    Args a{};
    for (int i = 0; i < N_IN; ++i) a.in[i] = d_in[i];
    a.out = (float*)d_out; a.ws = (unsigned char*)d_ws;
#if MK_PER_PHASE
    for (int p = 0; p < NPH; ++p) { a.ph_lo = p; a.ph_hi = p + 1;
        hipLaunchKernelGGL(fwd_kernel, dim3(grid), dim3(NWAVES * 64), LDS_BYTES, stream, a); }
#else
    a.ph_lo = 0; a.ph_hi = NPH;
    hipLaunchKernelGGL(fwd_kernel, dim3(grid), dim3(NWAVES * 64), LDS_BYTES, stream, a);
#endif
    const hipError_t le = hipPeekAtLastError();
    if (le != hipSuccess) fprintf(stderr, "kernel_launch: launch failed: %s\n", hipGetErrorName(le));
}
```

```cpp
#include <hip/hip_runtime.h>
#include <cstdio>
#include <cstdint>
namespace pg8 {
#define PG8_LAS __attribute__((address_space(3)))
typedef unsigned short bf16_t;
typedef short bf16x8 __attribute__((ext_vector_type(8)));
typedef float f32x4 __attribute__((ext_vector_type(4)));
typedef unsigned u32x4 __attribute__((ext_vector_type(4)));
constexpr int BM = 256, BK = 64, HALF = 128, HTB = HALF * BK * 2  , STAGE_BYTES = 8 * HTB, NXCD = 8;

__host__ __device__ __forceinline__ int lds_byte(int r, int c) { const int st = (r >> 4) * 2 + (c >> 5), rr = r & 15, cc = c & 31, ob = rr * 64 + cc * 2; return st * 1024 + (ob ^ (((ob >> 9) & 1) << 5)); }
__host__ __device__ __forceinline__ void stage_rc(int b, int& R, int& C) { const int st = b / 1024, sb = b % 1024, swz = sb ^ (((sb >> 9) & 1) << 5); R = (st >> 1) * 16 + swz / 64; C = (st & 1) * 32 + (swz % 64) / 2; }
__host__ __device__ __forceinline__ int perm32(int rho) { const int n = rho >> 4, i = rho & 15; return 8 * (i >> 2) + 4 * n + (i & 3); }

struct Unit { int pm, pn; };
struct Gemm { const bf16_t* A; const bf16_t* Bt; int M, N, K; };

struct StaticOrder {
    int nM, nN, nwg, G, c, WGM;
    __host__ __device__ void init(int M, int N, int G_, int c_, int wgm = 8) { nM = M / BM; nN = N / BM; nwg = nM * nN; G = G_; c = c_; WGM = wgm; }
    __host__ __device__ bool next(int i, Unit& u) const {
        const long L = (long)i * G + c; if (L >= nwg) return false;
        int wgid = (int)L; { const int q = nwg / NXCD, r = nwg % NXCD, xcd = wgid % NXCD, off = wgid / NXCD; wgid = (xcd < r ? xcd * (q + 1) : r * (q + 1) + (xcd - r) * q) + off; }
        const int nig = WGM * nN, gid = wgid / nig, fm = gid * WGM, gsz = (nM - fm) < WGM ? (nM - fm) : WGM;
        u.pm = fm + ((wgid % nig) % gsz); u.pn = (wgid % nig) / gsz; return true;
    }
    __device__ __forceinline__ void a_ready(const Unit&) const {}
    __device__ __forceinline__ void done(const Unit&) const {}
};

__device__ __forceinline__ unsigned cvt_pk_bf16(float lo, float hi) { unsigned r; asm volatile("v_cvt_pk_bf16_f32 %0, %1, %2" : "=v"(r) : "v"(lo), "v"(hi)); return r; }

__device__ __forceinline__ u32x4 lane_xpose(u32x4 w, int srcaddr) {
    u32x4 r; r.x = (unsigned)__builtin_amdgcn_ds_bpermute(srcaddr, (int)w.x); r.y = (unsigned)__builtin_amdgcn_ds_bpermute(srcaddr, (int)w.y);
    r.z = (unsigned)__builtin_amdgcn_ds_bpermute(srcaddr, (int)w.z); r.w = (unsigned)__builtin_amdgcn_ds_bpermute(srcaddr, (int)w.w); return r; }

constexpr float RSQ_SCALE = 4096.0f;
__device__ __forceinline__ void prefetch_rsq(PG8_LAS unsigned char* slot, const unsigned* rowsq, const Unit& u, int wr, int fr, int fq) {
    if (fq == 0) {
#pragma unroll
        for (int ai = 0; ai < 2; ++ai)
#pragma unroll
            for (int m = 0; m < 4; ++m) __builtin_amdgcn_global_load_lds(rowsq + (u.pm * BM + ai * HALF + wr * 64 + m * 16 + fr), (PG8_LAS unsigned*)(slot + (ai * 4 + m) * 64), 4, 0, 0);
    }
}
__device__ __forceinline__ float rstd_of(unsigned q) { return __builtin_amdgcn_rsqf((float)q * (1.0f / (RSQ_SCALE * 2048.0f)) + 1e-6f); }
#ifndef EPI_WIDE
#define EPI_WIDE 1
#endif
#if EPI_WIDE
#define EPI_WC 64
#define EPI_BJ 32
#else
#define EPI_WC 32
#define EPI_BJ HALF
#endif
#ifndef EPI_STORE_MODE
#define EPI_STORE_MODE 0
#endif
__device__ __forceinline__ void epi_store16(void* p, u32x4 v) {
#if EPI_STORE_MODE == 1
    asm volatile("global_store_dwordx4 %0, %1, off sc1\n\ts_nop 2" :: "v"(p), "v"(v) : "memory");
#elif EPI_STORE_MODE == 2
    asm volatile("global_store_dwordx4 %0, %1, off nt\n\ts_nop 2" :: "v"(p), "v"(v) : "memory");
#elif EPI_STORE_MODE == 3
    asm volatile("global_store_dwordx4 %0, %1, off sc0 sc1\n\ts_nop 2" :: "v"(p), "v"(v) : "memory");
#else
    *(u32x4*)p = v;
#endif
}
struct EpiBf16 {
    static constexpr bool PERM = true, AFTER_DRAIN = false; static constexpr int NVM = 16;
    bf16_t* O; int ldc; const unsigned* rowsq;
    __device__ __forceinline__ void prefetch(PG8_LAS unsigned char* slot, const Unit& u, int wr, int fr, int fq) const { prefetch_rsq(slot, rowsq, u, wr, fr, fq); }
    __device__ __forceinline__ void operator()(const f32x4 (&acc)[2][2][4][2], const Unit& u, int wr, int wc, int fr, int fq, const PG8_LAS unsigned char* slot) const {
        const int lane = fr + 16 * fq, pr = lane >> 2, pc = lane & 3, sa = (pr + 16 * pc) * 4;
        const int row0 = u.pm * BM + wr * 64 + pr, col0 = u.pn * BM + wc * EPI_WC + 8 * pc;
        float rs[2][4];
#pragma unroll
        for (int ai = 0; ai < 2; ++ai)
#pragma unroll
            for (int m = 0; m < 4; ++m) rs[ai][m] = rstd_of(*(const PG8_LAS unsigned*)(slot + (ai * 4 + m) * 64 + fr * 4));
#pragma unroll
        for (int ai = 0; ai < 2; ++ai)
#pragma unroll
            for (int m = 0; m < 4; ++m) { bf16_t* rowp = O + (size_t)(row0 + ai * HALF + m * 16) * ldc + col0;
#pragma unroll
                for (int bj = 0; bj < 2; ++bj) { const f32x4 v0 = acc[ai][bj][m][0] * rs[ai][m], v1 = acc[ai][bj][m][1] * rs[ai][m];
                    u32x4 w; w.x = cvt_pk_bf16(v0[0], v0[1]); w.y = cvt_pk_bf16(v0[2], v0[3]); w.z = cvt_pk_bf16(v1[0], v1[1]); w.w = cvt_pk_bf16(v1[2], v1[3]);
                    epi_store16(rowp + bj * EPI_BJ, lane_xpose(w, sa)); } }
    }
};
struct EpiBf16Rot {
    static constexpr bool PERM = true, AFTER_DRAIN = false, INIT_ACC = false; static constexpr int NVM = 16;
    bf16_t* O; int ldc; const unsigned* rowsq; const float* cosT; const float* sinT; const float* qg; const float* kg; int rot_lo, rot_k, rot_hi;
    __device__ __forceinline__ void prefetch(PG8_LAS unsigned char* slot, const Unit& u, int wr, int fr, int fq) const { prefetch_rsq(slot, rowsq, u, wr, fr, fq); }
    __device__ __forceinline__ void operator()(const f32x4 (&acc)[2][2][4][2], const Unit& u, int wr, int wc, int fr, int fq, const PG8_LAS unsigned char* slot) const {
        static_assert(EPI_WIDE, "EpiBf16Rot needs a (head, map) inside one wave");
        const int lane = fr + 16 * fq, pr = lane >> 2, pc = lane & 3, sa = (pr + 16 * pc) * 4;
        const int row0 = u.pm * BM + wr * 64 + pr, col0 = u.pn * BM + wc * EPI_WC + 8 * pc;
        float rs[2][4];
#pragma unroll
        for (int ai = 0; ai < 2; ++ai)
#pragma unroll
            for (int m = 0; m < 4; ++m) rs[ai][m] = rstd_of(*(const PG8_LAS unsigned*)(slot + (ai * 4 + m) * 64 + fr * 4));
        const bool rot = u.pn >= rot_lo && u.pn < rot_hi;
        if (!rot) {
#pragma unroll
            for (int ai = 0; ai < 2; ++ai)
#pragma unroll
                for (int m = 0; m < 4; ++m) { bf16_t* rowp = O + (size_t)(row0 + ai * HALF + m * 16) * ldc + col0;
#pragma unroll
                    for (int bj = 0; bj < 2; ++bj) { const f32x4 v0 = acc[ai][bj][m][0] * rs[ai][m], v1 = acc[ai][bj][m][1] * rs[ai][m];
                        u32x4 w; w.x = cvt_pk_bf16(v0[0], v0[1]); w.y = cvt_pk_bf16(v0[2], v0[3]); w.z = cvt_pk_bf16(v1[0], v1[1]); w.w = cvt_pk_bf16(v1[2], v1[3]);
                        epi_store16(rowp + bj * EPI_BJ, lane_xpose(w, sa)); } }
        } else {
            const float* gp = (u.pn < rot_k ? qg : kg) + 8 * fq;
            const f32x4 g1a = *(const f32x4*)gp, g1b = *(const f32x4*)(gp + 4), g2a = *(const f32x4*)(gp + 32), g2b = *(const f32x4*)(gp + 36);
#pragma unroll
            for (int ai = 0; ai < 2; ++ai)
#pragma unroll
                for (int m = 0; m < 4; ++m) {
                    const int rowa = u.pm * BM + ai * HALF + wr * 64 + m * 16 + fr;
                    const f32x4* cp = (const f32x4*)(cosT + (size_t)rowa * 32 + 8 * fq); const f32x4* sp = (const f32x4*)(sinT + (size_t)rowa * 32 + 8 * fq);
                    const f32x4 ca = cp[0], cb = cp[1], sna = sp[0], snb = sp[1];
                    const f32x4 x1a = acc[ai][0][m][0] * rs[ai][m], x1b = acc[ai][0][m][1] * rs[ai][m], x2a = acc[ai][1][m][0] * rs[ai][m], x2b = acc[ai][1][m][1] * rs[ai][m];
                    const f32x4 sq = x1a * x1a + x1b * x1b + x2a * x2a + x2b * x2b;
                    float ss = (sq[0] + sq[1]) + (sq[2] + sq[3]); ss += __shfl_xor(ss, 16); ss += __shfl_xor(ss, 32);
                    const float rq = 1.0f / sqrtf(ss * (1.0f / 64.0f) + 1e-6f);
                    const f32x4 y1a = x1a * rq * g1a, y1b = x1b * rq * g1b, y2a = x2a * rq * g2a, y2b = x2b * rq * g2b;
                    const f32x4 o1a = y1a * ca - y2a * sna, o1b = y1b * cb - y2b * snb, o2a = y2a * ca + y1a * sna, o2b = y2b * cb + y1b * snb;
                    bf16_t* rowp = O + (size_t)(row0 + ai * HALF + m * 16) * ldc + col0;
                    u32x4 w1; w1.x = cvt_pk_bf16(o1a[0], o1a[1]); w1.y = cvt_pk_bf16(o1a[2], o1a[3]); w1.z = cvt_pk_bf16(o1b[0], o1b[1]); w1.w = cvt_pk_bf16(o1b[2], o1b[3]);
                    u32x4 w2; w2.x = cvt_pk_bf16(o2a[0], o2a[1]); w2.y = cvt_pk_bf16(o2a[2], o2a[3]); w2.z = cvt_pk_bf16(o2b[0], o2b[1]); w2.w = cvt_pk_bf16(o2b[2], o2b[3]);
                    epi_store16(rowp, lane_xpose(w1, sa)); epi_store16(rowp + EPI_BJ, lane_xpose(w2, sa)); }
        }
    }
};
struct EpiSwiGLU {
    static constexpr bool PERM = true, AFTER_DRAIN = false; static constexpr int NVM = 8;
    bf16_t* O; int ldc; const unsigned* rowsq;
    __device__ __forceinline__ void prefetch(PG8_LAS unsigned char* slot, const Unit& u, int wr, int fr, int fq) const { prefetch_rsq(slot, rowsq, u, wr, fr, fq); }
    typedef float f32x2 __attribute__((ext_vector_type(2)));
    __device__ __forceinline__ f32x2 sg2(f32x2 g, f32x2 u, float rl, float r2) const {
        const f32x2 a = g * rl; f32x2 e; e.x = __builtin_amdgcn_exp2f(a.x); e.y = __builtin_amdgcn_exp2f(a.y);
        const f32x2 d = e + 1.0f; f32x2 q; q.x = __builtin_amdgcn_rcpf(d.x); q.y = __builtin_amdgcn_rcpf(d.y);
        return (g * u) * (q * r2);
    }
    __device__ __forceinline__ void operator()(const f32x4 (&acc)[2][2][4][2], const Unit& u, int wr, int wc, int fr, int fq, const PG8_LAS unsigned char* slot) const {
        const int lane = fr + 16 * fq, pr = lane >> 2, pc = lane & 3, sa = (pr + 16 * pc) * 4;
        const int row0 = u.pm * BM + wr * 64 + pr, col0 = u.pn * HALF + wc * 32 + 8 * pc;
        float rs[2][4];
#pragma unroll
        for (int ai = 0; ai < 2; ++ai)
#pragma unroll
            for (int m = 0; m < 4; ++m) rs[ai][m] = rstd_of(*(const PG8_LAS unsigned*)(slot + (ai * 4 + m) * 64 + fr * 4));
#pragma unroll
        for (int ai = 0; ai < 2; ++ai)
#pragma unroll
            for (int m = 0; m < 4; ++m) { bf16_t* rowp = O + (size_t)(row0 + ai * HALF + m * 16) * ldc + col0; const float r = rs[ai][m], rl = r * -1.44269504088896341f, r2 = r * r;
                const f32x4 g0 = acc[ai][0][m][0], g1 = acc[ai][0][m][1], u0 = acc[ai][1][m][0], u1 = acc[ai][1][m][1];
                const f32x2 h0 = sg2((f32x2){g0[0], g0[1]}, (f32x2){u0[0], u0[1]}, rl, r2), h1 = sg2((f32x2){g0[2], g0[3]}, (f32x2){u0[2], u0[3]}, rl, r2);
                const f32x2 h2 = sg2((f32x2){g1[0], g1[1]}, (f32x2){u1[0], u1[1]}, rl, r2), h3 = sg2((f32x2){g1[2], g1[3]}, (f32x2){u1[2], u1[3]}, rl, r2);
                u32x4 w; w.x = cvt_pk_bf16(h0.x, h0.y); w.y = cvt_pk_bf16(h1.x, h1.y); w.z = cvt_pk_bf16(h2.x, h2.y); w.w = cvt_pk_bf16(h3.x, h3.y);
                epi_store16(rowp, lane_xpose(w, sa)); }
    }
};
template <bool FINAL, bool ATOM = true> struct EpiResAdd {
    static constexpr bool PERM = true, AFTER_DRAIN = false; static constexpr int NVM = FINAL ? 32 : 16;
    bf16_t* xb; float* out; unsigned* rowsq_out; int ldc; float scale;
    __device__ __forceinline__ void prefetch(PG8_LAS unsigned char*, const Unit&, int, int, int) const {}
    __device__ __forceinline__ void operator()(const f32x4 (&acc)[2][2][4][2], const Unit& u, int wr, int wc, int fr, int fq, const PG8_LAS unsigned char*) const {
        const int lane = fr + 16 * fq, pr = lane >> 2, pc = lane & 3, sa = (pr + 16 * pc) * 4;
        const int row0 = u.pm * BM + wr * 64 + pr, col0 = u.pn * BM + wc * EPI_WC + 8 * pc;
#pragma unroll
        for (int ai = 0; ai < 2; ++ai) {
            u32x4 b[4][2];
#pragma unroll
            for (int m = 0; m < 4; ++m) { const size_t off = (size_t)(row0 + ai * HALF + m * 16) * ldc + col0;
#pragma unroll
                for (int bj = 0; bj < 2; ++bj) b[m][bj] = *(const u32x4*)(xb + off + bj * EPI_BJ); }
#pragma unroll
            for (int m = 0; m < 4; ++m) { const int row = row0 + ai * HALF + m * 16; const size_t off = (size_t)row * ldc + col0; float ss = 0.f;
#pragma unroll
                for (int bj = 0; bj < 2; ++bj) {
                    const f32x4 a0 = acc[ai][bj][m][0] * scale, a1 = acc[ai][bj][m][1] * scale;
                    const u32x4 bw = b[m][bj];
                    const f32x4 r0 = {__builtin_bit_cast(float, bw.x << 16), __builtin_bit_cast(float, bw.x & 0xffff0000u), __builtin_bit_cast(float, bw.y << 16), __builtin_bit_cast(float, bw.y & 0xffff0000u)};
                    const f32x4 r1 = {__builtin_bit_cast(float, bw.z << 16), __builtin_bit_cast(float, bw.z & 0xffff0000u), __builtin_bit_cast(float, bw.w << 16), __builtin_bit_cast(float, bw.w & 0xffff0000u)};
                    const f32x4 x0 = r0 + __builtin_bit_cast(f32x4, lane_xpose(__builtin_bit_cast(u32x4, a0), sa)), x1 = r1 + __builtin_bit_cast(f32x4, lane_xpose(__builtin_bit_cast(u32x4, a1), sa));
                    if constexpr (FINAL) { epi_store16(out + off + bj * EPI_BJ, __builtin_bit_cast(u32x4, x0)); epi_store16(out + off + bj * EPI_BJ + 4, __builtin_bit_cast(u32x4, x1)); }
                    else { u32x4 w; w.x = cvt_pk_bf16(x0[0], x0[1]); w.y = cvt_pk_bf16(x0[2], x0[3]); w.z = cvt_pk_bf16(x1[0], x1[1]); w.w = cvt_pk_bf16(x1[2], x1[3]);
                        epi_store16(xb + off + bj * EPI_BJ, w);
                        ss += (x0[0] * x0[0] + x0[1] * x0[1]) + (x0[2] * x0[2] + x0[3] * x0[3]) + (x1[0] * x1[0] + x1[1] * x1[1]) + (x1[2] * x1[2] + x1[3] * x1[3]); } }
                if constexpr (!FINAL) { ss += __shfl_xor(ss, 1); ss += __shfl_xor(ss, 2);
                    if (ATOM && pc == 0) __hip_atomic_fetch_add(rowsq_out + row, (unsigned)(ss * RSQ_SCALE), __ATOMIC_RELAXED, __HIP_MEMORY_SCOPE_AGENT); } }
            asm volatile("" ::: "memory"); }
    }
};

template <int MODE> struct EpiBf16Probe {
    static constexpr bool PERM = true, AFTER_DRAIN = false; static constexpr int NVM = 0;
    bf16_t* O; int ldc;
    __device__ __forceinline__ void prefetch(PG8_LAS unsigned char*, const Unit&, int, int, int) const {}
    __device__ __forceinline__ void operator()(const f32x4 (&acc)[2][2][4][2], const Unit& u, int wr, int wc, int fr, int fq, const PG8_LAS unsigned char*) const {
        const int lane = fr + 16 * fq, pr = lane >> 2, pc = lane & 3, sa = (pr + 16 * pc) * 4;
        const int row0 = wr * 64 + pr, col0 = wc * 32 + 8 * pc;
        bf16_t* Ob = O + (size_t)blockIdx.x * 65536;
        if (MODE == 4) { const size_t ul = ((size_t)u.pm * 32 + u.pn); bf16_t* Ot = O + ul * 65536 + (size_t)(wr * 64 + pr) * 256 + wc * 32 + 8 * pc;
#pragma unroll
            for (int ai = 0; ai < 2; ++ai)
#pragma unroll
                for (int m = 0; m < 4; ++m)
#pragma unroll
                    for (int bj = 0; bj < 2; ++bj) { const f32x4 v0 = acc[ai][bj][m][0], v1 = acc[ai][bj][m][1];
                        u32x4 w; w.x = cvt_pk_bf16(v0[0], v0[1]); w.y = cvt_pk_bf16(v0[2], v0[3]); w.z = cvt_pk_bf16(v1[0], v1[1]); w.w = cvt_pk_bf16(v1[2], v1[3]);
                        *(u32x4*)(Ot + (size_t)(ai * HALF + m * 16) * 256 + bj * HALF) = lane_xpose(w, sa); }
            return; }
        if (MODE == 3) { const size_t ul = ((size_t)u.pm * 32 + u.pn); bf16_t* Oc = O + ul * 65536 + (size_t)(wr * 4 + wc) * 8192 + lane * 8; int k = 0;
#pragma unroll
            for (int ai = 0; ai < 2; ++ai)
#pragma unroll
                for (int m = 0; m < 4; ++m)
#pragma unroll
                    for (int bj = 0; bj < 2; ++bj) { const f32x4 v0 = acc[ai][bj][m][0], v1 = acc[ai][bj][m][1];
                        u32x4 w; w.x = cvt_pk_bf16(v0[0], v0[1]); w.y = cvt_pk_bf16(v0[2], v0[3]); w.z = cvt_pk_bf16(v1[0], v1[1]); w.w = cvt_pk_bf16(v1[2], v1[3]);
                        *(u32x4*)(Oc + (k++) * 512) = lane_xpose(w, sa); }
            return; }
#pragma unroll
        for (int ai = 0; ai < 2; ++ai)
#pragma unroll
            for (int m = 0; m < 4; ++m) { bf16_t* rowp = Ob + (size_t)(row0 + ai * HALF + m * 16) * 256 + col0;
#pragma unroll
                for (int bj = 0; bj < 2; ++bj) { const f32x4 v0 = acc[ai][bj][m][0], v1 = acc[ai][bj][m][1];
                    u32x4 w; w.x = cvt_pk_bf16(v0[0], v0[1]); w.y = cvt_pk_bf16(v0[2], v0[3]); w.z = cvt_pk_bf16(v1[0], v1[1]); w.w = cvt_pk_bf16(v1[2], v1[3]);
                    const u32x4 t = lane_xpose(w, sa);
                    if (MODE == 1 || t.x == 0x12345678u) *(u32x4*)(rowp + bj * HALF) = t; } }
    }
};
struct EpiNone {
    static constexpr bool PERM = true, AFTER_DRAIN = false; static constexpr int NVM = 0;
    float* sink;
    __device__ __forceinline__ void prefetch(PG8_LAS unsigned char*, const Unit&, int, int, int) const {}
    __device__ __forceinline__ void operator()(const f32x4 (&acc)[2][2][4][2], const Unit& u, int wr, int wc, int fr, int fq, const PG8_LAS unsigned char*) const {
        float s = 0.f;
#pragma unroll
        for (int ai = 0; ai < 2; ++ai)
#pragma unroll
            for (int bj = 0; bj < 2; ++bj)
#pragma unroll
                for (int m = 0; m < 4; ++m)
#pragma unroll
                    for (int n = 0; n < 2; ++n) s += acc[ai][bj][m][n][0] + acc[ai][bj][m][n][1] + acc[ai][bj][m][n][2] + acc[ai][bj][m][n][3];
        if (s == 123456.789f) sink[u.pm + wr + wc + fr + fq] = s;
    }
};

#ifndef PG8_RELAX
#define PG8_RELAX 0
#endif
#ifndef PROBE_STAMP
#define PROBE_STAMP 0
#endif
template <class Epi, class Sched, bool ALIGN_EPI = false, bool SP2 = false>
__device__ __forceinline__ void gemm_phase(PG8_LAS unsigned char* lds, const Gemm g, const Sched& S, const Epi& E, unsigned long long* stamp_out = nullptr) {
    int tid_ = threadIdx.x; asm volatile("" : "+v"(tid_));
    const int tid = tid_, wid = __builtin_amdgcn_readfirstlane(tid >> 6), lane = tid & 63, wr = wid >> 2, wc = wid & 3, fr = lane & 15, fq = lane >> 4;
    const int K = g.K, nt = K / BK;
    unsigned voffA[2], voffB[2];
#pragma unroll
    for (int i = 0; i < 2; ++i) { int R, C; stage_rc(tid * 16 + i * 8192, R, C); const int Rb = Epi::PERM ? ((R & ~31) + perm32(R & 31)) : R;
        voffA[i] = (unsigned)(R * K + C) * 2u; voffB[i] = (unsigned)(Rb * K + C) * 2u; }
    const size_t kstep = (size_t)(BK * 2);
    const size_t hstep = (size_t)HALF * K * 2;
    const size_t tstep = 2 * hstep;
    const unsigned ldsw = (unsigned)wid * 1024u;
    const int aoff = lds_byte(wr * 64 + fr, fq * 8), boff = lds_byte(wc * 32 + fr, fq * 8);
#define PG8_SA(b, h) (((b) * 2 + (h)) * HTB)
#define PG8_SB(b, h) ((4 + (b) * 2 + (h)) * HTB)
#define PG8_STAGE(bufoff, gbase, voff) do { _Pragma("unroll") for (int _i = 0; _i < 2; ++_i) \
        __builtin_amdgcn_global_load_lds((const unsigned*)((const char*)(gbase) + (voff)[_i]), (PG8_LAS unsigned*)(lds + (bufoff) + ldsw + _i * 8192), 16, 0, 0); } while (0)
#define PG8_LDA(dst, b, h) do { _Pragma("unroll") for (int m = 0; m < 4; ++m) _Pragma("unroll") for (int k = 0; k < 2; ++k) dst[m][k] = *(const PG8_LAS bf16x8*)(lds + PG8_SA(b, h) + aoff + m * 2048 + k * 1024); } while (0)
#define PG8_LDB(dst, b, h) do { _Pragma("unroll") for (int n = 0; n < 2; ++n) _Pragma("unroll") for (int k = 0; k < 2; ++k) dst[n][k] = *(const PG8_LAS bf16x8*)(lds + PG8_SB(b, h) + boff + n * 2048 + k * 1024); } while (0)
#define PG8_MMA(ai, bj, At, Bt) do { __builtin_amdgcn_s_setprio(1); _Pragma("unroll") for (int m = 0; m < 4; ++m) _Pragma("unroll") for (int n = 0; n < 2; ++n) _Pragma("unroll") for (int k = 0; k < 2; ++k) \
        acc[ai][bj][m][n] = __builtin_amdgcn_mfma_f32_16x16x32_bf16(Bt[n][k], At[m][k], acc[ai][bj][m][n], 0, 0, 0); __builtin_amdgcn_s_setprio(0); } while (0)
#define PG8_WAIT_V(n) asm volatile("s_waitcnt vmcnt(" #n ")" ::: "memory")
#define PG8_WAIT_L(n) asm volatile("s_waitcnt lgkmcnt(" #n ")" ::: "memory")
#define PG8_WAIT_VR(rl) do { if (rl) asm volatile("s_waitcnt vmcnt(%0)" :: "n"(8 + Epi::NVM) : "memory"); else asm volatile("s_waitcnt vmcnt(8)" ::: "memory"); } while (0)
#define PG8_BAR __builtin_amdgcn_s_barrier()
#define PG8_SCHED __builtin_amdgcn_sched_barrier(0)
    Unit cur, nxt; int ui = 0;
    if (!S.next(0, cur)) return;
    f32x4 acc[2][2][4][2];
#pragma unroll
    for (int a = 0; a < 2; ++a)
#pragma unroll
        for (int b = 0; b < 2; ++b)
#pragma unroll
            for (int m = 0; m < 4; ++m)
#pragma unroll
                for (int n = 0; n < 2; ++n) acc[a][b][m][n] = (f32x4){0.f, 0.f, 0.f, 0.f};
    bf16x8 At[4][2], B0[2][2], B1[2][2];
    const char* cA = (const char*)g.A + (size_t)cur.pm * tstep; const char* cB = (const char*)g.Bt + (size_t)cur.pn * tstep;
    S.a_ready(cur);
    PG8_LAS unsigned char* const epi_lds = lds + STAGE_BYTES + wid * 512;
    E.prefetch(epi_lds, cur, wr, fr, fq);
    if constexpr (SP2) {
        PG8_STAGE(PG8_SB(0, 0), cB, voffB); PG8_STAGE(PG8_SB(0, 1), cB + hstep, voffB); PG8_STAGE(PG8_SA(0, 0), cA, voffA); PG8_STAGE(PG8_SA(0, 1), cA + hstep, voffA);
        if (wr == 1) PG8_BAR;
        PG8_WAIT_V(2); PG8_BAR;
        PG8_STAGE(PG8_SB(1, 0), cB + kstep, voffB); PG8_STAGE(PG8_SA(1, 0), cA + kstep, voffA); PG8_STAGE(PG8_SB(1, 1), cB + hstep + kstep, voffB);
        PG8_WAIT_V(6); PG8_BAR;
    } else {
        PG8_STAGE(PG8_SB(0, 0), cB, voffB); PG8_STAGE(PG8_SA(0, 0), cA, voffA); PG8_STAGE(PG8_SB(0, 1), cB + hstep, voffB); PG8_STAGE(PG8_SA(0, 1), cA + hstep, voffA);
        if (wr == 1) PG8_BAR;
        PG8_WAIT_V(4); PG8_BAR;
        PG8_STAGE(PG8_SB(1, 0), cB + kstep, voffB); PG8_STAGE(PG8_SA(1, 0), cA + kstep, voffA); PG8_STAGE(PG8_SB(1, 1), cB + hstep + kstep, voffB);
        PG8_WAIT_V(6); PG8_BAR;
    }
    for (;;) {
        const bool has_next = S.next(ui + 1, nxt);
        const char* nA = has_next ? (const char*)g.A + (size_t)nxt.pm * tstep : cA; const char* nB = has_next ? (const char*)g.Bt + (size_t)nxt.pn * tstep : cB;
#if PROBE_STAMP
        unsigned long long st0_ = 0; if (stamp_out && ui == 2 && wid == 0) st0_ = (PROBE_STAMP == 1) ? (unsigned long long)__builtin_amdgcn_s_memtime() : (unsigned long long)__builtin_amdgcn_s_memrealtime();
#endif
        for (int t = 0; t < nt; t += 2) {
            const bool last = (t == nt - 2);
            const char* a1 = cA + (size_t)(t + 1) * kstep;
            const char* a2 = last ? nA : cA + (size_t)(t + 2) * kstep; const char* b2 = last ? nB : cB + (size_t)(t + 2) * kstep;
            const char* a3 = a2 + kstep; const char* b3 = b2 + kstep;
            if (last && has_next) S.a_ready(nxt);
            int relax_ = __builtin_amdgcn_readfirstlane((PG8_RELAX && (ui > 0) && (t == 0)) ? 1 : 0); asm volatile("" : "+s"(relax_));
            const bool relax = relax_ != 0;
            if constexpr (SP2) {
            PG8_LDB(B0, 0, 0); PG8_LDB(B1, 0, 1); PG8_SCHED; PG8_LDA(At, 0, 0); PG8_STAGE(PG8_SA(1, 1), a1 + hstep, voffA);
            PG8_WAIT_VR(relax); PG8_WAIT_L(0); PG8_BAR; PG8_MMA(0, 0, At, B0); PG8_MMA(0, 1, At, B1); PG8_BAR; PG8_SCHED;
            PG8_LDA(At, 0, 1); PG8_STAGE(PG8_SB(0, 0), b2, voffB); PG8_STAGE(PG8_SB(0, 1), b2 + hstep, voffB); PG8_STAGE(PG8_SA(0, 0), a2, voffA);
            PG8_WAIT_VR(relax); PG8_WAIT_L(0); PG8_BAR; PG8_MMA(1, 0, At, B0); PG8_MMA(1, 1, At, B1); PG8_BAR; PG8_SCHED;
            PG8_LDB(B0, 1, 0); PG8_LDB(B1, 1, 1); PG8_SCHED; PG8_LDA(At, 1, 0); PG8_STAGE(PG8_SA(0, 1), a2 + hstep, voffA);
            PG8_WAIT_V(8); PG8_WAIT_L(0); PG8_BAR; PG8_MMA(0, 0, At, B0); PG8_MMA(0, 1, At, B1); PG8_BAR; PG8_SCHED;
            PG8_LDA(At, 1, 1); PG8_STAGE(PG8_SB(1, 0), b3, voffB); PG8_STAGE(PG8_SB(1, 1), b3 + hstep, voffB); PG8_STAGE(PG8_SA(1, 0), a3, voffA);
            PG8_WAIT_V(8); PG8_WAIT_L(0); PG8_BAR; PG8_MMA(1, 0, At, B0); PG8_MMA(1, 1, At, B1); PG8_BAR; PG8_SCHED;
            } else {
            PG8_LDB(B0, 0, 0); PG8_SCHED; PG8_LDA(At, 0, 0); PG8_STAGE(PG8_SA(1, 1), a1 + hstep, voffA);
            PG8_WAIT_L(8); PG8_BAR; PG8_WAIT_L(0); PG8_MMA(0, 0, At, B0); PG8_BAR; PG8_SCHED;
            PG8_LDB(B1, 0, 1); PG8_STAGE(PG8_SB(0, 0), b2, voffB);
            PG8_BAR; PG8_WAIT_L(0); PG8_MMA(0, 1, At, B1); PG8_BAR;
            PG8_LDA(At, 0, 1); PG8_STAGE(PG8_SA(0, 0), a2, voffA);
            PG8_BAR; PG8_WAIT_L(0); PG8_MMA(1, 0, At, B0); PG8_BAR; PG8_SCHED;
            PG8_STAGE(PG8_SB(0, 1), b2 + hstep, voffB);
            PG8_WAIT_V(6); PG8_BAR; PG8_MMA(1, 1, At, B1); PG8_BAR;
            PG8_LDB(B0, 1, 0); PG8_SCHED; PG8_LDA(At, 1, 0); PG8_STAGE(PG8_SA(0, 1), a2 + hstep, voffA);
            PG8_WAIT_L(8); PG8_BAR; PG8_WAIT_L(0); PG8_MMA(0, 0, At, B0); PG8_BAR; PG8_SCHED;
            PG8_LDB(B1, 1, 1); PG8_STAGE(PG8_SB(1, 0), b3, voffB);
            PG8_BAR; PG8_WAIT_L(0); PG8_MMA(0, 1, At, B1); PG8_BAR;
            PG8_LDA(At, 1, 1); PG8_STAGE(PG8_SA(1, 0), a3, voffA);
            PG8_BAR; PG8_WAIT_L(0); PG8_MMA(1, 0, At, B0); PG8_BAR; PG8_SCHED;
            PG8_STAGE(PG8_SB(1, 1), b3 + hstep, voffB);
            PG8_WAIT_V(6); PG8_BAR; PG8_MMA(1, 1, At, B1); PG8_BAR;
            }
        }
#if PROBE_STAMP
        if (stamp_out && ui == 2 && wid == 0) { const unsigned long long st1_ = (PROBE_STAMP == 1) ? (unsigned long long)__builtin_amdgcn_s_memtime() : (unsigned long long)__builtin_amdgcn_s_memrealtime(); if (lane == 0) stamp_out[0] = st1_ - st0_; }
#endif
        if constexpr (ALIGN_EPI) { if (wr == 0) PG8_BAR; }
        if constexpr (!Epi::AFTER_DRAIN) { E(acc, cur, wr, wc, fr, fq, epi_lds); S.done(cur); }
        if (!has_next) break;
#pragma unroll
        for (int a = 0; a < 2; ++a)
#pragma unroll
            for (int b = 0; b < 2; ++b)
#pragma unroll
                for (int m = 0; m < 4; ++m)
#pragma unroll
                    for (int n = 0; n < 2; ++n) acc[a][b][m][n] = (f32x4){0.f, 0.f, 0.f, 0.f};
        cur = nxt; cA = nA; cB = nB; ++ui;
        E.prefetch(epi_lds, cur, wr, fr, fq);
        if constexpr (ALIGN_EPI) { if (wr == 1) PG8_BAR; }
    }
    PG8_WAIT_V(0);
    if constexpr (!ALIGN_EPI) { if (wr == 0) PG8_BAR; }
    PG8_BAR;
    if constexpr (Epi::AFTER_DRAIN) { E.fused(acc, cur, wr, wc, fr, fq, lds, wid, lane); S.done(cur); }
#undef PG8_SA
#undef PG8_SB
#undef PG8_STAGE
#undef PG8_LDA
#undef PG8_LDB
#undef PG8_MMA
#undef PG8_WAIT_V
#undef PG8_WAIT_L
#undef PG8_WAIT_VR
#undef PG8_BAR
#undef PG8_SCHED
}
}

#define GAS __attribute__((address_space(1)))
#define LAS __attribute__((address_space(3)))
typedef unsigned short bf16;
typedef unsigned v4u __attribute__((ext_vector_type(4)));
typedef float f32x4 __attribute__((ext_vector_type(4)));
typedef GAS unsigned gu32;
#define LDS_WAIT() asm volatile("s_waitcnt lgkmcnt(0)" ::: "memory")
#define VM_WAIT() asm volatile("s_waitcnt vmcnt(0)" ::: "memory")

__device__ __forceinline__ size_t t256_off(int m, int c, int ntn) { return ((size_t)(m >> 8) * ntn + (c >> 8)) * 65536 + (size_t)((m & 255) * 256 + (c & 255)); }
#define P_OFF(m_, c_) t256_off((m_), (c_), 32)
#define X_OFF(m_, c_) t256_off((m_), (c_), 8)

#define XB_TMO      128
#define XB_XCNT(j)  (256  + 64 * (j))
#define XB_XSUB(j)  (1280 + 64 * (j))
#define XB_XGEN(j)  (2304 + 64 * (j))
#define XB_TOP      3328
#define XB_TOPGEN   3392
#define XCD_BAR_WORDS 3456
#define XB_SPIN_CAP (1u << 18)

__device__ __forceinline__ unsigned xb_ld(unsigned* p)              { return __hip_atomic_load(p, __ATOMIC_RELAXED, __HIP_MEMORY_SCOPE_AGENT); }
__device__ __forceinline__ unsigned xb_add(unsigned* p, unsigned v) { return __hip_atomic_fetch_add(p, v, __ATOMIC_RELAXED, __HIP_MEMORY_SCOPE_AGENT); }
__device__ __forceinline__ unsigned xb_xcc_id() { return (unsigned)__builtin_amdgcn_s_getreg((3 << 11) | 20) & 0xFu; }
#define XB_SPIN(cond, bar) do { unsigned _sp = 0; while (cond) { __builtin_amdgcn_s_sleep(1); \
    if ((++_sp & 255u) == 0u) { if (xb_ld(&(bar)[XB_TMO])) break; if (_sp > XB_SPIN_CAP) { atomicAdd(&(bar)[XB_TMO], 1u); break; } } } } while (0)

struct XcdBarrier {
    unsigned* bar; unsigned x;
    volatile LAS unsigned* st;
};

__device__ __forceinline__ XcdBarrier xcd_barrier_post(unsigned* bar, volatile LAS unsigned* st) {
    XcdBarrier b; b.bar = bar; b.x = xb_xcc_id(); b.st = st;
    if (threadIdx.x == 0) (void)xb_add(&bar[XB_XCNT(b.x)], 1u);
    return b;
}
__device__ __forceinline__ void xcd_barrier_complete(unsigned* bar, unsigned x, unsigned& nloc, unsigned& nx) {
    const unsigned G = gridDim.x * gridDim.y * gridDim.z;
    unsigned sum, cnt, mine, sp = 0u;
    for (;;) {
        sum = 0u; cnt = 0u; mine = 0u;
#pragma unroll
        for (unsigned j = 0; j < 16; ++j) { const unsigned c = xb_ld(&bar[XB_XCNT(j)]); sum += c; cnt += (c > 0u) ? 1u : 0u; mine = (j == x) ? c : mine; }
        if (sum == G) break;
        __builtin_amdgcn_s_sleep(1);
        if ((++sp & 255u) == 0u) { if (xb_ld(&bar[XB_TMO])) break; if (sp > XB_SPIN_CAP) { atomicAdd(&bar[XB_TMO], 1u); break; } }
    }
    nloc = mine > 0u ? mine : 1u; nx = cnt > 0u ? cnt : 1u;
}

__device__ __forceinline__ void xcd_barrier(const XcdBarrier& b) {
    asm volatile("s_waitcnt vmcnt(0)" ::: "memory");
    __syncthreads();
    if (threadIdx.x == 0) {
        unsigned* bar = b.bar;
        __builtin_amdgcn_s_waitcnt(0);
        unsigned nloc = b.st[0], nx = b.st[1];
        if (nloc == 0u) { xcd_barrier_complete(bar, b.x, nloc, nx); b.st[0] = nloc; b.st[1] = nx; }
        const unsigned old = xb_add(&bar[XB_XSUB(b.x)], 1u);
        const unsigned gen = old / nloc;
        if (old + 1u == (gen + 1u) * nloc) {
            __builtin_amdgcn_fence(__ATOMIC_RELEASE, "agent");
            asm volatile("s_waitcnt vmcnt(0)" ::: "memory");
            const unsigned og = xb_add(&bar[XB_TOP], 1u);
            const unsigned tg = og / nx;
            if (og + 1u == (tg + 1u) * nx) xb_add(&bar[XB_TOPGEN], 1u);
            else XB_SPIN(xb_ld(&bar[XB_TOPGEN]) == tg, bar);
            __builtin_amdgcn_fence(__ATOMIC_ACQUIRE, "agent");
            xb_add(&bar[XB_XGEN(b.x)], 1u);
            asm volatile("s_waitcnt vmcnt(0)" ::: "memory");
        } else {
            XB_SPIN(xb_ld(&bar[XB_XGEN(b.x)]) == gen, bar);
            __builtin_amdgcn_fence(__ATOMIC_ACQUIRE, "agent");
            asm volatile("s_waitcnt vmcnt(0)" ::: "memory");
        }
    }
    __syncthreads();
}

namespace att {
using bf16x8 = __attribute__((ext_vector_type(8))) short;
using s16x4  = __attribute__((ext_vector_type(4))) short;
using f32x16 = __attribute__((ext_vector_type(16))) float;
using u32x4  = __attribute__((ext_vector_type(4))) unsigned;
constexpr int QBLK = 32, KVBLK = 64, NW = 8, DV = 128, DQK = 64;
constexpr float SCALE = 0.125f, THR = 8.f;
constexpr int ATT_LDP = 8192, ATT_LDO = 1024;
constexpr int SHM_V = KVBLK * DV * 2, SHM_K = KVBLK * DQK * 2, SHM_ATTN = 2 * SHM_V + 2 * SHM_K + NW * 64 * 4;
#define ATT_KSWZ(row, colB) ((row) * 128 + ((colB) ^ ((((row) >> 1) & 7) << 4)))
#define ATT_SBAR() __builtin_amdgcn_sched_barrier(0)
__device__ __forceinline__ int crow(int r, int hi) { return (r & 3) + 8 * (r >> 2) + 4 * hi; }
__device__ __forceinline__ unsigned cvtpk(float lo, float hi) { unsigned r; asm volatile("v_cvt_pk_bf16_f32 %0, %1, %2" : "=v"(r) : "v"(lo), "v"(hi)); return r; }

template <int PMODE> __device__ __forceinline__ void partialSM(f32x16& p0, f32x16& p1, float mbC) {
  constexpr float C = SCALE * 1.4426950408889634f;
#pragma unroll
  for (int r = 0; r < 16; ++r) p0[r] = fmaf(p0[r], C, -mbC);
#pragma unroll
  for (int r = 0; r < 16; ++r) p1[r] = fmaf(p1[r], C, -mbC);
#pragma unroll
  for (int r = 0; r < 16; ++r) p0[r] = (PMODE == 1) ? p0[r] : __builtin_amdgcn_exp2f(p0[r]);
}
template <int PMODE> __device__ __forceinline__ void finishSM(f32x16& p0, f32x16& p1, float& l_reg, bf16x8& pa0, bf16x8& pa1, bf16x8& pa2, bf16x8& pa3) {
#pragma unroll
  for (int r = 0; r < 16; ++r) p1[r] = (PMODE == 1) ? p1[r] : __builtin_amdgcn_exp2f(p1[r]);
  float ps = 0;
#pragma unroll
  for (int r = 0; r < 16; ++r) ps += p0[r];
#pragma unroll
  for (int r = 0; r < 16; ++r) ps += p1[r];
  { auto rr = __builtin_amdgcn_permlane32_swap(__float_as_uint(ps), __float_as_uint(ps), false, false);
    ps = __uint_as_float(rr[0]) + __uint_as_float(rr[1]); }
  l_reg += ps;
#define ATT_PK4(P, BASE, OUT) do { unsigned a0 = cvtpk(P[BASE + 0], P[BASE + 1]), a1 = cvtpk(P[BASE + 2], P[BASE + 3]);   \
    unsigned b0 = cvtpk(P[BASE + 4], P[BASE + 5]), b1 = cvtpk(P[BASE + 6], P[BASE + 7]);                              \
    auto r0 = __builtin_amdgcn_permlane32_swap(a0, b0, false, false); auto r1 = __builtin_amdgcn_permlane32_swap(a1, b1, false, false); \
    u32x4 w = {r0[0], r1[0], r0[1], r1[1]}; OUT = *reinterpret_cast<bf16x8*>(&w); } while (0)
  ATT_PK4(p0, 0, pa0); ATT_PK4(p0, 8, pa1); ATT_PK4(p1, 0, pa2); ATT_PK4(p1, 8, pa3);
#undef ATT_PK4
}
__device__ __forceinline__ void qkt(f32x16& p0, f32x16& p1, const char* Ks, const bf16x8 (&qr)[4], int r32, int hi) {
  p0 = f32x16{}; p1 = f32x16{};
#pragma unroll
  for (int d0 = 0; d0 < 4; ++d0) { const int cb = (d0 * 16 + hi * 8) * 2;
    bf16x8 b0 = *reinterpret_cast<const bf16x8*>(Ks + ATT_KSWZ(r32, cb));
    bf16x8 b1 = *reinterpret_cast<const bf16x8*>(Ks + ATT_KSWZ(32 + r32, cb));
    p0 = __builtin_amdgcn_mfma_f32_32x32x16_bf16(b0, qr[d0], p0, 0, 0, 0);
    p1 = __builtin_amdgcn_mfma_f32_32x32x16_bf16(b1, qr[d0], p1, 0, 0, 0); }
}
__device__ __forceinline__ int v_st(int k, int c) { const int kk = (k & ~0xC) | ((k & 4) << 1) | ((k & 8) >> 1); return ((kk >> 3) * 4 + (c >> 5)) * 512 + ((kk & 7) * 32 + (c & 31)) * 2; }
__device__ __forceinline__ int v_rd_base(int lane) { return ((lane & 3) << 3) | (((lane >> 2) & 3) << 6) | (((lane >> 4) & 1) << 5) | (((lane >> 5) & 1) << 8); }
constexpr int v_rd_off(int d0, int ks, int half) { return d0 * 512 + ks * 4096 + half * 2048; }
template <int OFF> __device__ __forceinline__ s16x4 tr_read(int vb) {
  s16x4 r; asm volatile("ds_read_b64_tr_b16 %0, %1 offset:%2" : "=&v"(r) : "v"(vb), "i"(OFF) : "memory"); return r;
}
template <int D0> __device__ __forceinline__ void pv_one(f32x16& od, int vb, bf16x8 pa0, bf16x8 pa1, bf16x8 pa2, bf16x8 pa3) {
  const s16x4 l0 = tr_read<v_rd_off(D0, 0, 0)>(vb), h0 = tr_read<v_rd_off(D0, 0, 1)>(vb), l1 = tr_read<v_rd_off(D0, 1, 0)>(vb), h1 = tr_read<v_rd_off(D0, 1, 1)>(vb);
  const s16x4 l2 = tr_read<v_rd_off(D0, 2, 0)>(vb), h2 = tr_read<v_rd_off(D0, 2, 1)>(vb), l3 = tr_read<v_rd_off(D0, 3, 0)>(vb), h3 = tr_read<v_rd_off(D0, 3, 1)>(vb);
  asm volatile("s_waitcnt lgkmcnt(0)" ::: "memory"); ATT_SBAR();
#define ATT_PK(L, H) (bf16x8){L[0], L[1], L[2], L[3], H[0], H[1], H[2], H[3]}
  od = __builtin_amdgcn_mfma_f32_32x32x16_bf16(pa0, ATT_PK(l0, h0), od, 0, 0, 0);
  od = __builtin_amdgcn_mfma_f32_32x32x16_bf16(pa1, ATT_PK(l1, h1), od, 0, 0, 0);
  od = __builtin_amdgcn_mfma_f32_32x32x16_bf16(pa2, ATT_PK(l2, h2), od, 0, 0, 0);
  od = __builtin_amdgcn_mfma_f32_32x32x16_bf16(pa3, ATT_PK(l3, h3), od, 0, 0, 0);
#undef ATT_PK
}
__device__ __forceinline__ void pv_d0(f32x16 (&o)[4], int vb, bf16x8 pa0, bf16x8 pa1, bf16x8 pa2, bf16x8 pa3) {
  pv_one<0>(o[0], vb, pa0, pa1, pa2, pa3); pv_one<1>(o[1], vb, pa0, pa1, pa2, pa3); pv_one<2>(o[2], vb, pa0, pa1, pa2, pa3); pv_one<3>(o[3], vb, pa0, pa1, pa2, pa3);
}
__device__ __forceinline__ unsigned short f2bf(float f) { unsigned u = __builtin_bit_cast(unsigned, f); return (unsigned short)((u + 0x7fffu + ((u >> 16) & 1u)) >> 16); }

template <int PMODE = 0> __device__ __forceinline__ void attn_unit(const unsigned short* __restrict__ Qb, const unsigned short* __restrict__ Kh, const unsigned short* __restrict__ Vh,
                                          unsigned short* __restrict__ Ob, int seq, char* lds, float mbC) {
  int tid_ = threadIdx.x; asm volatile("" : "+v"(tid_));
  const int tid = tid_, wid = tid >> 6, lane = tid & 63, r32 = lane & 31, hi = lane >> 5;
  char* V_lds = lds; char* K_lds = lds + 2 * SHM_V;
  float* wsf = (float*)(lds + 2 * SHM_V + 2 * SHM_K) + wid * 64; float* li_l = wsf;
  float l_reg = 0; f32x16 o[4] = {}; bf16x8 qr[4];
  const unsigned short* Qw = Qb + (long)(wid * QBLK + r32) * ATT_LDP + hi * 8;
#pragma unroll
  for (int d0 = 0; d0 < 4; ++d0) qr[d0] = *reinterpret_cast<const bf16x8*>(Qw + d0 * 16);
  const int sr = tid >> 4, sc = (tid & 15) * 8, vst0 = v_st(sr, sc), vst1 = v_st(32 + sr, sc);
  const int kr = tid >> 3, kc = (tid & 7) * 8, kst = ATT_KSWZ(kr, kc * 2);
  const int vb0 = (int)(uintptr_t)V_lds + v_rd_base(lane);
  bf16x8 s_vs0[2], s_vs1[2], s_ks[2];
#define ATT_SLOAD(i, k0) do { s_vs0[i] = *reinterpret_cast<const bf16x8*>(&Vh[(long)((k0) + sr) * ATT_LDP + sc]); s_vs1[i] = *reinterpret_cast<const bf16x8*>(&Vh[(long)((k0) + 32 + sr) * ATT_LDP + sc]); \
    s_ks[i] = *reinterpret_cast<const bf16x8*>(&Kh[(long)((k0) + kr) * ATT_LDP + kc]); } while (0)
#define ATT_SWRITE(b, i) do { *(bf16x8*)(V_lds + (b) * SHM_V + vst0) = s_vs0[i]; *(bf16x8*)(V_lds + (b) * SHM_V + vst1) = s_vs1[i]; \
    *(bf16x8*)(K_lds + (b) * SHM_K + kst) = s_ks[i]; } while (0)
#define ATT_SWAIT() asm volatile("s_waitcnt vmcnt(3)" ::: "memory")
  f32x16 pA0, pA1, pB0, pB1; bf16x8 pa0, pa1, pa2, pa3; const int NT = seq / KVBLK;
  ATT_SLOAD(0, 0); asm volatile("s_waitcnt vmcnt(0)" ::: "memory"); ATT_SWRITE(0, 0); __syncthreads();
  qkt(pA0, pA1, K_lds, qr, r32, hi); partialSM<PMODE>(pA0, pA1, mbC);
  ATT_SLOAD(1, KVBLK); if (2 < NT) ATT_SLOAD(0, 2 * KVBLK);
  ATT_SWAIT(); ATT_SWRITE(1, 1); __syncthreads();
  for (int j = 1; j + 1 < NT; j += 2) {
    ATT_SBAR(); qkt(pB0, pB1, K_lds + SHM_K, qr, r32, hi);
    finishSM<PMODE>(pA0, pA1, l_reg, pa0, pa1, pa2, pa3); ATT_SBAR();
    ATT_SLOAD(1, (j + 2) * KVBLK); ATT_SBAR();
    if (PMODE != 2) pv_d0(o, vb0, pa0, pa1, pa2, pa3); else { o[0][0] += __builtin_bit_cast(float, (int)pa0[0]); } partialSM<PMODE>(pB0, pB1, mbC);
    __syncthreads(); ATT_SWAIT(); ATT_SWRITE(0, 0);
    __syncthreads();
    ATT_SBAR(); qkt(pA0, pA1, K_lds, qr, r32, hi);
    finishSM<PMODE>(pB0, pB1, l_reg, pa0, pa1, pa2, pa3); ATT_SBAR();
    if (j + 3 < NT) ATT_SLOAD(0, (j + 3) * KVBLK); ATT_SBAR();
    if (PMODE != 2) pv_d0(o, vb0 + SHM_V, pa0, pa1, pa2, pa3); else { o[0][0] += __builtin_bit_cast(float, (int)pa1[0]); } partialSM<PMODE>(pA0, pA1, mbC);
    __syncthreads(); ATT_SWAIT(); ATT_SWRITE(1, 1);
    __syncthreads();
  }
  ATT_SBAR(); qkt(pB0, pB1, K_lds + SHM_K, qr, r32, hi);
  finishSM<PMODE>(pA0, pA1, l_reg, pa0, pa1, pa2, pa3); ATT_SBAR();
  if (PMODE != 2) pv_d0(o, vb0, pa0, pa1, pa2, pa3); else { o[0][0] += __builtin_bit_cast(float, (int)pa0[0]); } partialSM<PMODE>(pB0, pB1, mbC);
  __syncthreads();
  finishSM<PMODE>(pB0, pB1, l_reg, pa0, pa1, pa2, pa3); ATT_SBAR();
  if (PMODE != 2) pv_d0(o, vb0 + SHM_V, pa0, pa1, pa2, pa3); else { o[0][0] += __builtin_bit_cast(float, (int)pa1[0]); }
  if (hi == 0) li_l[r32] = l_reg; asm volatile("s_waitcnt lgkmcnt(0)" ::: "memory");
  float rli[16];
#pragma unroll
  for (int r = 0; r < 16; ++r) rli[r] = __builtin_amdgcn_rcpf(li_l[crow(r, hi)]);
  unsigned short* Ow = Ob + (long)(wid * QBLK) * ATT_LDO;
#pragma unroll
  for (int r = 0; r < 16; ++r) { const int orow = crow(r, hi);
#pragma unroll
    for (int d0 = 0; d0 < 4; ++d0) Ow[(long)orow * ATT_LDO + d0 * 32 + r32] = f2bf(o[d0][r] * rli[r]); }
#undef ATT_SLOAD
#undef ATT_SWRITE
#undef ATT_SWAIT
}
}

#ifndef W_DROP_BITS
#define W_DROP_BITS 0
#endif

constexpr int NWAVES = 8;
constexpr int D = 2048, BATCH = 16, SEQ = 2048, DEPTH = 4, M = BATCH * SEQ;
constexpr int DFF = 5504, NGU = 2 * DFF, DIN = 8192;
constexpr int C_HGQ = 0, C_HGI = 1024, C_HGZF = 2048, C_HGZB = 3072, C_HGG = 4096, C_DAQ = 5120, C_DAK = 5632, C_DAV = 6144, C_SCB = 6656, C_SCC = 7168, C_SCU = 7680;
constexpr float EPS = 1e-6f;
enum { I_X = 0, I_POS, I_F1N, I_F1G, I_F1U, I_F1D, I_MIXN, I_WIN, I_LB, I_HGN, I_DAQN, I_DAKN, I_LQ1, I_LK1, I_LQ2, I_LK2, I_DAON, I_CW, I_CB, I_CN, I_WOUT, I_F2N, I_F2G, I_F2U, I_F2D, N_IN };

constexpr size_t MiB = 1u << 20;
constexpr size_t WS_CTL = 0, CTL_ZERO_BYTES = 3 * MiB;
constexpr size_t WS_ROWSQ = 1 * MiB;
constexpr size_t WS_SMALL = 5 * MiB;
constexpr size_t WS_ROPE = 6 * MiB;
constexpr size_t SZ_WGU = (size_t)NGU * D * 2, SZ_WD = (size_t)D * DFF * 2, SZ_WIN = (size_t)DIN * D * 2, SZ_WOUT = (size_t)D * D * 2;
constexpr size_t WS_WGU = 14 * MiB;
constexpr size_t WS_WD = WS_WGU + 8 * SZ_WGU;
constexpr size_t WS_WIN = WS_WD + 8 * SZ_WD;
constexpr size_t WS_WOUT = WS_WIN + 4 * SZ_WIN;
constexpr size_t WS_H = WS_WOUT + 4 * SZ_WOUT;
constexpr size_t WS_P = WS_H + (size_t)M * D * 2;
constexpr size_t WS_OF = WS_P + (size_t)M * DIN * 2;
constexpr size_t WS_OA = WS_OF + (size_t)2 * M * 1024 * 2;
constexpr size_t WS_END = WS_OA + (size_t)M * 1024 * 2;
static_assert(WS_WGU % 256 == 0 && WS_WD % 256 == 0 && WS_WIN % 256 == 0 && WS_H % 256 == 0 && WS_P % 256 == 0 && WS_OF % 256 == 0 && WS_OA % 256 == 0, "ws alignment");
static_assert(WS_ROWSQ + (size_t)13 * M * 4 <= CTL_ZERO_BYTES, "rowsq slots inside the per-call memset");
constexpr int CW_BAR = 4096;

constexpr int RING_OFF = 0, RING_BYTES = 131072;
constexpr int LDSCTL_OFF = 146944, MISC_OFF = LDSCTL_OFF + 320;
constexpr int LDS_BYTES = 147456;
static_assert(MISC_OFF + 128 <= LDS_BYTES && LDSCTL_OFF >= RING_BYTES, "LDS map");

typedef unsigned v2u __attribute__((ext_vector_type(2)));
typedef float f32x2 __attribute__((ext_vector_type(2)));
__device__ __forceinline__ float wave_sum(float v) {
#pragma unroll
    for (int o = 1; o < 64; o <<= 1) v += __shfl_xor(v, o);
    return v;
}
__device__ __forceinline__ float bflo(unsigned w) { return __builtin_bit_cast(float, w << 16); }
__device__ __forceinline__ float bfhi(unsigned w) { return __builtin_bit_cast(float, w & 0xffff0000u); }
__device__ __forceinline__ void unpack8(const v4u w, float (&x)[8]) { x[0] = bflo(w.x); x[1] = bfhi(w.x); x[2] = bflo(w.y); x[3] = bfhi(w.y); x[4] = bflo(w.z); x[5] = bfhi(w.z); x[6] = bflo(w.w); x[7] = bfhi(w.w); }
__device__ __forceinline__ v4u pack8(const float (&x)[8]) { v4u w; w.x = pg8::cvt_pk_bf16(x[0], x[1]); w.y = pg8::cvt_pk_bf16(x[2], x[3]); w.z = pg8::cvt_pk_bf16(x[4], x[5]); w.w = pg8::cvt_pk_bf16(x[6], x[7]); return w; }

__constant__ double c_inv_freq[32] = {1.0, 0.7498942093324559, 0.5623413251903491, 0.4216965034285822, 0.31622776601683794, 0.23713737056616552, 0.1778279410038923, 0.1333521432163324, 0.1, 0.07498942093324558, 0.05623413251903491,
    0.042169650342858224, 0.03162277660168379, 0.023713737056616554, 0.01778279410038923, 0.01333521432163324, 0.01, 0.007498942093324558, 0.005623413251903491, 0.004216965034285823, 0.0031622776601683794, 0.0023713737056616554,
    0.0017782794100389228, 0.001333521432163324, 0.001, 0.0007498942093324559, 0.0005623413251903491, 0.00042169650342858224, 0.00031622776601683794, 0.00023713737056616554, 0.00017782794100389227, 0.0001333521432163324};
__constant__ float c_lam_init[4] = {0.20000000000000007f, 0.35550906759096934f, 0.4707130183435842f, 0.5560582041556406f};

__device__ __forceinline__ void p0_transpose_item(const float* W, int K, int N, bf16* WT, int gu, const float* gain, LAS float* scr, int item, int lane) {
    const int nblk = N / 32, kb = item / nblk, nb = item % nblk, k0 = 64 * kb, n0 = 32 * nb;
#pragma unroll
    for (int i = 0; i < 8; ++i) { const int kk = 8 * i + (lane >> 3), n4 = (lane & 7) * 4;
        f32x4 v = *(const GAS f32x4*)(W + (size_t)(k0 + kk) * N + n0 + n4); if (gain) v = v * gain[k0 + kk];
        LAS float* d = scr + kk * 33 + n4; d[0] = v.x; d[1] = v.y; d[2] = v.z; d[3] = v.w; }
    LDS_WAIT(); asm volatile("" ::: "memory");
    const int c = lane & 7;
#pragma unroll
    for (int j = 0; j < 4; ++j) { const int n = (lane >> 3) + 8 * j; const LAS float* s = scr + (8 * c) * 33 + n;
        v4u o; o.x = pg8::cvt_pk_bf16(s[0 * 33], s[1 * 33]); o.y = pg8::cvt_pk_bf16(s[2 * 33], s[3 * 33]); o.z = pg8::cvt_pk_bf16(s[4 * 33], s[5 * 33]); o.w = pg8::cvt_pk_bf16(s[6 * 33], s[7 * 33]);
        const int ns = n0 + n; const int dr = gu ? ((ns >> 7) * 256 + (gu - 1) * 128 + (ns & 127)) : ns;
        *(GAS v4u*)(WT + (size_t)dr * K + k0 + 8 * c) = o; }
    LDS_WAIT(); asm volatile("" ::: "memory");
}

constexpr int CONV_I_GU = (D / 64) * (DFF / 32), CONV_I_DN = (DFF / 64) * (D / 32), CONV_I_IN = (D / 64) * (DIN / 32), CONV_I_OUT = (D / 64) * (D / 32);
constexpr int CONV_PER_LAYER = 2 * (2 * CONV_I_GU + CONV_I_DN) + CONV_I_IN + CONV_I_OUT;
struct ConvItem { const float* W; bf16* WT; const float* gain; int K, N, gu, item; };
template <class ArgsT> __device__ __forceinline__ ConvItem conv_decode(const ArgsT& args, unsigned char* ws, int L, int r) {
    ConvItem c; c.gain = nullptr; c.K = D; c.N = DFF; c.gu = 0;
    const size_t oGU = (size_t)L * D * DFF;
    if (r < CONV_I_GU) { c.W = (const float*)args.in[I_F1G] + oGU; c.WT = (bf16*)(ws + WS_WGU + (size_t)(2 * L) * SZ_WGU); c.gu = 1; c.gain = (const float*)args.in[I_F1N] + (size_t)L * D; }
    else if ((r -= CONV_I_GU) < CONV_I_GU) { c.W = (const float*)args.in[I_F1U] + oGU; c.WT = (bf16*)(ws + WS_WGU + (size_t)(2 * L) * SZ_WGU); c.gu = 2; c.gain = (const float*)args.in[I_F1N] + (size_t)L * D; }
    else if ((r -= CONV_I_GU) < CONV_I_DN) { c.W = (const float*)args.in[I_F1D] + oGU; c.WT = (bf16*)(ws + WS_WD + (size_t)(2 * L) * SZ_WD); c.K = DFF; c.N = D; }
    else if ((r -= CONV_I_DN) < CONV_I_GU) { c.W = (const float*)args.in[I_F2G] + oGU; c.WT = (bf16*)(ws + WS_WGU + (size_t)(2 * L + 1) * SZ_WGU); c.gu = 1; c.gain = (const float*)args.in[I_F2N] + (size_t)L * D; }
    else if ((r -= CONV_I_GU) < CONV_I_GU) { c.W = (const float*)args.in[I_F2U] + oGU; c.WT = (bf16*)(ws + WS_WGU + (size_t)(2 * L + 1) * SZ_WGU); c.gu = 2; c.gain = (const float*)args.in[I_F2N] + (size_t)L * D; }
    else if ((r -= CONV_I_GU) < CONV_I_DN) { c.W = (const float*)args.in[I_F2D] + oGU; c.WT = (bf16*)(ws + WS_WD + (size_t)(2 * L + 1) * SZ_WD); c.K = DFF; c.N = D; }
    else if ((r -= CONV_I_DN) < CONV_I_IN) { c.W = (const float*)args.in[I_WIN] + (size_t)L * D * DIN; c.WT = (bf16*)(ws + WS_WIN + (size_t)L * SZ_WIN); c.N = DIN; c.gain = (const float*)args.in[I_MIXN] + (size_t)L * D; }
    else { r -= CONV_I_IN; c.W = (const float*)args.in[I_WOUT] + (size_t)L * D * D; c.WT = (bf16*)(ws + WS_WOUT + (size_t)L * SZ_WOUT); c.N = D; }
    c.item = r; return c;
}
constexpr int CONV_JIT_C = CONV_PER_LAYER / 2, CONV_JIT_P0 = DEPTH * CONV_PER_LAYER - (2 * DEPTH - 1) * CONV_JIT_C - CONV_I_DN;
template <class ArgsT> __device__ __forceinline__ ConvItem conv_decode_need(const ArgsT& args, unsigned char* ws, int q) {
    const int L = q / CONV_PER_LAYER; int s = q % CONV_PER_LAYER, r;
    constexpr int A0 = 2 * CONV_I_GU, A1 = A0 + CONV_I_DN, A2 = A1 + CONV_I_IN, A3 = A2 + CONV_I_OUT, A4 = A3 + 2 * CONV_I_GU;
    if (s < A1) r = s;
    else if (s < A2) r = 2 * (2 * CONV_I_GU + CONV_I_DN) + (s - A1);
    else if (s < A3) r = 2 * (2 * CONV_I_GU + CONV_I_DN) + CONV_I_IN + (s - A2);
    else if (s < A4) r = (2 * CONV_I_GU + CONV_I_DN) + (s - A3);
    else r = (2 * CONV_I_GU + CONV_I_DN) + 2 * CONV_I_GU + (s - A4);
    return conv_decode(args, ws, L, r);
}
__device__ __forceinline__ void conv_load(const ConvItem& c, f32x4 (&v)[8], float (&gv)[8], int lane) {
    const int nblk = c.N / 32, kb = c.item / nblk, nb = c.item % nblk, k0 = 64 * kb, n0 = 32 * nb;
#pragma unroll
    for (int i = 0; i < 8; ++i) { const int kk = 8 * i + (lane >> 3), n4 = (lane & 7) * 4;
        v[i] = *(const GAS f32x4*)(c.W + (size_t)(k0 + kk) * c.N + n0 + n4); gv[i] = c.gain ? c.gain[k0 + kk] : 1.0f; }
}
__device__ __forceinline__ void conv_finish(const ConvItem& c, const f32x4 (&v)[8], const float (&gv)[8], LAS float* scr, int lane) {
    const int nblk = c.N / 32, kb = c.item / nblk, nb = c.item % nblk, k0 = 64 * kb, n0 = 32 * nb;
#pragma unroll
    for (int i = 0; i < 8; ++i) { const int kk = 8 * i + (lane >> 3), n4 = (lane & 7) * 4; const f32x4 x = v[i] * gv[i];
        LAS float* d = scr + kk * 33 + n4; d[0] = x.x; d[1] = x.y; d[2] = x.z; d[3] = x.w; }
    LDS_WAIT(); asm volatile("" ::: "memory");
    const int cc = lane & 7;
#pragma unroll
    for (int j = 0; j < 4; ++j) { const int n = (lane >> 3) + 8 * j; const LAS float* s = scr + (8 * cc) * 33 + n;
        v4u o; o.x = pg8::cvt_pk_bf16(s[0 * 33], s[1 * 33]); o.y = pg8::cvt_pk_bf16(s[2 * 33], s[3 * 33]); o.z = pg8::cvt_pk_bf16(s[4 * 33], s[5 * 33]); o.w = pg8::cvt_pk_bf16(s[6 * 33], s[7 * 33]);
#if W_DROP_BITS > 0
        { constexpr unsigned C_ = (1u << (W_DROP_BITS - 1)) * 0x00010001u, M_ = ~(((1u << W_DROP_BITS) - 1u) * 0x00010001u); o.x = (o.x + C_) & M_; o.y = (o.y + C_) & M_; o.z = (o.z + C_) & M_; o.w = (o.w + C_) & M_; }
#endif
        const int ns = n0 + n; const int dr = c.gu ? ((ns >> 7) * 256 + (c.gu - 1) * 128 + (ns & 127)) : (EPI_WIDE ? ((ns & ~255) + ((ns >> 5) & 1) * 128 + ((ns >> 6) & 3) * 32 + (ns & 31)) : ns);
        *(GAS v4u*)(c.WT + (size_t)dr * c.K + k0 + 8 * cc) = o; }
    LDS_WAIT(); asm volatile("" ::: "memory");
}
template <bool NEED = false, class ArgsT> __device__ __forceinline__ void convert_items(const ArgsT& args, unsigned char* ws, int nl_per, int r, int r_end, int stride, int Lbase, LAS float* scr, int lane) {
    for (; r < r_end; r += 4 * stride) {
        ConvItem c0 = (NEED ? conv_decode_need(args, ws, r) : conv_decode(args, ws, Lbase + r / nl_per, r % nl_per)), c1 = c0, c2 = c0, c3 = c0;
        const bool h1 = r + stride < r_end, h2 = r + 2 * stride < r_end, h3 = r + 3 * stride < r_end;
        if (h1) c1 = (NEED ? conv_decode_need(args, ws, r + stride) : conv_decode(args, ws, Lbase + (r + stride) / nl_per, (r + stride) % nl_per));
        if (h2) c2 = (NEED ? conv_decode_need(args, ws, r + 2 * stride) : conv_decode(args, ws, Lbase + (r + 2 * stride) / nl_per, (r + 2 * stride) % nl_per));
        if (h3) c3 = (NEED ? conv_decode_need(args, ws, r + 3 * stride) : conv_decode(args, ws, Lbase + (r + 3 * stride) / nl_per, (r + 3 * stride) % nl_per));
        f32x4 v0[8], v1[8], v2[8], v3[8]; float g0[8], g1[8], g2[8], g3[8];
        conv_load(c0, v0, g0, lane); conv_load(c1, v1, g1, lane); conv_load(c2, v2, g2, lane); conv_load(c3, v3, g3, lane);
        conv_finish(c0, v0, g0, scr, lane);
        if (h1) conv_finish(c1, v1, g1, scr, lane);
        if (h2) conv_finish(c2, v2, g2, scr, lane);
        if (h3) conv_finish(c3, v3, g3, scr, lane);
    }
}

__device__ __forceinline__ void xcopy_phase(const float* x, bf16* XB, unsigned* rowsq, int gw, int NGW, int lane) {
    for (int m = gw; m < M; m += NGW) {
        const GAS f32x4* xr = (const GAS f32x4*)(x + (size_t)m * D) + lane;
        f32x4 v[8]; float s = 0.f;
#pragma unroll
        for (int j = 0; j < 8; ++j) { v[j] = xr[64 * j]; s += (v[j].x * v[j].x + v[j].y * v[j].y) + (v[j].z * v[j].z + v[j].w * v[j].w); }
        s = wave_sum(s);
        GAS v2u* o8 = (GAS v2u*)(XB + (size_t)m * D) + lane;
#pragma unroll
        for (int j = 0; j < 8; ++j) { v2u w; w.x = pg8::cvt_pk_bf16(v[j].x, v[j].y); w.y = pg8::cvt_pk_bf16(v[j].z, v[j].w); o8[64 * j] = w; }
        if (lane == 0) rowsq[m] = (unsigned)(s * pg8::RSQ_SCALE);
    }
}

__device__ __forceinline__ void prep_phase(bf16* P, const float* cosT, const float* sinT, const float* qg, const float* kg, int gw, int NGW, int lane) {
    const int grp = lane >> 2, sub = lane & 3;
    float ga1[8], ga2[8];
    { const float* gp = (grp < 8 ? qg : kg);
#pragma unroll
      for (int e = 0; e < 8; ++e) { ga1[e] = gp[sub * 8 + e]; ga2[e] = gp[32 + sub * 8 + e]; } }
    for (int m = gw; m < M; m += NGW) {
        bf16* row = P + (size_t)m * DIN;
        bf16* p1 = row + C_DAQ + grp * 64 + sub * 8; bf16* p2 = p1 + 32;
        const v4u a = *(const GAS v4u*)p1, b = *(const GAS v4u*)p2;
        const GAS f32x4* cp = (const GAS f32x4*)(cosT + (size_t)m * 32 + sub * 8); const GAS f32x4* sp = (const GAS f32x4*)(sinT + (size_t)m * 32 + sub * 8);
        const f32x4 cA = cp[0], cB = cp[1], sA = sp[0], sB = sp[1];
        float x1[8], x2[8]; unpack8(a, x1); unpack8(b, x2);
        float ss = 0.f;
#pragma unroll
        for (int e = 0; e < 8; ++e) ss += x1[e] * x1[e] + x2[e] * x2[e];
        ss += __shfl_xor(ss, 1); ss += __shfl_xor(ss, 2);
        const float rstd = 1.0f / sqrtf(ss * (1.0f / 64.0f) + EPS);
        const float cs[8] = {cA.x, cA.y, cA.z, cA.w, cB.x, cB.y, cB.z, cB.w}, sn[8] = {sA.x, sA.y, sA.z, sA.w, sB.x, sB.y, sB.z, sB.w};
        float o1[8], o2[8];
#pragma unroll
        for (int e = 0; e < 8; ++e) { const float y1 = x1[e] * rstd * ga1[e], y2 = x2[e] * rstd * ga2[e]; o1[e] = y1 * cs[e] - y2 * sn[e]; o2[e] = y2 * cs[e] + y1 * sn[e]; }
        *(GAS v4u*)p1 = pack8(o1); *(GAS v4u*)p2 = pack8(o2);
    }
}

__device__ __forceinline__ void combine_phase(const bf16* P, const bf16* OA, bf16* Y, const float* hgn, const float* daon, const float* lq1, const float* lk1, const float* lq2, const float* lk2, float lam_init,
                                              const float* cw, const float* cb, const float* cn, int gw, int NGW, int lane) {
    const float d1 = wave_sum(lq1[lane] * lk1[lane]), d2 = wave_sum(lq2[lane] * lk2[lane]);
    const float lam = expf(d1) - expf(d2) + lam_init;
    const int ca = lane * 16, c8 = lane * 8;
    const int head = lane >> 4, v0 = (lane & 15) * 8;
    float ga[16], gb[8], w0[8], w1[8], w2[8], bb[8], gn[8];
#pragma unroll
    for (int e = 0; e < 16; ++e) ga[e] = hgn[ca + e];
#pragma unroll
    for (int e = 0; e < 8; ++e) { gb[e] = daon[c8 + e] * (1.0f - lam_init); w0[e] = cw[c8 + e]; w1[e] = cw[512 + c8 + e]; w2[e] = cw[1024 + c8 + e]; bb[e] = cb[c8 + e]; gn[e] = cn[c8 + e]; }
    for (int m = gw; m < M; m += NGW) {
        const int s = m & (SEQ - 1);
        const bf16* row = P + (size_t)m * DIN;
        const bf16* rowp = (s > 0) ? row - DIN : row; const bf16* rown = (s < SEQ - 1) ? row + DIN : row;
        const float fp = (s > 0) ? 1.f : 0.f, fn = (s < SEQ - 1) ? 1.f : 0.f;
        const bf16* f0 = row + C_HGZF + ca; const bf16* f1 = row + C_HGZB + ca; const bf16* gp = row + C_HGG + ca;
        const bf16* ap = OA + (size_t)m * 1024 + head * 256 + v0;
        const v4u L0 = *(const GAS v4u*)f0, L1 = *(const GAS v4u*)(f0 + 8), L2 = *(const GAS v4u*)f1, L3 = *(const GAS v4u*)(f1 + 8), L4 = *(const GAS v4u*)gp, L5 = *(const GAS v4u*)(gp + 8);
        const v4u L6 = *(const GAS v4u*)ap, L7 = *(const GAS v4u*)(ap + 128);
        const v4u L8 = *(const GAS v4u*)(row + C_SCC + c8), L9 = *(const GAS v4u*)(row + C_SCU + c8), L10 = *(const GAS v4u*)(rowp + C_SCC + c8), L11 = *(const GAS v4u*)(rowp + C_SCU + c8);
        const v4u L12 = *(const GAS v4u*)(rown + C_SCC + c8), L13 = *(const GAS v4u*)(rown + C_SCU + c8), L14 = *(const GAS v4u*)(row + C_SCB + c8);
        {
            float a[16], b[16], g[16]; float t[8];
            unpack8(L0, t);
#pragma unroll
            for (int e = 0; e < 8; ++e) a[e] = t[e];
            unpack8(L1, t);
#pragma unroll
            for (int e = 0; e < 8; ++e) a[8 + e] = t[e];
            unpack8(L2, t);
#pragma unroll
            for (int e = 0; e < 8; ++e) b[e] = t[e];
            unpack8(L3, t);
#pragma unroll
            for (int e = 0; e < 8; ++e) b[8 + e] = t[e];
            unpack8(L4, t);
#pragma unroll
            for (int e = 0; e < 8; ++e) g[e] = t[e];
            unpack8(L5, t);
#pragma unroll
            for (int e = 0; e < 8; ++e) g[8 + e] = t[e];
            float ss = 0.f;
#pragma unroll
            for (int e = 0; e < 16; ++e) { a[e] += b[e]; ss += a[e] * a[e]; }
            ss += __shfl_xor(ss, 1); ss += __shfl_xor(ss, 2); ss += __shfl_xor(ss, 4);
            const float rstd = 1.0f / sqrtf(ss * (1.0f / 128.0f) + EPS);
            float o0[8], o1[8];
#pragma unroll
            for (int e = 0; e < 8; ++e) { const float g0 = g[e], g1 = g[8 + e];
                o0[e] = a[e] * rstd * ga[e] * (g0 * __builtin_amdgcn_rcpf(1.0f + __expf(-g0))); o1[e] = a[8 + e] * rstd * ga[8 + e] * (g1 * __builtin_amdgcn_rcpf(1.0f + __expf(-g1))); }
            GAS v4u* yp = (GAS v4u*)(Y + (size_t)m * D + ca); yp[0] = pack8(o0); yp[1] = pack8(o1);
        }
        {
            float a0[8], a1[8]; unpack8(L6, a0); unpack8(L7, a1);
            float ss = 0.f;
#pragma unroll
            for (int e = 0; e < 8; ++e) { a0[e] = a0[e] - lam * a1[e]; ss += a0[e] * a0[e]; }
            ss += __shfl_xor(ss, 1); ss += __shfl_xor(ss, 2); ss += __shfl_xor(ss, 4); ss += __shfl_xor(ss, 8);
            const float rstd = 1.0f / sqrtf(ss * (1.0f / 128.0f) + EPS);
#pragma unroll
            for (int e = 0; e < 8; ++e) a0[e] = a0[e] * rstd * gb[e];
            *(GAS v4u*)(Y + (size_t)m * D + 1024 + c8) = pack8(a0);
        }
        {
            float cc[8], uc[8], cpv[8], upv[8], cnx[8], unx[8], bg[8];
            unpack8(L8, cc); unpack8(L9, uc); unpack8(L10, cpv); unpack8(L11, upv); unpack8(L12, cnx); unpack8(L13, unx); unpack8(L14, bg);
            float y[8]; float ss = 0.f;
#pragma unroll
            for (int e = 0; e < 8; ++e) { y[e] = (bb[e] + w0[e] * (cpv[e] * upv[e] * fp) + w1[e] * (cc[e] * uc[e]) + w2[e] * (cnx[e] * unx[e] * fn)) * bg[e]; ss += y[e] * y[e]; }
            ss += __shfl_xor(ss, 1); ss += __shfl_xor(ss, 2); ss += __shfl_xor(ss, 4); ss += __shfl_xor(ss, 8);
            const float rstd = 1.0f / sqrtf(ss * (1.0f / 128.0f) + EPS);
#pragma unroll
            for (int e = 0; e < 8; ++e) y[e] = y[e] * rstd * gn[e];
            *(GAS v4u*)(Y + (size_t)m * D + 1536 + c8) = pack8(y);
        }
    }
}

__device__ __forceinline__ void scan_unit_v1(const bf16* P, const float* lbt, bf16* OFd, int b, int h, int dir, LAS unsigned char* ldsb, int tid) {
    LAS float* Fs = (LAS float*)ldsb; LAS float* Ks = Fs + 4096; LAS float* Qs = Ks + 4096; LAS float* Vs = Qs + 4096; LAS float* Os = Vs + 4096;
    const int lane = tid & 63, wv = tid >> 6, v = wv * 16 + (lane & 15), kq = lane >> 4;
    const int tok = tid >> 4, ch0 = (tid & 15) * 8;
    float lbv[8];
#pragma unroll
    for (int e = 0; e < 8; ++e) lbv[e] = lbt[h * 128 + ch0 + e];
    float S[32];
#pragma unroll
    for (int j = 0; j < 32; ++j) S[j] = 0.f;
    const int zc = (dir ? C_HGZB : C_HGZF) + h * 128 + ch0;
    for (int blk = 0; blk < SEQ / 32; ++blk) {
        const int tau = blk * 32 + tok, s = dir ? (SEQ - 1 - tau) : tau; const size_t m = (size_t)b * SEQ + s;
        const bf16* row = P + m * DIN;
        { float q[8], iv[8], z[8], f[8], kk[8];
          unpack8(*(const GAS v4u*)(row + C_HGQ + h * 128 + ch0), q); unpack8(*(const GAS v4u*)(row + C_HGI + h * 128 + ch0), iv); unpack8(*(const GAS v4u*)(row + zc), z);
#pragma unroll
          for (int e = 0; e < 8; ++e) { const float ex = __expf(-z[e]); const float sg = 1.0f / (1.0f + ex); const float om = 1.0f - lbv[e]; f[e] = lbv[e] + om * sg; kk[e] = om * (ex * sg); }
          LAS f32x4* d;
          d = (LAS f32x4*)(Fs + tok * 128 + ch0); d[0] = (f32x4){f[0], f[1], f[2], f[3]}; d[1] = (f32x4){f[4], f[5], f[6], f[7]};
          d = (LAS f32x4*)(Ks + tok * 128 + ch0); d[0] = (f32x4){kk[0], kk[1], kk[2], kk[3]}; d[1] = (f32x4){kk[4], kk[5], kk[6], kk[7]};
          d = (LAS f32x4*)(Qs + tok * 128 + ch0); d[0] = (f32x4){q[0], q[1], q[2], q[3]}; d[1] = (f32x4){q[4], q[5], q[6], q[7]};
          d = (LAS f32x4*)(Vs + tok * 128 + ch0); d[0] = (f32x4){iv[0], iv[1], iv[2], iv[3]}; d[1] = (f32x4){iv[4], iv[5], iv[6], iv[7]}; }
        __syncthreads();
#pragma unroll 1
        for (int t = 0; t < 32; ++t) {
            const float vv = Vs[t * 128 + v]; float acc = 0.f;
            const LAS f32x4* fp = (const LAS f32x4*)(Fs + t * 128 + kq * 32); const LAS f32x4* kp = (const LAS f32x4*)(Ks + t * 128 + kq * 32); const LAS f32x4* qp = (const LAS f32x4*)(Qs + t * 128 + kq * 32);
#pragma unroll
            for (int j4 = 0; j4 < 8; ++j4) { const f32x4 f4 = fp[j4], k4 = kp[j4], q4 = qp[j4];
                S[4 * j4 + 0] = f4.x * S[4 * j4 + 0] + k4.x * vv; acc += S[4 * j4 + 0] * q4.x;
                S[4 * j4 + 1] = f4.y * S[4 * j4 + 1] + k4.y * vv; acc += S[4 * j4 + 1] * q4.y;
                S[4 * j4 + 2] = f4.z * S[4 * j4 + 2] + k4.z * vv; acc += S[4 * j4 + 2] * q4.z;
                S[4 * j4 + 3] = f4.w * S[4 * j4 + 3] + k4.w * vv; acc += S[4 * j4 + 3] * q4.w; }
            acc += __shfl_xor(acc, 16); acc += __shfl_xor(acc, 32);
            if (kq == 0) Os[t * 128 + v] = acc;
        }
        __syncthreads();
        { const LAS f32x4* op = (const LAS f32x4*)(Os + tok * 128 + ch0); const f32x4 oA = op[0], oB = op[1];
          const float o8[8] = {oA.x, oA.y, oA.z, oA.w, oB.x, oB.y, oB.z, oB.w};
          *(GAS v4u*)(OFd + m * 1024 + h * 128 + ch0) = pack8(o8); }
    }
    __syncthreads();
}


namespace sc2 {
typedef short bf16x8 __attribute__((ext_vector_type(8)));
typedef float f32x4 __attribute__((ext_vector_type(4)));
typedef float f32x2 __attribute__((ext_vector_type(2)));
typedef unsigned u32x2 __attribute__((ext_vector_type(2)));
typedef unsigned u32x4 __attribute__((ext_vector_type(4)));
constexpr int CH = 32;
constexpr int RS_RAW = 256;
constexpr int O_RZ = 0, O_RQ = 8192, O_RV = 16384, O_TOT = 24576;
constexpr int RS_QI = 272;
constexpr int O_QI = 28672, O_KI = O_QI + 32 * RS_QI;
constexpr int RS_T = 80;
constexpr int O_KHT = O_KI + 32 * RS_QI, O_VT = O_KHT + 128 * RS_T;
constexpr int O_DK = O_VT + 128 * RS_T;
constexpr int RS_OB = 528;
constexpr int O_OB = O_DK + 512;
constexpr int LDS_END = O_OB + 32 * RS_OB;
static_assert(LDS_END <= 131072 && O_QI % 16 == 0 && O_KHT % 16 == 0 && O_DK % 16 == 0 && O_OB % 16 == 0, "scan LDS map");
typedef __bf16 bf16v2 __attribute__((ext_vector_type(2)));
__device__ __forceinline__ unsigned pk(float lo, float hi) { const f32x2 v = {lo, hi}; return __builtin_bit_cast(unsigned, __builtin_convertvector(v, bf16v2)); }
__device__ __forceinline__ bf16x8 mk8(u32x2 a, u32x2 b) { u32x4 w = {a.x, a.y, b.x, b.y}; return __builtin_bit_cast(bf16x8, w); }
#define SC2_MFMA(a, b, c) __builtin_amdgcn_mfma_f32_16x16x32_bf16((a), (b), (c), 0, 0, 0)

__device__ __forceinline__ void scan_unit(unsigned short* P, const float* lbt, int b, int h, int dir, LAS unsigned char* L, int tid_in) {
    int tid = tid_in; asm volatile("" : "+v"(tid));
    const int lane = tid & 63, w = __builtin_amdgcn_readfirstlane(tid >> 6), c16 = lane & 15, g = lane >> 4;
    const int tok = tid >> 4, ch0 = (tid & 15) * 8;
    const int kp = lane;
    const float lb0 = lbt[h * 128 + 2 * kp], lb1 = lbt[h * 128 + 2 * kp + 1];
    const float om0 = 1.0f - lb0, om1 = 1.0f - lb1;
    const int zc = (dir ? C_HGZB : C_HGZF) + h * 128 + ch0;
    f32x4 S[8];
#pragma unroll
    for (int i = 0; i < 8; ++i) S[i] = (f32x4){0.f, 0.f, 0.f, 0.f};
    v4u rq, rz, rv;
    { const int s = dir ? (SEQ - 1 - tok) : tok; const unsigned short* row = P + ((size_t)b * SEQ + s) * DIN;
      rq = *(const GAS v4u*)(row + C_HGQ + h * 128 + ch0); rv = *(const GAS v4u*)(row + C_HGI + h * 128 + ch0); rz = *(const GAS v4u*)(row + zc); }
    *(LAS v4u*)(L + O_RQ + tok * RS_RAW + ch0 * 2) = rq; *(LAS v4u*)(L + O_RV + tok * RS_RAW + ch0 * 2) = rv; *(LAS v4u*)(L + O_RZ + tok * RS_RAW + ch0 * 2) = rz;
    __syncthreads();
#pragma unroll 1
    for (int c = 0; c < SEQ / CH; ++c) {
        if (c > 0) { const int tau = (c - 1) * CH + tok, s = dir ? (SEQ - 1 - tau) : tau;
            const LAS f32x4* op = (const LAS f32x4*)(L + O_OB + tok * RS_OB + ch0 * 4); const f32x4 oA = op[0], oB = op[1];
            v4u o; o.x = pk(oA.x, oA.y); o.y = pk(oA.z, oA.w); o.z = pk(oB.x, oB.y); o.w = pk(oB.z, oB.w);
            *(GAS v4u*)(P + ((size_t)b * SEQ + s) * DIN + zc) = o; }
        if (c + 1 < SEQ / CH) { const int tau = (c + 1) * CH + tok, s = dir ? (SEQ - 1 - tau) : tau; const unsigned short* row = P + ((size_t)b * SEQ + s) * DIN;
            rq = *(const GAS v4u*)(row + C_HGQ + h * 128 + ch0); rv = *(const GAS v4u*)(row + C_HGI + h * 128 + ch0); rz = *(const GAS v4u*)(row + zc); }
        float c0[4], c1[4], kk0[4], kk1[4];
        { float a0 = 0.f, a1 = 0.f;
#pragma unroll
          for (int i = 0; i < 4; ++i) { const unsigned zw = *(const LAS unsigned*)(L + O_RZ + (4 * w + i) * RS_RAW + kp * 4);
              const float z0 = fminf(fmaxf(bflo(zw), -30.f), 30.f), z1 = fminf(fmaxf(bfhi(zw), -30.f), 30.f);
              const float e0 = __expf(-z0), e1 = __expf(-z1); const float s0 = __builtin_amdgcn_rcpf(1.0f + e0), s1 = __builtin_amdgcn_rcpf(1.0f + e1);
              const float f0 = lb0 + om0 * s0, f1 = lb1 + om1 * s1; kk0[i] = om0 * (e0 * s0); kk1[i] = om1 * (e1 * s1);
              a0 += __logf(f0); a1 += __logf(f1); c0[i] = a0; c1[i] = a1; }
          *(LAS f32x2*)(L + O_TOT + (w * 128 + 2 * kp) * 4) = (f32x2){a0, a1}; }
        __syncthreads();
        { float off0 = 0.f, off1 = 0.f, end0 = 0.f, end1 = 0.f;
#pragma unroll
          for (int ww = 0; ww < 8; ++ww) { const f32x2 t = *(const LAS f32x2*)(L + O_TOT + (ww * 128 + 2 * kp) * 4); end0 += t.x; end1 += t.y; if (ww < w) { off0 += t.x; off1 += t.y; } }
          float kh0[4], kh1[4]; unsigned vw[4];
#pragma unroll
          for (int i = 0; i < 4; ++i) { const int tau = 4 * w + i;
              const unsigned qw = *(const LAS unsigned*)(L + O_RQ + tau * RS_RAW + kp * 4); vw[i] = *(const LAS unsigned*)(L + O_RV + tau * RS_RAW + kp * 4);
              const float cu0 = off0 + c0[i], cu1 = off1 + c1[i];
              const float eq0 = __expf(cu0), eq1 = __expf(cu1), ek0 = __expf(fminf(-cu0, 60.f)), ek1 = __expf(fminf(-cu1, 60.f));
              kh0[i] = kk0[i] * __expf(end0 - cu0); kh1[i] = kk1[i] * __expf(end1 - cu1);
              *(LAS unsigned*)(L + O_QI + tau * RS_QI + kp * 4) = pk(bflo(qw) * eq0, bfhi(qw) * eq1);
              *(LAS unsigned*)(L + O_KI + tau * RS_QI + kp * 4) = pk(kk0[i] * ek0, kk1[i] * ek1); }
          *(LAS u32x2*)(L + O_KHT + (2 * kp) * RS_T + 8 * w) = (u32x2){pk(kh0[0], kh0[1]), pk(kh0[2], kh0[3])};
          *(LAS u32x2*)(L + O_KHT + (2 * kp + 1) * RS_T + 8 * w) = (u32x2){pk(kh1[0], kh1[1]), pk(kh1[2], kh1[3])};
          *(LAS u32x2*)(L + O_VT + (2 * kp) * RS_T + 8 * w) = (u32x2){(vw[0] & 0xffffu) | (vw[1] << 16), (vw[2] & 0xffffu) | (vw[3] << 16)};
          *(LAS u32x2*)(L + O_VT + (2 * kp + 1) * RS_T + 8 * w) = (u32x2){(vw[0] >> 16) | (vw[1] & 0xffff0000u), (vw[2] >> 16) | (vw[3] & 0xffff0000u)};
          if (w == 0) *(LAS f32x2*)(L + O_DK + 2 * kp * 4) = (f32x2){__expf(end0), __expf(end1)}; }
        __syncthreads();
        { const bf16x8 vf = mk8(*(const LAS u32x2*)(L + O_VT + (16 * w + c16) * RS_T + 8 * g), *(const LAS u32x2*)(L + O_VT + (16 * w + c16) * RS_T + 32 + 8 * g));
          bf16x8 qf[2][4], kf[2][4];
#pragma unroll
          for (int tb = 0; tb < 2; ++tb)
#pragma unroll
              for (int ks = 0; ks < 4; ++ks) { const int ro = (16 * tb + c16) * RS_QI + (32 * ks + 4 * g) * 2;
                  qf[tb][ks] = mk8(*(const LAS u32x2*)(L + O_QI + ro), *(const LAS u32x2*)(L + O_QI + ro + 32));
                  kf[tb][ks] = mk8(*(const LAS u32x2*)(L + O_KI + ro), *(const LAS u32x2*)(L + O_KI + ro + 32)); }
          f32x4 p00 = {0.f, 0.f, 0.f, 0.f}, p01 = p00, p11 = p00;
#pragma unroll
          for (int ks = 0; ks < 4; ++ks) { p00 = SC2_MFMA(kf[0][ks], qf[0][ks], p00); p01 = SC2_MFMA(kf[0][ks], qf[1][ks], p01); p11 = SC2_MFMA(kf[1][ks], qf[1][ks], p11); }
#pragma unroll
          for (int r = 0; r < 4; ++r) { const bool keep = (4 * g + r) <= c16; p00[r] = keep ? p00[r] : 0.f; p11[r] = keep ? p11[r] : 0.f; }
          const bf16x8 pa0 = mk8((u32x2){pk(p00[0], p00[1]), pk(p00[2], p00[3])}, (u32x2){0u, 0u});
          const bf16x8 pa1 = mk8((u32x2){pk(p01[0], p01[1]), pk(p01[2], p01[3])}, (u32x2){pk(p11[0], p11[1]), pk(p11[2], p11[3])});
          f32x4 o0 = {0.f, 0.f, 0.f, 0.f}, o1 = o0;
          o0 = SC2_MFMA(pa0, vf, o0); o1 = SC2_MFMA(pa1, vf, o1);
#pragma unroll
          for (int ks = 0; ks < 4; ++ks) { const bf16x8 sf = mk8((u32x2){pk(S[2 * ks][0], S[2 * ks][1]), pk(S[2 * ks][2], S[2 * ks][3])}, (u32x2){pk(S[2 * ks + 1][0], S[2 * ks + 1][1]), pk(S[2 * ks + 1][2], S[2 * ks + 1][3])});
              o0 = SC2_MFMA(qf[0][ks], sf, o0); o1 = SC2_MFMA(qf[1][ks], sf, o1); }
#pragma unroll
          for (int kb = 0; kb < 8; ++kb) { const int ro = (16 * kb + c16) * RS_T + 8 * g;
              const bf16x8 hf = mk8(*(const LAS u32x2*)(L + O_KHT + ro), *(const LAS u32x2*)(L + O_KHT + ro + 32));
              const f32x4 dv = *(const LAS f32x4*)(L + O_DK + (16 * kb + 4 * g) * 4);
              S[kb] = S[kb] * dv; S[kb] = SC2_MFMA(hf, vf, S[kb]); }
#pragma unroll
          for (int r = 0; r < 4; ++r) { *(LAS float*)(L + O_OB + (4 * g + r) * RS_OB + (16 * w + c16) * 4) = o0[r]; *(LAS float*)(L + O_OB + (16 + 4 * g + r) * RS_OB + (16 * w + c16) * 4) = o1[r]; } }
        if (c + 1 < SEQ / CH) { *(LAS v4u*)(L + O_RQ + tok * RS_RAW + ch0 * 2) = rq; *(LAS v4u*)(L + O_RV + tok * RS_RAW + ch0 * 2) = rv; *(LAS v4u*)(L + O_RZ + tok * RS_RAW + ch0 * 2) = rz; }
        __syncthreads();
    }
    { const int tau = (SEQ / CH - 1) * CH + tok, s = dir ? (SEQ - 1 - tau) : tau;
      const LAS f32x4* op = (const LAS f32x4*)(L + O_OB + tok * RS_OB + ch0 * 4); const f32x4 oA = op[0], oB = op[1];
      v4u o; o.x = pk(oA.x, oA.y); o.y = pk(oA.z, oA.w); o.z = pk(oB.x, oB.y); o.w = pk(oB.z, oB.w);
      *(GAS v4u*)(P + ((size_t)b * SEQ + s) * DIN + zc) = o; }
    __syncthreads();
}
#undef SC2_MFMA
}


#ifndef SCAN_XPRIO
#define SCAN_XPRIO 0
#endif
namespace sc3 {
using sc2::bf16x8; using sc2::f32x4; using sc2::f32x2; using sc2::u32x2; using sc2::u32x4; using sc2::pk; using sc2::mk8;
constexpr int CH = 32, NCH = SEQ / CH;
constexpr int RS_RAW = 256, RAW_BYTES = 3 * 8192;
constexpr int RS_QI = 272, RS_T = 80, RS_OB = 272;
constexpr int IMG_QI = 0, IMG_KI = 32 * RS_QI, IMG_KHT = 2 * 32 * RS_QI, IMG_VT = IMG_KHT + 128 * RS_T, IMG_DK = IMG_VT + 128 * RS_T, IMG_BYTES = IMG_DK + 512;
constexpr int O_RAW = 0, O_IMG = 2 * RAW_BYTES, O_OB = O_IMG + 2 * IMG_BYTES, OB_BYTES = 32 * RS_OB, LDS_END = O_OB + 2 * OB_BYTES;
static_assert(LDS_END <= LDSCTL_OFF, "scan v3 LDS map");
static_assert(IMG_BYTES % 16 == 0 && O_IMG % 16 == 0 && O_OB % 16 == 0, "alignment");
#define SC3_MFMA(a, b, c) __builtin_amdgcn_mfma_f32_16x16x32_bf16((a), (b), (c), 0, 0, 0)

template <int PROBE_OUT = 0> __device__ __forceinline__ void scan_unit(unsigned short* P, const float* lbt, int b, int h, int dir, LAS unsigned char* L, int tid_in, unsigned short* Yp = nullptr) {
    int tid = tid_in; asm volatile("" : "+v"(tid));
    const int lane = tid & 63, w = __builtin_amdgcn_readfirstlane(tid >> 6);
    const int zcol = (dir ? C_HGZB : C_HGZF) + h * 128, qcol = C_HGQ + h * 128, vcol = C_HGI + h * 128;
    const int xt = tid & 255;
    const int k = 32 * (w & 3) + (lane & 31), hf = lane >> 5;
    const int kp_ = (k & ~31) + 8 * ((k >> 2) & 3) + 4 * ((k >> 4) & 1) + (k & 3);
    float lb = 0.f, om = 1.f;
    const int c16 = lane & 15, g = lane >> 4, wy = w & 3;
    f32x4 S[2][8];
#pragma unroll
    for (int sl = 0; sl < 2; ++sl)
#pragma unroll
        for (int i = 0; i < 8; ++i) S[sl][i] = (f32x4){0.f, 0.f, 0.f, 0.f};
    if (w < 4) { lb = lbt[h * 128 + k]; om = 1.0f - lb; }
#if SCAN_XPRIO
    if (w < 4) __builtin_amdgcn_s_setprio(SCAN_XPRIO);
#endif

#define SC3_ROW(cidx, tau) (P + ((size_t)b * SEQ + (dir ? (SEQ - 1 - ((cidx) * CH + (tau))) : ((cidx) * CH + (tau)))) * DIN)
#define SC3_DMA(cidx, par) do { const unsigned short* r0_ = SC3_ROW(cidx, xt >> 4); const unsigned short* r1_ = SC3_ROW(cidx, 16 + (xt >> 4)); const int co_ = (xt & 15) * 8; \
        LAS unsigned char* rb_ = L + O_RAW + (par) * RAW_BYTES + w * 1024; \
        __builtin_amdgcn_global_load_lds((const unsigned*)(r0_ + zcol + co_), (LAS unsigned*)(rb_), 16, 0, 0);         __builtin_amdgcn_global_load_lds((const unsigned*)(r1_ + zcol + co_), (LAS unsigned*)(rb_ + 4096), 16, 0, 0); \
        __builtin_amdgcn_global_load_lds((const unsigned*)(r0_ + qcol + co_), (LAS unsigned*)(rb_ + 8192), 16, 0, 0);  __builtin_amdgcn_global_load_lds((const unsigned*)(r1_ + qcol + co_), (LAS unsigned*)(rb_ + 8192 + 4096), 16, 0, 0); \
        __builtin_amdgcn_global_load_lds((const unsigned*)(r0_ + vcol + co_), (LAS unsigned*)(rb_ + 16384), 16, 0, 0); __builtin_amdgcn_global_load_lds((const unsigned*)(r1_ + vcol + co_), (LAS unsigned*)(rb_ + 16384 + 4096), 16, 0, 0); } while (0)
#define SC3_DMA_WAIT() asm volatile("s_waitcnt vmcnt(0)" ::: "memory")
#define SC3_IMAGES(par) do { \
        const LAS unsigned char* rw_ = L + O_RAW + (par) * RAW_BYTES + (16 * hf) * RS_RAW + k * 2; LAS unsigned char* im_ = L + O_IMG + (par) * IMG_BYTES; \
        unsigned zr_[16], qr_[16], vr_[16];                        \
        _Pragma("unroll") for (int i = 0; i < 16; ++i) zr_[i] = *(const LAS unsigned short*)(rw_ + i * RS_RAW); \
        _Pragma("unroll") for (int i = 0; i < 16; ++i) qr_[i] = *(const LAS unsigned short*)(rw_ + 8192 + i * RS_RAW); \
        _Pragma("unroll") for (int i = 0; i < 16; ++i) vr_[i] = *(const LAS unsigned short*)(rw_ + 16384 + i * RS_RAW); \
        float cp_[16], kk_[16]; float a_ = 1.0f;                   \
        _Pragma("unroll") for (int i = 0; i < 16; ++i) { const float z_ = fminf(fmaxf(bflo(zr_[i]), -30.f), 30.f); \
            const float e_ = __expf(-z_); const float s_ = __builtin_amdgcn_rcpf(1.0f + e_); kk_[i] = om * (e_ * s_); a_ *= (lb + om * s_); cp_[i] = a_; } \
        const float oth_ = __shfl_xor(a_, 32); const float off_ = hf ? oth_ : 1.0f; const float dk_ = a_ * oth_; \
        unsigned kh_[8], vv_[8], qi_[16], ki_[16]; \
        _Pragma("unroll") for (int i = 0; i < 16; ++i) { const float eq_ = fmaxf(off_ * cp_[i], 8.7565e-27f);      \
            const float ek_ = __builtin_amdgcn_rcpf(eq_); \
            const float q_ = bflo(qr_[i]); const unsigned v_ = vr_[i]; \
            const float kt_ = kk_[i] * ek_; const float kh = kt_ * dk_; \
            qi_[i] = pk(q_ * eq_, 0.f); ki_[i] = pk(kt_, 0.f); \
            if (i & 1) { kh_[i >> 1] = pk(cp_[i - 1], kh); vv_[i >> 1] |= v_ << 16; } else { cp_[i] = kh; vv_[i >> 1] = v_; } } \
        _Pragma("unroll") for (int i = 0; i < 16; ++i) { *(LAS unsigned short*)(im_ + IMG_QI + (16 * hf + i) * RS_QI + kp_ * 2) = (unsigned short)(qi_[i] & 0xffffu); \
            *(LAS unsigned short*)(im_ + IMG_KI + (16 * hf + i) * RS_QI + kp_ * 2) = (unsigned short)(ki_[i] & 0xffffu); } \
        _Pragma("unroll") for (int gg = 0; gg < 4; ++gg) {        \
            *(LAS u32x2*)(im_ + IMG_KHT + k * RS_T + 16 * gg + 8 * hf) = (u32x2){kh_[2 * gg], kh_[2 * gg + 1]}; \
            *(LAS u32x2*)(im_ + IMG_VT + k * RS_T + 16 * gg + 8 * hf) = (u32x2){vv_[2 * gg], vv_[2 * gg + 1]}; } \
        if (hf == 0) *(LAS float*)(im_ + IMG_DK + k * 4) = dk_; } while (0)

    if (w < 4) { SC3_DMA(0, 0); if (1 < NCH) SC3_DMA(1, 1); SC3_DMA_WAIT(); }
    __syncthreads();
    if (w < 4) { SC3_IMAGES(0); }
    __syncthreads();
#pragma unroll 1
    for (int c = 0; c < NCH; ++c) {
        const int par = c & 1;
        if (w < 4) {
            if (c > 0) {
#pragma unroll
                for (int pz = 0; pz < 2; ++pz) { const int p = xt + 256 * pz, tau = p >> 4, co = (p & 15) * 8;
                    const v4u o = *(const LAS v4u*)(L + O_OB + (par ^ 1) * OB_BYTES + tau * RS_OB + co * 2);
                    if (PROBE_OUT) *(GAS v4u*)(Yp + (size_t)(SC3_ROW(c - 1, tau) - P) / DIN * D + dir * 1024 + h * 128 + co) = o; else *(GAS v4u*)(SC3_ROW(c - 1, tau) + zcol + co) = o; } }
            if (c + 2 < NCH) SC3_DMA(c + 2, par);
            if (c + 1 < NCH && PROBE_OUT != 2) SC3_IMAGES(par ^ 1);
        } else if (PROBE_OUT != 3) {
            const LAS unsigned char* im = L + O_IMG + par * IMG_BYTES;
            bf16x8 qf[2][4], kf[2][4];
#pragma unroll
            for (int tb = 0; tb < 2; ++tb)
#pragma unroll
                for (int ks = 0; ks < 4; ++ks) { const int ro = (16 * tb + c16) * RS_QI + (32 * ks + 8 * g) * 2;
                    qf[tb][ks] = __builtin_bit_cast(bf16x8, *(const LAS u32x4*)(im + IMG_QI + ro));
                    kf[tb][ks] = __builtin_bit_cast(bf16x8, *(const LAS u32x4*)(im + IMG_KI + ro)); }
            f32x4 p00 = {0.f, 0.f, 0.f, 0.f}, p01 = p00, p11 = p00;
#pragma unroll
            for (int ks = 0; ks < 4; ++ks) { p00 = SC3_MFMA(kf[0][ks], qf[0][ks], p00); p01 = SC3_MFMA(kf[0][ks], qf[1][ks], p01); p11 = SC3_MFMA(kf[1][ks], qf[1][ks], p11); }
#pragma unroll
            for (int r = 0; r < 4; ++r) { const bool keep = (4 * g + r) <= c16; p00[r] = keep ? p00[r] : 0.f; p11[r] = keep ? p11[r] : 0.f; }
            const bf16x8 pa0 = mk8((u32x2){pk(p00[0], p00[1]), pk(p00[2], p00[3])}, (u32x2){0u, 0u});
            const bf16x8 pa1 = mk8((u32x2){pk(p01[0], p01[1]), pk(p01[2], p01[3])}, (u32x2){pk(p11[0], p11[1]), pk(p11[2], p11[3])});
            bf16x8 vf[2]; f32x4 o[2][2];
#pragma unroll
            for (int sl = 0; sl < 2; ++sl) { const int vr = (32 * wy + 16 * sl + c16) * RS_T + 16 * g;
                vf[sl] = __builtin_bit_cast(bf16x8, *(const LAS u32x4*)(im + IMG_VT + vr));
                o[sl][0] = SC3_MFMA(pa0, vf[sl], ((f32x4){0.f, 0.f, 0.f, 0.f})); o[sl][1] = SC3_MFMA(pa1, vf[sl], ((f32x4){0.f, 0.f, 0.f, 0.f})); }
#pragma unroll
            for (int sl = 0; sl < 2; ++sl)
#pragma unroll
                for (int ks = 0; ks < 4; ++ks) { const bf16x8 sf = mk8((u32x2){pk(S[sl][2 * ks][0], S[sl][2 * ks][1]), pk(S[sl][2 * ks][2], S[sl][2 * ks][3])}, (u32x2){pk(S[sl][2 * ks + 1][0], S[sl][2 * ks + 1][1]), pk(S[sl][2 * ks + 1][2], S[sl][2 * ks + 1][3])});
                    o[sl][0] = SC3_MFMA(qf[0][ks], sf, o[sl][0]); o[sl][1] = SC3_MFMA(qf[1][ks], sf, o[sl][1]); }
#pragma unroll
            for (int kb = 0; kb < 8; ++kb) { const int ro = (16 * kb + c16) * RS_T + 16 * g;
                const bf16x8 hfr = __builtin_bit_cast(bf16x8, *(const LAS u32x4*)(im + IMG_KHT + ro));
                const f32x4 dv = *(const LAS f32x4*)(im + IMG_DK + (16 * kb + 4 * g) * 4);
#pragma unroll
                for (int sl = 0; sl < 2; ++sl) { S[sl][kb] = S[sl][kb] * dv; S[sl][kb] = SC3_MFMA(hfr, vf[sl], S[sl][kb]); } }
            LAS unsigned char* ob = L + O_OB + par * OB_BYTES;
#pragma unroll
            for (int sl = 0; sl < 2; ++sl)
#pragma unroll
                for (int r = 0; r < 4; ++r) { *(LAS unsigned short*)(ob + (4 * g + r) * RS_OB + (32 * wy + 16 * sl + c16) * 2) = (unsigned short)(pk(o[sl][0][r], 0.f) & 0xffffu);
                    *(LAS unsigned short*)(ob + (16 + 4 * g + r) * RS_OB + (32 * wy + 16 * sl + c16) * 2) = (unsigned short)(pk(o[sl][1][r], 0.f) & 0xffffu); }
        }
        if (w < 4) SC3_DMA_WAIT();
        __syncthreads();
    }
    if (w < 4) {
#pragma unroll
        for (int pz = 0; pz < 2; ++pz) { const int p = xt + 256 * pz, tau = p >> 4, co = (p & 15) * 8;
            const v4u o = *(const LAS v4u*)(L + O_OB + ((NCH - 1) & 1) * OB_BYTES + tau * RS_OB + co * 2);
            if (PROBE_OUT) *(GAS v4u*)(Yp + (size_t)(SC3_ROW(NCH - 1, tau) - P) / DIN * D + dir * 1024 + h * 128 + co) = o; else *(GAS v4u*)(SC3_ROW(NCH - 1, tau) + zcol + co) = o; } }
#if SCAN_XPRIO
    __builtin_amdgcn_s_setprio(0);
#endif
    __syncthreads();
#undef SC3_ROW
#undef SC3_DMA
#undef SC3_DMA_WAIT
#undef SC3_IMAGES
}
#undef SC3_MFMA
}

#ifndef WIN_STAGGER_TICKS
#define WIN_STAGGER_TICKS 0
#endif
#ifndef GU_STAGGER_TICKS
#define GU_STAGGER_TICKS 0
#endif
#ifndef PROBE_T1
#define PROBE_T1 66000ull
#define PROBE_T2 70000ull
#define PROBE_T3 74000ull
#endif
#ifndef WIN_FUSE_PREP
#define WIN_FUSE_PREP 1
#endif
#ifndef MERGE_SCAN_ATTN
#define MERGE_SCAN_ATTN 1
#endif
#ifndef TAIL_CONVERT
#define TAIL_CONVERT 1
#endif
#ifndef PROBE_PM_MASK
#define PROBE_PM_MASK 0
#define PROBE_PN_MASK 0
#endif
#ifndef WGM_GU
#define WGM_GU 8
#define WGM_WIN 4
#define WGM_RES 4
#endif
#ifndef ATT_PROBE_MODE
#define ATT_PROBE_MODE 0
#endif
#ifndef GEMM_ALIGN
#define GEMM_ALIGN true
#endif
#ifndef PROBE_EPI_MODE
#define PROBE_EPI_MODE 4
#endif
#ifndef SCAN_PROBE_MODE
#define SCAN_PROBE_MODE 1
#endif
#ifndef PROBE_ARR_STEP
#define PROBE_ARR_FIRST 0
#define PROBE_ARR_STEP 8
#endif
#ifndef PROBE_ARRIVE
#define PROBE_ARRIVE 0
#endif
#ifndef DUP_MASK
#define DUP_MASK 0
#endif
#define REPS(b) ((((DUP_MASK) >> (b)) & 1) + 1)
#ifndef EN_P0
#define EN_P0 1
#endif
#ifndef EN_NORM
#define EN_NORM 1
#endif
#ifndef EN_GU
#define EN_GU 1
#endif
#ifndef EN_WIN
#define EN_WIN 1
#endif
#ifndef EN_PREP
#define EN_PREP 1
#endif
#ifndef EN_SCAN
#define EN_SCAN 1
#endif
#ifndef EN_ATTN
#define EN_ATTN 1
#endif
#ifndef EN_COMB
#define EN_COMB 1
#endif
#ifndef EN_RES
#define EN_RES 1
#endif
struct Args { const void* in[N_IN]; float* out; unsigned char* ws; int ph_lo, ph_hi; };
constexpr int PH_PER_LAYER = 9, NPH = 1 + DEPTH * PH_PER_LAYER;

__global__ void __launch_bounds__(NWAVES * 64, 2) fwd_kernel(Args args) {
    extern __shared__ __attribute__((aligned(16))) unsigned char lds[];
    LAS unsigned char* ldsb = (LAS unsigned char*)lds;
    volatile LAS unsigned* MISC = (volatile LAS unsigned*)(ldsb + MISC_OFF);
    const int tid0 = threadIdx.x;
    const int G = gridDim.x; const int bx = blockIdx.x; const int vcu = (G % 8 == 0) ? (bx % 8) * (G / 8) + bx / 8 : bx;
    const int NGW = G * NWAVES;
#define PHASE_IDS() int tid = threadIdx.x; asm volatile("" : "+v"(tid)); const int lane = tid & 63, wave = __builtin_amdgcn_readfirstlane(tid >> 6), gw = vcu * NWAVES + wave; (void)lane; (void)gw
    unsigned char* ws = args.ws;
    gu32* ctl = (gu32*)(ws + WS_CTL);
    for (int u = tid0; u < (LDS_BYTES - LDSCTL_OFF) / 4; u += NWAVES * 64) ((LAS unsigned*)(ldsb + LDSCTL_OFF))[u] = 0u;
    __syncthreads();
    const int lo = args.ph_lo, hi = args.ph_hi;
    const bool multi = (hi - lo) > 1;
    XcdBarrier bar; bar.bar = (unsigned*)(ctl + CW_BAR); bar.x = 0; bar.st = nullptr;
    if (multi) bar = xcd_barrier_post((unsigned*)(ctl + CW_BAR), MISC + 8);
#define RUN(k) (lo <= (k) && (k) < hi)
#if PROBE_ARRIVE
#define SEAM(k) do { if (RUN(k) && RUN((k) + 1)) { if ((k) == PROBE_ARRIVE && threadIdx.x == 0) ((volatile unsigned long long*)(ws + WS_SMALL + 262144))[bx] = __builtin_amdgcn_s_memrealtime(); xcd_barrier(bar); } } while (0)
#else
#define SEAM(k) do { if (RUN(k) && RUN((k) + 1)) { xcd_barrier(bar); if (DUP_MASK & 4096) xcd_barrier(bar); } } while (0)
#endif

    float* out = args.out;
    bf16* Y = (bf16*)(ws + WS_H); bf16* P = (bf16*)(ws + WS_P); bf16* ACT = P; bf16* XB = (bf16*)(ws + WS_OF); bf16* OA = (bf16*)(ws + WS_OA);
    unsigned* rowsq = (unsigned*)(ws + WS_ROWSQ);
    float* lbt = (float*)(ws + WS_SMALL); float* cosT = (float*)(ws + WS_ROPE); float* sinT = cosT + (size_t)M * 32;

    if (EN_P0 && RUN(0)) {
        PHASE_IDS();
        for (int rep = 0; rep < REPS(7); ++rep) {
        LAS float* scr = (LAS float*)(ldsb + RING_OFF + wave * 16384);
        { const int nq = (TAIL_CONVERT && G == 256) ? CONV_JIT_P0 : DEPTH * CONV_PER_LAYER;
          convert_items<true>(args, ws, CONV_PER_LAYER, gw, nq, NGW, 0, scr, lane); }
        xcopy_phase((const float*)args.in[I_X], XB, rowsq, gw, NGW, lane);
        { const int* pos = (const int*)args.in[I_POS];
          for (int i = (vcu * NWAVES * 64 + tid); i < M * 32; i += G * NWAVES * 64) { const int m = i >> 5, j = i & 31;
              const double ang = (double)(float)((float)pos[m] * (float)c_inv_freq[j]);
              double rev = ang * 0.15915494309189533577; rev -= __builtin_rint(rev);
              const float rf = (float)rev; cosT[i] = __builtin_amdgcn_cosf(rf); sinT[i] = __builtin_amdgcn_sinf(rf); } }
        { const float* lg = (const float*)args.in[I_LB];
          for (int i = (vcu * NWAVES * 64 + tid); i < 2 * 1024; i += G * NWAVES * 64) { const int dir = i >> 10, c = i & 1023;
              float l[DEPTH], mx = -1e30f;
#pragma unroll
              for (int j = 0; j < DEPTH; ++j) { l[j] = lg[(dir * DEPTH + j) * 1024 + c]; mx = fmaxf(mx, l[j]); }
              float sum = 0.f;
#pragma unroll
              for (int j = 0; j < DEPTH; ++j) { l[j] = expf(l[j] - mx); sum += l[j]; }
              float cum = 0.f;
#pragma unroll
              for (int j = 0; j < DEPTH; ++j) { if (j > 0) cum += l[j] / sum; lbt[(dir * DEPTH + j) * 1024 + c] = cum; } } }
        }
    }
    SEAM(0);

#pragma unroll 1
    for (int L = 0; L < DEPTH; ++L) {
#pragma unroll 1
        for (int st = 0; st < 3; ++st) {
            const int pb = 1 + PH_PER_LAYER * L + (st == 0 ? 0 : (st == 1 ? 2 : 7));
            const unsigned* rsq_in = rowsq + (size_t)(3 * L + st) * M;
            int plast;
            if (st != 1) {
                if (EN_GU && RUN(pb)) {
                    const bf16* W = (const bf16*)(ws + WS_WGU + (size_t)(2 * L + (st == 2 ? 1 : 0)) * SZ_WGU);
                    pg8::Gemm g{XB, W, M, NGU, D}; pg8::StaticOrder S; S.init(M, NGU, G, bx, WGM_GU);
                    pg8::EpiSwiGLU E{ACT, DFF, rsq_in};
#if DUP_MASK & 512
                    { pg8::EpiNone EN{(float*)(ws + WS_SMALL + 65536)}; pg8::gemm_phase<pg8::EpiNone, pg8::StaticOrder, GEMM_ALIGN, true>(ldsb + RING_OFF, g, S, EN); }
#endif
                    for (int rep = 0; rep < REPS(0); ++rep) pg8::gemm_phase<pg8::EpiSwiGLU, pg8::StaticOrder, GEMM_ALIGN, true>(ldsb + RING_OFF, g, S, E, (PROBE_STAMP && bx == 0 && L == 1 && st == 0) ? (unsigned long long*)(ws + WS_SMALL + 131072) : nullptr);
                    if (TAIL_CONVERT && G == 256 && bx >= 128) {
                        PHASE_IDS();
                        LAS float* scr = (LAS float*)(ldsb + RING_OFF + wave * 16384);
                        const int kph = 2 * L + (st == 2 ? 1 : 0), lo_q = CONV_JIT_P0 + kph * CONV_JIT_C, hi_q = (lo_q + CONV_JIT_C < DEPTH * CONV_PER_LAYER) ? lo_q + CONV_JIT_C : DEPTH * CONV_PER_LAYER;
                        convert_items<true>(args, ws, CONV_PER_LAYER, lo_q + (bx - 128) * NWAVES + wave, hi_q, 128 * NWAVES, 0, scr, lane);
                    }
                }
                SEAM(pb);
                plast = pb + 1;
            } else {
                if (EN_WIN && RUN(pb)) {
                    const bf16* W = (const bf16*)(ws + WS_WIN + (size_t)L * SZ_WIN);
                    pg8::Gemm g{XB, W, M, DIN, D}; pg8::StaticOrder S; S.init(M, DIN, G, bx, WGM_WIN);
                    pg8::EpiBf16Rot E{P, DIN, rsq_in, cosT, sinT, (const float*)args.in[I_DAQN] + L * 64, (const float*)args.in[I_DAKN] + L * 64, C_DAQ / 256, C_DAK / 256, C_DAV / 256};
#if DUP_MASK & 32768
                    { struct ProbeOrder : pg8::StaticOrder { __device__ bool next(int i, pg8::Unit& u) const { pg8::Unit t; const bool r = pg8::StaticOrder::next(i, t); u.pm = t.pm & PROBE_PM_MASK; u.pn = t.pn & PROBE_PN_MASK; return r; } } PS; PS.init(M, DIN, G, bx);
                      pg8::EpiNone EN{(float*)(ws + WS_SMALL + 65536)}; pg8::gemm_phase<pg8::EpiNone, ProbeOrder, true, true>(ldsb + RING_OFF, g, PS, EN); }
#endif
#if DUP_MASK & 65536
                    { pg8::EpiBf16Probe<PROBE_EPI_MODE> EN{P, 256}; pg8::gemm_phase<pg8::EpiBf16Probe<PROBE_EPI_MODE>, pg8::StaticOrder, GEMM_ALIGN, true>(ldsb + RING_OFF, g, S, EN); }
#endif
#if DUP_MASK & 2048
                    { pg8::EpiNone EN{(float*)(ws + WS_SMALL + 65536)}; pg8::gemm_phase<pg8::EpiNone, pg8::StaticOrder, GEMM_ALIGN, true>(ldsb + RING_OFF, g, S, EN); }
#endif
                    for (int rep = 0; rep < REPS(2); ++rep) pg8::gemm_phase<pg8::EpiBf16Rot, pg8::StaticOrder, GEMM_ALIGN, true>(ldsb + RING_OFF, g, S, E);
                }
                SEAM(pb);
                if (RUN(pb + 1)) {
                    PHASE_IDS();
                    if (EN_PREP && !WIN_FUSE_PREP) prep_phase(P, cosT, sinT, (const float*)args.in[I_DAQN] + L * 64, (const float*)args.in[I_DAKN] + L * 64, gw, NGW, lane);
#if DUP_MASK & 16
                    for (int u = vcu; u < BATCH * 8 * 2; u += G) { const int b = u >> 4, h = (u >> 1) & 7, dir = u & 1;
                        sc3::scan_unit<SCAN_PROBE_MODE>(P, lbt + (size_t)(dir * DEPTH + L) * 1024, b, h, dir, ldsb + RING_OFF, tid, Y); }
#endif
                    if (EN_SCAN)
                    for (int u = vcu; u < BATCH * 8 * 2; u += G) { const int b = u >> 4, h = (u >> 1) & 7, dir = u & 1;
                        sc3::scan_unit(P, lbt + (size_t)(dir * DEPTH + L) * 1024, b, h, dir, ldsb + RING_OFF, tid); }
                }
#if !(WIN_FUSE_PREP && MERGE_SCAN_ATTN)
                SEAM(pb + 1);
#endif
                if (EN_ATTN && RUN(pb + 2)) {
                    float mbC;
                    { PHASE_IDS(); const float gq = fabsf(((const float*)args.in[I_DAQN])[L * 64 + lane]), gk = fabsf(((const float*)args.in[I_DAKN])[L * 64 + lane]); float mq = gq, mk = gk;
#pragma unroll
                      for (int o = 1; o < 64; o <<= 1) { mq = fmaxf(mq, __shfl_xor(mq, o)); mk = fmaxf(mk, __shfl_xor(mk, o)); }
                      mbC = fminf(8.0f * mq * mk, 40.0f) * 1.4426950408889634f; }
#if ATT_PROBE_MODE
                    for (int u = vcu; u < BATCH * 4 * 2 * (SEQ / 256); u += G) { const int qb = u & 7, cmb = u >> 3, map = cmb & 1, h = (cmb >> 1) & 3, b = cmb >> 3;
                        const bf16* Pb = P + (size_t)b * SEQ * DIN;
                        __syncthreads();
                        att::attn_unit<ATT_PROBE_MODE>(Pb + (size_t)(qb * 256) * DIN + C_DAQ + h * 128 + map * 64, Pb + C_DAK + h * 128 + map * 64, Pb + C_DAV + h * 128,
                                       OA + ((size_t)b * SEQ + qb * 256) * 1024 + h * 256 + map * 128, SEQ, (char*)lds + RING_OFF, mbC); }
#endif
                    for (int rep = 0; rep < REPS(5); ++rep)
                    for (int u = vcu; u < BATCH * 4 * 2 * (SEQ / 256); u += G) { const int qb = u & 7, cmb = u >> 3, map = cmb & 1, h = (cmb >> 1) & 3, b = cmb >> 3;
                        const bf16* Pb = P + (size_t)b * SEQ * DIN;
                        __syncthreads();
                        att::attn_unit(Pb + (size_t)(qb * 256) * DIN + C_DAQ + h * 128 + map * 64, Pb + C_DAK + h * 128 + map * 64, Pb + C_DAV + h * 128,
                                       OA + ((size_t)b * SEQ + qb * 256) * 1024 + h * 256 + map * 128, SEQ, (char*)lds + RING_OFF, mbC); }
                    __syncthreads();
                }
                SEAM(pb + 2);
                if (EN_COMB && RUN(pb + 3)) {
                    PHASE_IDS();
                    for (int rep = 0; rep < REPS(8); ++rep) combine_phase(P, OA, Y, (const float*)args.in[I_HGN] + L * 1024, (const float*)args.in[I_DAON] + L * 512, (const float*)args.in[I_LQ1] + L * 64, (const float*)args.in[I_LK1] + L * 64,
                                  (const float*)args.in[I_LQ2] + L * 64, (const float*)args.in[I_LK2] + L * 64, c_lam_init[L], (const float*)args.in[I_CW] + L * 1536, (const float*)args.in[I_CB] + L * 512,
                                  (const float*)args.in[I_CN] + L * 512, gw, NGW, lane);
                }
                SEAM(pb + 3);
                plast = pb + 4;
            }
            if (EN_RES && RUN(plast)) {
                const bf16* A = (st == 1) ? Y : ACT; const int K = (st == 1) ? D : DFF;
                const bf16* W = (st == 1) ? (const bf16*)(ws + WS_WOUT + (size_t)L * SZ_WOUT) : (const bf16*)(ws + WS_WD + (size_t)(2 * L + (st == 2 ? 1 : 0)) * SZ_WD);
                pg8::Gemm g{A, W, M, D, K}; pg8::StaticOrder S; S.init(M, D, G, bx, WGM_RES);
#if DUP_MASK & 1024
                if (st != 1) { pg8::EpiNone EN{(float*)(ws + WS_SMALL + 65536)}; pg8::gemm_phase<pg8::EpiNone, pg8::StaticOrder, GEMM_ALIGN, true>(ldsb + RING_OFF, g, S, EN); }
#endif
                const float scale = (st == 1) ? 1.0f : 0.5f;
#if DUP_MASK & 2
                if (st != 1) { pg8::EpiResAdd<false, false> E0{XB, out, nullptr, D, 0.0f}; pg8::gemm_phase<pg8::EpiResAdd<false, false>, pg8::StaticOrder, GEMM_ALIGN, true>(ldsb + RING_OFF, g, S, E0); }
#endif
#if DUP_MASK & 8
                if (st == 1) { pg8::EpiResAdd<false, false> E0{XB, out, nullptr, D, 0.0f}; pg8::gemm_phase<pg8::EpiResAdd<false, false>, pg8::StaticOrder, GEMM_ALIGN, true>(ldsb + RING_OFF, g, S, E0); }
#endif
                if (L == DEPTH - 1 && st == 2) { pg8::EpiResAdd<true> E{XB, out, nullptr, D, scale}; pg8::gemm_phase<pg8::EpiResAdd<true>, pg8::StaticOrder, GEMM_ALIGN, true>(ldsb + RING_OFF, g, S, E); }
                else { pg8::EpiResAdd<false> E{XB, out, rowsq + (size_t)(3 * L + st + 1) * M, D, scale}; pg8::gemm_phase<pg8::EpiResAdd<false>, pg8::StaticOrder, GEMM_ALIGN, true>(ldsb + RING_OFF, g, S, E); }
            }
            SEAM(plast);
        }
    }
#if PROBE_ARRIVE
    if (hi == NPH) { xcd_barrier(bar); if (bx == 0 && tid0 == 0) { unsigned long long mn = ~0ull, mx = 0; for (int i = PROBE_ARR_FIRST; i < G; i += PROBE_ARR_STEP) { const unsigned long long t = ((volatile unsigned long long*)(ws + WS_SMALL + 262144))[i]; mn = t < mn ? t : mn; mx = t > mx ? t : mx; }
        const unsigned long long d_ = mx - mn; const int code_ = (d_ > PROBE_T1) + 2 * (d_ > PROBE_T2) + 4 * (d_ > PROBE_T3); if (code_) out[0] = 1.0e6f * code_; } }
#endif
#if PROBE_STAMP
    if (hi == NPH) { xcd_barrier(bar); if (bx == 0 && tid0 == 0) { const unsigned long long d_ = *(volatile unsigned long long*)(ws + WS_SMALL + 131072); const int code_ = (d_ > PROBE_T1) + 2 * (d_ > PROBE_T2) + 4 * (d_ > PROBE_T3); if (code_) out[0] = 1.0e6f * code_; } }
#endif
#undef RUN
#undef SEAM
}

#ifndef MK_PER_PHASE
#define MK_PER_PHASE 0
#endif
extern "C" void kernel_launch(void* const* d_in, const int* in_sizes, int n_in, void* d_out, int out_size, void* d_ws, size_t ws_size, hipStream_t stream) {
    static int grid = 0;
    if (grid == 0) {
        if (n_in != N_IN || in_sizes[0] != M * D || out_size != M * D || ws_size < WS_END) {
            fprintf(stderr, "kernel_launch: shape/workspace mismatch: n_in %d in0 %d out %d ws %zu (need %zu); nothing launched\n", n_in, n_in > 0 ? in_sizes[0] : -1, out_size, ws_size, (size_t)WS_END); grid = -1; return; }
        int dev = 0, cus = 0, per_cu = 0;
        if (hipGetDevice(&dev) != hipSuccess || hipDeviceGetAttribute(&cus, hipDeviceAttributeMultiprocessorCount, dev) != hipSuccess) { fprintf(stderr, "kernel_launch: device query failed\n"); grid = -1; return; }
        if (hipFuncSetAttribute((const void*)fwd_kernel, hipFuncAttributeMaxDynamicSharedMemorySize, LDS_BYTES) != hipSuccess) { fprintf(stderr, "kernel_launch: hipFuncSetAttribute failed\n"); grid = -1; return; }
        if (hipOccupancyMaxActiveBlocksPerMultiprocessor(&per_cu, (const void*)fwd_kernel, NWAVES * 64, LDS_BYTES) != hipSuccess || per_cu < 1)
            fprintf(stderr, "kernel_launch: note: occupancy query reports %d workgroups per CU\n", per_cu);
        (void)hipGetLastError();
        grid = cus;
    }
    if (grid < 0) return;
    if (hipMemsetAsync((char*)d_ws + WS_CTL, 0, CTL_ZERO_BYTES, stream) != hipSuccess) { fprintf(stderr, "kernel_launch: memset failed\n"); return; }
    Args a{};
    for (int i = 0; i < N_IN; ++i) a.in[i] = d_in[i];
    a.out = (float*)d_out; a.ws = (unsigned char*)d_ws;
#if MK_PER_PHASE
    for (int p = 0; p < NPH; ++p) { a.ph_lo = p; a.ph_hi = p + 1;
        hipLaunchKernelGGL(fwd_kernel, dim3(grid), dim3(NWAVES * 64), LDS_BYTES, stream, a); }
#else
    a.ph_lo = 0; a.ph_hi = NPH;
    hipLaunchKernelGGL(fwd_kernel, dim3(grid), dim3(NWAVES * 64), LDS_BYTES, stream, a);
#endif
    const hipError_t le = hipPeekAtLastError();
    if (le != hipSuccess) fprintf(stderr, "kernel_launch: launch failed: %s\n", hipGetErrorName(le));
}
```

```cpp
#include <hip/hip_runtime.h>
#include <cstdio>
#include <cstdint>
namespace pg8 {
#define PG8_LAS __attribute__((address_space(3)))
typedef unsigned short bf16_t;
typedef short bf16x8 __attribute__((ext_vector_type(8)));
typedef float f32x4 __attribute__((ext_vector_type(4)));
typedef unsigned u32x4 __attribute__((ext_vector_type(4)));
constexpr int BM = 256, BK = 64, HALF = 128, HTB = HALF * BK * 2  , STAGE_BYTES = 8 * HTB, NXCD = 8;

__host__ __device__ __forceinline__ int lds_byte(int r, int c) { const int st = (r >> 4) * 2 + (c >> 5), rr = r & 15, cc = c & 31, ob = rr * 64 + cc * 2; return st * 1024 + (ob ^ (((ob >> 9) & 1) << 5)); }
__host__ __device__ __forceinline__ void stage_rc(int b, int& R, int& C) { const int st = b / 1024, sb = b % 1024, swz = sb ^ (((sb >> 9) & 1) << 5); R = (st >> 1) * 16 + swz / 64; C = (st & 1) * 32 + (swz % 64) / 2; }
__host__ __device__ __forceinline__ int perm32(int rho) { const int n = rho >> 4, i = rho & 15; return 8 * (i >> 2) + 4 * n + (i & 3); }

struct Unit { int pm, pn; };
struct Gemm { const bf16_t* A; const bf16_t* Bt; int M, N, K; };

struct StaticOrder {
    int nM, nN, nwg, G, c, WGM, rev;
    __host__ __device__ void init(int M, int N, int G_, int c_, int wgm = 8, int rev_ = 0) { nM = M / BM; nN = N / BM; nwg = nM * nN; G = G_; c = c_; WGM = wgm; rev = rev_; }
    __host__ __device__ bool next(int i, Unit& u) const {
        const long L = (long)i * G + c; if (L >= nwg) return false;
        int wgid = (int)L; { const int q = nwg / NXCD, r = nwg % NXCD, xcd = wgid % NXCD, off = wgid / NXCD; const int cx = q + (xcd < r ? 1 : 0); wgid = (xcd < r ? xcd * (q + 1) : r * (q + 1) + (xcd - r) * q) + (rev ? cx - 1 - off : off); }
        const int nig = WGM * nN, gid = wgid / nig, fm = gid * WGM, gsz = (nM - fm) < WGM ? (nM - fm) : WGM;
        u.pm = fm + ((wgid % nig) % gsz); u.pn = (wgid % nig) / gsz; return true;
    }
    __device__ __forceinline__ void a_ready(const Unit&) const {}
    __device__ __forceinline__ void done(const Unit&) const {}
};

__device__ __forceinline__ unsigned cvt_pk_bf16(float lo, float hi) { unsigned r; asm volatile("v_cvt_pk_bf16_f32 %0, %1, %2" : "=v"(r) : "v"(lo), "v"(hi)); return r; }

__device__ __forceinline__ u32x4 lane_xpose(u32x4 w, int srcaddr) {
    u32x4 r; r.x = (unsigned)__builtin_amdgcn_ds_bpermute(srcaddr, (int)w.x); r.y = (unsigned)__builtin_amdgcn_ds_bpermute(srcaddr, (int)w.y);
    r.z = (unsigned)__builtin_amdgcn_ds_bpermute(srcaddr, (int)w.z); r.w = (unsigned)__builtin_amdgcn_ds_bpermute(srcaddr, (int)w.w); return r; }

constexpr float RSQ_SCALE = 4096.0f;
__device__ __forceinline__ void prefetch_rsq(PG8_LAS unsigned char* slot, const unsigned* rowsq, const Unit& u, int wr, int fr, int fq) {
    if (fq == 0) {
#pragma unroll
        for (int ai = 0; ai < 2; ++ai)
#pragma unroll
            for (int m = 0; m < 4; ++m) __builtin_amdgcn_global_load_lds(rowsq + (u.pm * BM + ai * HALF + wr * 64 + m * 16 + fr), (PG8_LAS unsigned*)(slot + (ai * 4 + m) * 64), 4, 0, 0);
    }
}
__device__ __forceinline__ float rstd_of(unsigned q) { return __builtin_amdgcn_rsqf((float)q * (1.0f / (RSQ_SCALE * 2048.0f)) + 1e-6f); }
#ifndef EPI_WIDE
#define EPI_WIDE 1
#endif
#if EPI_WIDE
#define EPI_WC 64
#define EPI_BJ 32
#else
#define EPI_WC 32
#define EPI_BJ HALF
#endif
#ifndef EPI_STORE_MODE
#define EPI_STORE_MODE 0
#endif
__device__ __forceinline__ void epi_store16(void* p, u32x4 v) {
#if EPI_STORE_MODE == 1
    asm volatile("global_store_dwordx4 %0, %1, off sc1\n\ts_nop 2" :: "v"(p), "v"(v) : "memory");
#elif EPI_STORE_MODE == 2
    asm volatile("global_store_dwordx4 %0, %1, off nt\n\ts_nop 2" :: "v"(p), "v"(v) : "memory");
#elif EPI_STORE_MODE == 3
    asm volatile("global_store_dwordx4 %0, %1, off sc0 sc1\n\ts_nop 2" :: "v"(p), "v"(v) : "memory");
#else
    *(u32x4*)p = v;
#endif
}
struct EpiBf16 {
    static constexpr bool PERM = true, AFTER_DRAIN = false; static constexpr int NVM = 16;
    bf16_t* O; int ldc; const unsigned* rowsq;
    __device__ __forceinline__ void prefetch(PG8_LAS unsigned char* slot, const Unit& u, int wr, int fr, int fq) const { prefetch_rsq(slot, rowsq, u, wr, fr, fq); }
    __device__ __forceinline__ void operator()(const f32x4 (&acc)[2][2][4][2], const Unit& u, int wr, int wc, int fr, int fq, const PG8_LAS unsigned char* slot) const {
        const int lane = fr + 16 * fq, pr = lane >> 2, pc = lane & 3, sa = (pr + 16 * pc) * 4;
        const int row0 = u.pm * BM + wr * 64 + pr, col0 = u.pn * BM + wc * EPI_WC + 8 * pc;
        float rs[2][4];
#pragma unroll
        for (int ai = 0; ai < 2; ++ai)
#pragma unroll
            for (int m = 0; m < 4; ++m) rs[ai][m] = rstd_of(*(const PG8_LAS unsigned*)(slot + (ai * 4 + m) * 64 + fr * 4));
#pragma unroll
        for (int ai = 0; ai < 2; ++ai)
#pragma unroll
            for (int m = 0; m < 4; ++m) { bf16_t* rowp = O + (size_t)(row0 + ai * HALF + m * 16) * ldc + col0;
#pragma unroll
                for (int bj = 0; bj < 2; ++bj) { const f32x4 v0 = acc[ai][bj][m][0] * rs[ai][m], v1 = acc[ai][bj][m][1] * rs[ai][m];
                    u32x4 w; w.x = cvt_pk_bf16(v0[0], v0[1]); w.y = cvt_pk_bf16(v0[2], v0[3]); w.z = cvt_pk_bf16(v1[0], v1[1]); w.w = cvt_pk_bf16(v1[2], v1[3]);
                    epi_store16(rowp + bj * EPI_BJ, lane_xpose(w, sa)); } }
    }
};
struct EpiBf16Rot {
    static constexpr bool PERM = true, AFTER_DRAIN = false, INIT_ACC = false; static constexpr int NVM = 16;
    bf16_t* O; int ldc; const unsigned* rowsq; const float* cosT; const float* sinT; const float* qg; const float* kg; int rot_lo, rot_k, rot_hi;
    __device__ __forceinline__ void prefetch(PG8_LAS unsigned char* slot, const Unit& u, int wr, int fr, int fq) const { prefetch_rsq(slot, rowsq, u, wr, fr, fq); }
    __device__ __forceinline__ void operator()(const f32x4 (&acc)[2][2][4][2], const Unit& u, int wr, int wc, int fr, int fq, const PG8_LAS unsigned char* slot) const {
        static_assert(EPI_WIDE, "EpiBf16Rot needs a (head, map) inside one wave");
        const int lane = fr + 16 * fq, pr = lane >> 2, pc = lane & 3, sa = (pr + 16 * pc) * 4;
        const int row0 = u.pm * BM + wr * 64 + pr, col0 = u.pn * BM + wc * EPI_WC + 8 * pc;
        float rs[2][4];
#pragma unroll
        for (int ai = 0; ai < 2; ++ai)
#pragma unroll
            for (int m = 0; m < 4; ++m) rs[ai][m] = rstd_of(*(const PG8_LAS unsigned*)(slot + (ai * 4 + m) * 64 + fr * 4));
        const bool rot = u.pn >= rot_lo && u.pn < rot_hi;
        if (!rot) {
#pragma unroll
            for (int ai = 0; ai < 2; ++ai)
#pragma unroll
                for (int m = 0; m < 4; ++m) { bf16_t* rowp = O + (size_t)(row0 + ai * HALF + m * 16) * ldc + col0;
#pragma unroll
                    for (int bj = 0; bj < 2; ++bj) { const f32x4 v0 = acc[ai][bj][m][0] * rs[ai][m], v1 = acc[ai][bj][m][1] * rs[ai][m];
                        u32x4 w; w.x = cvt_pk_bf16(v0[0], v0[1]); w.y = cvt_pk_bf16(v0[2], v0[3]); w.z = cvt_pk_bf16(v1[0], v1[1]); w.w = cvt_pk_bf16(v1[2], v1[3]);
                        epi_store16(rowp + bj * EPI_BJ, lane_xpose(w, sa)); } }
        } else {
            const float* gp = (u.pn < rot_k ? qg : kg) + 8 * fq;
            const f32x4 g1a = *(const f32x4*)gp, g1b = *(const f32x4*)(gp + 4), g2a = *(const f32x4*)(gp + 32), g2b = *(const f32x4*)(gp + 36);
#pragma unroll
            for (int ai = 0; ai < 2; ++ai)
#pragma unroll
                for (int m = 0; m < 4; ++m) {
                    const int rowa = u.pm * BM + ai * HALF + wr * 64 + m * 16 + fr;
                    const f32x4* cp = (const f32x4*)(cosT + (size_t)rowa * 32 + 8 * fq); const f32x4* sp = (const f32x4*)(sinT + (size_t)rowa * 32 + 8 * fq);
                    const f32x4 ca = cp[0], cb = cp[1], sna = sp[0], snb = sp[1];
                    const f32x4 x1a = acc[ai][0][m][0] * rs[ai][m], x1b = acc[ai][0][m][1] * rs[ai][m], x2a = acc[ai][1][m][0] * rs[ai][m], x2b = acc[ai][1][m][1] * rs[ai][m];
                    const f32x4 sq = x1a * x1a + x1b * x1b + x2a * x2a + x2b * x2b;
                    float ss = (sq[0] + sq[1]) + (sq[2] + sq[3]); ss += __shfl_xor(ss, 16); ss += __shfl_xor(ss, 32);
                    const float rq = 1.0f / sqrtf(ss * (1.0f / 64.0f) + 1e-6f);
                    const f32x4 y1a = x1a * rq * g1a, y1b = x1b * rq * g1b, y2a = x2a * rq * g2a, y2b = x2b * rq * g2b;
                    const f32x4 o1a = y1a * ca - y2a * sna, o1b = y1b * cb - y2b * snb, o2a = y2a * ca + y1a * sna, o2b = y2b * cb + y1b * snb;
                    bf16_t* rowp = O + (size_t)(row0 + ai * HALF + m * 16) * ldc + col0;
                    u32x4 w1; w1.x = cvt_pk_bf16(o1a[0], o1a[1]); w1.y = cvt_pk_bf16(o1a[2], o1a[3]); w1.z = cvt_pk_bf16(o1b[0], o1b[1]); w1.w = cvt_pk_bf16(o1b[2], o1b[3]);
                    u32x4 w2; w2.x = cvt_pk_bf16(o2a[0], o2a[1]); w2.y = cvt_pk_bf16(o2a[2], o2a[3]); w2.z = cvt_pk_bf16(o2b[0], o2b[1]); w2.w = cvt_pk_bf16(o2b[2], o2b[3]);
                    epi_store16(rowp, lane_xpose(w1, sa)); epi_store16(rowp + EPI_BJ, lane_xpose(w2, sa)); }
        }
    }
};
struct EpiSwiGLU {
    static constexpr bool PERM = true, AFTER_DRAIN = false; static constexpr int NVM = 8;
    bf16_t* O; int ldc; const unsigned* rowsq;
    __device__ __forceinline__ void prefetch(PG8_LAS unsigned char* slot, const Unit& u, int wr, int fr, int fq) const { prefetch_rsq(slot, rowsq, u, wr, fr, fq); }
    typedef float f32x2 __attribute__((ext_vector_type(2)));
    __device__ __forceinline__ f32x2 sg2(f32x2 g, f32x2 u, float rl, float r2) const {
        const f32x2 a = g * rl; f32x2 e; e.x = __builtin_amdgcn_exp2f(a.x); e.y = __builtin_amdgcn_exp2f(a.y);
        const f32x2 d = e + 1.0f; f32x2 q; q.x = __builtin_amdgcn_rcpf(d.x); q.y = __builtin_amdgcn_rcpf(d.y);
        return (g * u) * (q * r2);
    }
    __device__ __forceinline__ void operator()(const f32x4 (&acc)[2][2][4][2], const Unit& u, int wr, int wc, int fr, int fq, const PG8_LAS unsigned char* slot) const {
        const int lane = fr + 16 * fq, pr = lane >> 2, pc = lane & 3, sa = (pr + 16 * pc) * 4;
        const int row0 = u.pm * BM + wr * 64 + pr, col0 = u.pn * HALF + wc * 32 + 8 * pc;
        float rs[2][4];
#pragma unroll
        for (int ai = 0; ai < 2; ++ai)
#pragma unroll
            for (int m = 0; m < 4; ++m) rs[ai][m] = rstd_of(*(const PG8_LAS unsigned*)(slot + (ai * 4 + m) * 64 + fr * 4));
#pragma unroll
        for (int ai = 0; ai < 2; ++ai)
#pragma unroll
            for (int m = 0; m < 4; ++m) { bf16_t* rowp = O + (size_t)(row0 + ai * HALF + m * 16) * ldc + col0; const float r = rs[ai][m], rl = r * -1.44269504088896341f, r2 = r * r * 5.9604644775390625e-08f;
                const f32x4 g0 = acc[ai][0][m][0], g1 = acc[ai][0][m][1], u0 = acc[ai][1][m][0], u1 = acc[ai][1][m][1];
                const f32x2 G0 = {g0[0], g0[1]}, G1 = {g0[2], g0[3]}, G2 = {g1[0], g1[1]}, G3 = {g1[2], g1[3]};
                const f32x2 a0 = G0 * rl - 24.0f, a1 = G1 * rl - 24.0f, a2 = G2 * rl - 24.0f, a3 = G3 * rl - 24.0f;
                f32x2 d0, d1, d2, d3;
                d0.x = __builtin_amdgcn_exp2f(a0.x); d0.y = __builtin_amdgcn_exp2f(a0.y); d1.x = __builtin_amdgcn_exp2f(a1.x); d1.y = __builtin_amdgcn_exp2f(a1.y);
                d2.x = __builtin_amdgcn_exp2f(a2.x); d2.y = __builtin_amdgcn_exp2f(a2.y); d3.x = __builtin_amdgcn_exp2f(a3.x); d3.y = __builtin_amdgcn_exp2f(a3.y);
                d0 = d0 + 5.9604644775390625e-08f; d1 = d1 + 5.9604644775390625e-08f; d2 = d2 + 5.9604644775390625e-08f; d3 = d3 + 5.9604644775390625e-08f;
                const f32x2 P01 = d0 * d1, P23 = d2 * d3, P = P01 * P23; f32x2 R; R.x = __builtin_amdgcn_rcpf(P.x); R.y = __builtin_amdgcn_rcpf(P.y);
                const f32x2 R01 = R * P23, R23 = R * P01;
                const f32x2 q0 = R01 * d1, q1 = R01 * d0, q2 = R23 * d3, q3 = R23 * d2;
                const f32x2 h0 = (G0 * (f32x2){u0[0], u0[1]}) * (q0 * r2), h1 = (G1 * (f32x2){u0[2], u0[3]}) * (q1 * r2);
                const f32x2 h2 = (G2 * (f32x2){u1[0], u1[1]}) * (q2 * r2), h3 = (G3 * (f32x2){u1[2], u1[3]}) * (q3 * r2);
                u32x4 w; w.x = cvt_pk_bf16(h0.x, h0.y); w.y = cvt_pk_bf16(h1.x, h1.y); w.z = cvt_pk_bf16(h2.x, h2.y); w.w = cvt_pk_bf16(h3.x, h3.y);
                epi_store16(rowp, lane_xpose(w, sa)); }
    }
};
template <bool FINAL, bool ATOM = true> struct EpiResAdd {
    static constexpr bool PERM = true, AFTER_DRAIN = false; static constexpr int NVM = FINAL ? 32 : 16;
    bf16_t* xb; float* out; unsigned* rowsq_out; int ldc; float scale;
    __device__ __forceinline__ void prefetch(PG8_LAS unsigned char*, const Unit&, int, int, int) const {}
    __device__ __forceinline__ void operator()(const f32x4 (&acc)[2][2][4][2], const Unit& u, int wr, int wc, int fr, int fq, const PG8_LAS unsigned char*) const {
        const int lane = fr + 16 * fq, pr = lane >> 2, pc = lane & 3, sa = (pr + 16 * pc) * 4;
        const int row0 = u.pm * BM + wr * 64 + pr, col0 = u.pn * BM + wc * EPI_WC + 8 * pc;
#pragma unroll
        for (int ai = 0; ai < 2; ++ai) {
            u32x4 b[4][2];
#pragma unroll
            for (int m = 0; m < 4; ++m) { const size_t off = (size_t)(row0 + ai * HALF + m * 16) * ldc + col0;
#pragma unroll
                for (int bj = 0; bj < 2; ++bj) b[m][bj] = *(const u32x4*)(xb + off + bj * EPI_BJ); }
#pragma unroll
            for (int m = 0; m < 4; ++m) { const int row = row0 + ai * HALF + m * 16; const size_t off = (size_t)row * ldc + col0; float ss = 0.f;
#pragma unroll
                for (int bj = 0; bj < 2; ++bj) {
                    const f32x4 a0 = acc[ai][bj][m][0], a1 = acc[ai][bj][m][1];
                    const u32x4 bw = b[m][bj];
                    const f32x4 r0 = {__builtin_bit_cast(float, bw.x << 16), __builtin_bit_cast(float, bw.x & 0xffff0000u), __builtin_bit_cast(float, bw.y << 16), __builtin_bit_cast(float, bw.y & 0xffff0000u)};
                    const f32x4 r1 = {__builtin_bit_cast(float, bw.z << 16), __builtin_bit_cast(float, bw.z & 0xffff0000u), __builtin_bit_cast(float, bw.w << 16), __builtin_bit_cast(float, bw.w & 0xffff0000u)};
                    const f32x4 x0 = __builtin_bit_cast(f32x4, lane_xpose(__builtin_bit_cast(u32x4, a0), sa)) * scale + r0, x1 = __builtin_bit_cast(f32x4, lane_xpose(__builtin_bit_cast(u32x4, a1), sa)) * scale + r1;
                    if constexpr (FINAL) { epi_store16(out + off + bj * EPI_BJ, __builtin_bit_cast(u32x4, x0)); epi_store16(out + off + bj * EPI_BJ + 4, __builtin_bit_cast(u32x4, x1)); }
                    else { u32x4 w; w.x = cvt_pk_bf16(x0[0], x0[1]); w.y = cvt_pk_bf16(x0[2], x0[3]); w.z = cvt_pk_bf16(x1[0], x1[1]); w.w = cvt_pk_bf16(x1[2], x1[3]);
                        epi_store16(xb + off + bj * EPI_BJ, w);
                        ss += (x0[0] * x0[0] + x0[1] * x0[1]) + (x0[2] * x0[2] + x0[3] * x0[3]) + (x1[0] * x1[0] + x1[1] * x1[1]) + (x1[2] * x1[2] + x1[3] * x1[3]); } }
                if constexpr (!FINAL) { ss += __shfl_xor(ss, 1); ss += __shfl_xor(ss, 2);
                    if (ATOM && pc == 0) __hip_atomic_fetch_add(rowsq_out + row, (unsigned)(ss * RSQ_SCALE), __ATOMIC_RELAXED, __HIP_MEMORY_SCOPE_AGENT); } }
            asm volatile("" ::: "memory"); }
    }
};

template <int MODE> struct EpiBf16Probe {
    static constexpr bool PERM = true, AFTER_DRAIN = false; static constexpr int NVM = 0;
    bf16_t* O; int ldc;
    __device__ __forceinline__ void prefetch(PG8_LAS unsigned char*, const Unit&, int, int, int) const {}
    __device__ __forceinline__ void operator()(const f32x4 (&acc)[2][2][4][2], const Unit& u, int wr, int wc, int fr, int fq, const PG8_LAS unsigned char*) const {
        const int lane = fr + 16 * fq, pr = lane >> 2, pc = lane & 3, sa = (pr + 16 * pc) * 4;
        const int row0 = wr * 64 + pr, col0 = wc * 32 + 8 * pc;
        bf16_t* Ob = O + (size_t)blockIdx.x * 65536;
        if (MODE == 4) { const size_t ul = ((size_t)u.pm * 32 + u.pn); bf16_t* Ot = O + ul * 65536 + (size_t)(wr * 64 + pr) * 256 + wc * 32 + 8 * pc;
#pragma unroll
            for (int ai = 0; ai < 2; ++ai)
#pragma unroll
                for (int m = 0; m < 4; ++m)
#pragma unroll
                    for (int bj = 0; bj < 2; ++bj) { const f32x4 v0 = acc[ai][bj][m][0], v1 = acc[ai][bj][m][1];
                        u32x4 w; w.x = cvt_pk_bf16(v0[0], v0[1]); w.y = cvt_pk_bf16(v0[2], v0[3]); w.z = cvt_pk_bf16(v1[0], v1[1]); w.w = cvt_pk_bf16(v1[2], v1[3]);
                        *(u32x4*)(Ot + (size_t)(ai * HALF + m * 16) * 256 + bj * HALF) = lane_xpose(w, sa); }
            return; }
        if (MODE == 3) { const size_t ul = ((size_t)u.pm * 32 + u.pn); bf16_t* Oc = O + ul * 65536 + (size_t)(wr * 4 + wc) * 8192 + lane * 8; int k = 0;
#pragma unroll
            for (int ai = 0; ai < 2; ++ai)
#pragma unroll
                for (int m = 0; m < 4; ++m)
#pragma unroll
                    for (int bj = 0; bj < 2; ++bj) { const f32x4 v0 = acc[ai][bj][m][0], v1 = acc[ai][bj][m][1];
                        u32x4 w; w.x = cvt_pk_bf16(v0[0], v0[1]); w.y = cvt_pk_bf16(v0[2], v0[3]); w.z = cvt_pk_bf16(v1[0], v1[1]); w.w = cvt_pk_bf16(v1[2], v1[3]);
                        *(u32x4*)(Oc + (k++) * 512) = lane_xpose(w, sa); }
            return; }
#pragma unroll
        for (int ai = 0; ai < 2; ++ai)
#pragma unroll
            for (int m = 0; m < 4; ++m) { bf16_t* rowp = Ob + (size_t)(row0 + ai * HALF + m * 16) * 256 + col0;
#pragma unroll
                for (int bj = 0; bj < 2; ++bj) { const f32x4 v0 = acc[ai][bj][m][0], v1 = acc[ai][bj][m][1];
                    u32x4 w; w.x = cvt_pk_bf16(v0[0], v0[1]); w.y = cvt_pk_bf16(v0[2], v0[3]); w.z = cvt_pk_bf16(v1[0], v1[1]); w.w = cvt_pk_bf16(v1[2], v1[3]);
                    const u32x4 t = lane_xpose(w, sa);
                    if (MODE == 1 || t.x == 0x12345678u) *(u32x4*)(rowp + bj * HALF) = t; } }
    }
};
struct EpiNone {
    static constexpr bool PERM = true, AFTER_DRAIN = false; static constexpr int NVM = 0;
    float* sink;
    __device__ __forceinline__ void prefetch(PG8_LAS unsigned char*, const Unit&, int, int, int) const {}
    __device__ __forceinline__ void operator()(const f32x4 (&acc)[2][2][4][2], const Unit& u, int wr, int wc, int fr, int fq, const PG8_LAS unsigned char*) const {
        float s = 0.f;
#pragma unroll
        for (int ai = 0; ai < 2; ++ai)
#pragma unroll
            for (int bj = 0; bj < 2; ++bj)
#pragma unroll
                for (int m = 0; m < 4; ++m)
#pragma unroll
                    for (int n = 0; n < 2; ++n) s += acc[ai][bj][m][n][0] + acc[ai][bj][m][n][1] + acc[ai][bj][m][n][2] + acc[ai][bj][m][n][3];
        if (s == 123456.789f) sink[u.pm + wr + wc + fr + fq] = s;
    }
};

#ifndef PG8_RELAX
#define PG8_RELAX 0
#endif
#ifndef PROBE_STAMP
#define PROBE_STAMP 0
#endif
template <class Epi, class Sched, bool ALIGN_EPI = false, bool SP2 = false>
__device__ __forceinline__ void gemm_phase(PG8_LAS unsigned char* lds, const Gemm g, const Sched& S, const Epi& E, unsigned long long* stamp_out = nullptr) {
    int tid_ = threadIdx.x; asm volatile("" : "+v"(tid_));
    const int tid = tid_, wid = __builtin_amdgcn_readfirstlane(tid >> 6), lane = tid & 63, wr = wid >> 2, wc = wid & 3, fr = lane & 15, fq = lane >> 4;
    const int K = g.K, nt = K / BK;
    unsigned voffA[2], voffB[2];
#pragma unroll
    for (int i = 0; i < 2; ++i) { int R, C; stage_rc(tid * 16 + i * 8192, R, C); const int Rb = Epi::PERM ? ((R & ~31) + perm32(R & 31)) : R;
        voffA[i] = (unsigned)(R * K + C) * 2u; voffB[i] = (unsigned)(Rb * K + C) * 2u; }
    const size_t kstep = (size_t)(BK * 2);
    const size_t hstep = (size_t)HALF * K * 2;
    const size_t tstep = 2 * hstep;
    const unsigned ldsw = (unsigned)wid * 1024u;
    const int aoff = lds_byte(wr * 64 + fr, fq * 8), boff = lds_byte(wc * 32 + fr, fq * 8);
#define PG8_SA(b, h) (((b) * 2 + (h)) * HTB)
#define PG8_SB(b, h) ((4 + (b) * 2 + (h)) * HTB)
#define PG8_STAGE(bufoff, gbase, voff) do { _Pragma("unroll") for (int _i = 0; _i < 2; ++_i) \
        __builtin_amdgcn_global_load_lds((const unsigned*)((const char*)(gbase) + (voff)[_i]), (PG8_LAS unsigned*)(lds + (bufoff) + ldsw + _i * 8192), 16, 0, 0); } while (0)
#define PG8_LDA(dst, b, h) do { _Pragma("unroll") for (int m = 0; m < 4; ++m) _Pragma("unroll") for (int k = 0; k < 2; ++k) dst[m][k] = *(const PG8_LAS bf16x8*)(lds + PG8_SA(b, h) + aoff + m * 2048 + k * 1024); } while (0)
#define PG8_LDB(dst, b, h) do { _Pragma("unroll") for (int n = 0; n < 2; ++n) _Pragma("unroll") for (int k = 0; k < 2; ++k) dst[n][k] = *(const PG8_LAS bf16x8*)(lds + PG8_SB(b, h) + boff + n * 2048 + k * 1024); } while (0)
#define PG8_MMA(ai, bj, At, Bt) do { __builtin_amdgcn_s_setprio(1); _Pragma("unroll") for (int m = 0; m < 4; ++m) _Pragma("unroll") for (int n = 0; n < 2; ++n) _Pragma("unroll") for (int k = 0; k < 2; ++k) \
        acc[ai][bj][m][n] = __builtin_amdgcn_mfma_f32_16x16x32_bf16(Bt[n][k], At[m][k], acc[ai][bj][m][n], 0, 0, 0); __builtin_amdgcn_s_setprio(0); } while (0)
#define PG8_WAIT_V(n) asm volatile("s_waitcnt vmcnt(" #n ")" ::: "memory")
#define PG8_WAIT_L(n) asm volatile("s_waitcnt lgkmcnt(" #n ")" ::: "memory")
#define PG8_WAIT_VR(rl) do { if (rl) asm volatile("s_waitcnt vmcnt(%0)" :: "n"(8 + Epi::NVM) : "memory"); else asm volatile("s_waitcnt vmcnt(8)" ::: "memory"); } while (0)
#define PG8_BAR __builtin_amdgcn_s_barrier()
#define PG8_SCHED __builtin_amdgcn_sched_barrier(0)
    Unit cur, nxt; int ui = 0;
    if (!S.next(0, cur)) return;
    f32x4 acc[2][2][4][2];
#pragma unroll
    for (int a = 0; a < 2; ++a)
#pragma unroll
        for (int b = 0; b < 2; ++b)
#pragma unroll
            for (int m = 0; m < 4; ++m)
#pragma unroll
                for (int n = 0; n < 2; ++n) acc[a][b][m][n] = (f32x4){0.f, 0.f, 0.f, 0.f};
    bf16x8 At[4][2], B0[2][2], B1[2][2];
    const char* cA = (const char*)g.A + (size_t)cur.pm * tstep; const char* cB = (const char*)g.Bt + (size_t)cur.pn * tstep;
    S.a_ready(cur);
    PG8_LAS unsigned char* const epi_lds = lds + STAGE_BYTES + wid * 512;
    E.prefetch(epi_lds, cur, wr, fr, fq);
    if constexpr (SP2) {
        PG8_STAGE(PG8_SB(0, 0), cB, voffB); PG8_STAGE(PG8_SB(0, 1), cB + hstep, voffB); PG8_STAGE(PG8_SA(0, 0), cA, voffA); PG8_STAGE(PG8_SA(0, 1), cA + hstep, voffA);
        if (wr == 1) PG8_BAR;
        PG8_WAIT_V(2); PG8_BAR;
        PG8_STAGE(PG8_SB(1, 0), cB + kstep, voffB); PG8_STAGE(PG8_SA(1, 0), cA + kstep, voffA); PG8_STAGE(PG8_SB(1, 1), cB + hstep + kstep, voffB);
        PG8_WAIT_V(6); PG8_BAR;
    } else {
        PG8_STAGE(PG8_SB(0, 0), cB, voffB); PG8_STAGE(PG8_SA(0, 0), cA, voffA); PG8_STAGE(PG8_SB(0, 1), cB + hstep, voffB); PG8_STAGE(PG8_SA(0, 1), cA + hstep, voffA);
        if (wr == 1) PG8_BAR;
        PG8_WAIT_V(4); PG8_BAR;
        PG8_STAGE(PG8_SB(1, 0), cB + kstep, voffB); PG8_STAGE(PG8_SA(1, 0), cA + kstep, voffA); PG8_STAGE(PG8_SB(1, 1), cB + hstep + kstep, voffB);
        PG8_WAIT_V(6); PG8_BAR;
    }
    for (;;) {
        const bool has_next = S.next(ui + 1, nxt);
        const char* nA = has_next ? (const char*)g.A + (size_t)nxt.pm * tstep : cA; const char* nB = has_next ? (const char*)g.Bt + (size_t)nxt.pn * tstep : cB;
#if PROBE_STAMP
        unsigned long long st0_ = 0; if (stamp_out && ui == 2 && wid == 0) st0_ = (PROBE_STAMP == 1) ? (unsigned long long)__builtin_amdgcn_s_memtime() : (unsigned long long)__builtin_amdgcn_s_memrealtime();
#endif
        for (int t = 0; t < nt; t += 2) {
            const bool last = (t == nt - 2);
            const char* a1 = cA + (size_t)(t + 1) * kstep;
            const char* a2 = last ? nA : cA + (size_t)(t + 2) * kstep; const char* b2 = last ? nB : cB + (size_t)(t + 2) * kstep;
            const char* a3 = a2 + kstep; const char* b3 = b2 + kstep;
            if (last && has_next) S.a_ready(nxt);
            int relax_ = __builtin_amdgcn_readfirstlane((PG8_RELAX && (ui > 0) && (t == 0)) ? 1 : 0); asm volatile("" : "+s"(relax_));
            const bool relax = relax_ != 0;
            if constexpr (SP2) {
            PG8_LDB(B0, 0, 0); PG8_LDB(B1, 0, 1); PG8_SCHED; PG8_LDA(At, 0, 0); PG8_STAGE(PG8_SA(1, 1), a1 + hstep, voffA);
            PG8_WAIT_VR(relax); PG8_WAIT_L(0); PG8_BAR; PG8_MMA(0, 0, At, B0); PG8_MMA(0, 1, At, B1); PG8_BAR; PG8_SCHED;
            PG8_LDA(At, 0, 1); PG8_STAGE(PG8_SB(0, 0), b2, voffB); PG8_STAGE(PG8_SB(0, 1), b2 + hstep, voffB); PG8_STAGE(PG8_SA(0, 0), a2, voffA);
            PG8_WAIT_VR(relax); PG8_WAIT_L(0); PG8_BAR; PG8_MMA(1, 0, At, B0); PG8_MMA(1, 1, At, B1); PG8_BAR; PG8_SCHED;
            PG8_LDB(B0, 1, 0); PG8_LDB(B1, 1, 1); PG8_SCHED; PG8_LDA(At, 1, 0); PG8_STAGE(PG8_SA(0, 1), a2 + hstep, voffA);
            PG8_WAIT_V(8); PG8_WAIT_L(0); PG8_BAR; PG8_MMA(0, 0, At, B0); PG8_MMA(0, 1, At, B1); PG8_BAR; PG8_SCHED;
            PG8_LDA(At, 1, 1); PG8_STAGE(PG8_SB(1, 0), b3, voffB); PG8_STAGE(PG8_SB(1, 1), b3 + hstep, voffB); PG8_STAGE(PG8_SA(1, 0), a3, voffA);
            PG8_WAIT_V(8); PG8_WAIT_L(0); PG8_BAR; PG8_MMA(1, 0, At, B0); PG8_MMA(1, 1, At, B1); PG8_BAR; PG8_SCHED;
            } else {
            PG8_LDB(B0, 0, 0); PG8_SCHED; PG8_LDA(At, 0, 0); PG8_STAGE(PG8_SA(1, 1), a1 + hstep, voffA);
            PG8_WAIT_L(8); PG8_BAR; PG8_WAIT_L(0); PG8_MMA(0, 0, At, B0); PG8_BAR; PG8_SCHED;
            PG8_LDB(B1, 0, 1); PG8_STAGE(PG8_SB(0, 0), b2, voffB);
            PG8_BAR; PG8_WAIT_L(0); PG8_MMA(0, 1, At, B1); PG8_BAR;
            PG8_LDA(At, 0, 1); PG8_STAGE(PG8_SA(0, 0), a2, voffA);
            PG8_BAR; PG8_WAIT_L(0); PG8_MMA(1, 0, At, B0); PG8_BAR; PG8_SCHED;
            PG8_STAGE(PG8_SB(0, 1), b2 + hstep, voffB);
            PG8_WAIT_V(6); PG8_BAR; PG8_MMA(1, 1, At, B1); PG8_BAR;
            PG8_LDB(B0, 1, 0); PG8_SCHED; PG8_LDA(At, 1, 0); PG8_STAGE(PG8_SA(0, 1), a2 + hstep, voffA);
            PG8_WAIT_L(8); PG8_BAR; PG8_WAIT_L(0); PG8_MMA(0, 0, At, B0); PG8_BAR; PG8_SCHED;
            PG8_LDB(B1, 1, 1); PG8_STAGE(PG8_SB(1, 0), b3, voffB);
            PG8_BAR; PG8_WAIT_L(0); PG8_MMA(0, 1, At, B1); PG8_BAR;
            PG8_LDA(At, 1, 1); PG8_STAGE(PG8_SA(1, 0), a3, voffA);
            PG8_BAR; PG8_WAIT_L(0); PG8_MMA(1, 0, At, B0); PG8_BAR; PG8_SCHED;
            PG8_STAGE(PG8_SB(1, 1), b3 + hstep, voffB);
            PG8_WAIT_V(6); PG8_BAR; PG8_MMA(1, 1, At, B1); PG8_BAR;
            }
        }
#if PROBE_STAMP
        if (stamp_out && ui == 2 && wid == 0) { const unsigned long long st1_ = (PROBE_STAMP == 1) ? (unsigned long long)__builtin_amdgcn_s_memtime() : (unsigned long long)__builtin_amdgcn_s_memrealtime(); if (lane == 0) stamp_out[0] = st1_ - st0_; }
#endif
        if constexpr (ALIGN_EPI) { if (wr == 0) PG8_BAR; }
        if constexpr (!Epi::AFTER_DRAIN) { E(acc, cur, wr, wc, fr, fq, epi_lds); S.done(cur); }
        if (!has_next) break;
        { f32x4 z4_ = {0.f, 0.f, 0.f, 0.f}; asm volatile("" : "+v"(z4_));
#pragma unroll
        for (int a = 0; a < 2; ++a)
#pragma unroll
            for (int b = 0; b < 2; ++b)
#pragma unroll
                for (int m = 0; m < 4; ++m)
#pragma unroll
                    for (int n = 0; n < 2; ++n) acc[a][b][m][n] = z4_; }
        cur = nxt; cA = nA; cB = nB; ++ui;
        E.prefetch(epi_lds, cur, wr, fr, fq);
        if constexpr (ALIGN_EPI) { if (wr == 1) PG8_BAR; }
    }
    PG8_WAIT_V(0);
    if constexpr (!ALIGN_EPI) { if (wr == 0) PG8_BAR; }
    PG8_BAR;
    if constexpr (Epi::AFTER_DRAIN) { E.fused(acc, cur, wr, wc, fr, fq, lds, wid, lane); S.done(cur); }
#undef PG8_SA
#undef PG8_SB
#undef PG8_STAGE
#undef PG8_LDA
#undef PG8_LDB
#undef PG8_MMA
#undef PG8_WAIT_V
#undef PG8_WAIT_L
#undef PG8_WAIT_VR
#undef PG8_BAR
#undef PG8_SCHED
}
}

#define GAS __attribute__((address_space(1)))
#define LAS __attribute__((address_space(3)))
typedef unsigned short bf16;
typedef unsigned v4u __attribute__((ext_vector_type(4)));
typedef float f32x4 __attribute__((ext_vector_type(4)));
typedef GAS unsigned gu32;
#define LDS_WAIT() asm volatile("s_waitcnt lgkmcnt(0)" ::: "memory")
#define VM_WAIT() asm volatile("s_waitcnt vmcnt(0)" ::: "memory")

__device__ __forceinline__ size_t t256_off(int m, int c, int ntn) { return ((size_t)(m >> 8) * ntn + (c >> 8)) * 65536 + (size_t)((m & 255) * 256 + (c & 255)); }
#define P_OFF(m_, c_) t256_off((m_), (c_), 32)
#define X_OFF(m_, c_) t256_off((m_), (c_), 8)

#define XB_TMO      128
#define XB_XCNT(j)  (256  + 64 * (j))
#define XB_XSUB(j)  (1280 + 64 * (j))
#define XB_XGEN(j)  (2304 + 64 * (j))
#define XB_TOP      3328
#define XB_TOPGEN   3392
#define XCD_BAR_WORDS 3456
#define XB_SPIN_CAP (1u << 18)

__device__ __forceinline__ unsigned xb_ld(unsigned* p)              { return __hip_atomic_load(p, __ATOMIC_RELAXED, __HIP_MEMORY_SCOPE_AGENT); }
__device__ __forceinline__ unsigned xb_add(unsigned* p, unsigned v) { return __hip_atomic_fetch_add(p, v, __ATOMIC_RELAXED, __HIP_MEMORY_SCOPE_AGENT); }
__device__ __forceinline__ unsigned xb_xcc_id() { return (unsigned)__builtin_amdgcn_s_getreg((3 << 11) | 20) & 0xFu; }
#define XB_SPIN(cond, bar) do { unsigned _sp = 0; while (cond) { __builtin_amdgcn_s_sleep(1); \
    if ((++_sp & 255u) == 0u) { if (xb_ld(&(bar)[XB_TMO])) break; if (_sp > XB_SPIN_CAP) { atomicAdd(&(bar)[XB_TMO], 1u); break; } } } } while (0)

struct XcdBarrier {
    unsigned* bar; unsigned x;
    unsigned total;
    volatile LAS unsigned* st;
};

__device__ __forceinline__ XcdBarrier xcd_barrier_post(unsigned* bar, volatile LAS unsigned* st, unsigned total = 0u) {
    XcdBarrier b; b.bar = bar; b.x = xb_xcc_id(); b.st = st; b.total = total;
    if (threadIdx.x == 0) (void)xb_add(&bar[XB_XCNT(b.x)], 1u);
    return b;
}
__device__ __forceinline__ void xcd_barrier_complete(unsigned* bar, unsigned x, unsigned total, unsigned& nloc, unsigned& nx) {
    const unsigned G = total ? total : gridDim.x * gridDim.y * gridDim.z;
    unsigned sum, cnt, mine, sp = 0u;
    for (;;) {
        sum = 0u; cnt = 0u; mine = 0u;
#pragma unroll
        for (unsigned j = 0; j < 16; ++j) { const unsigned c = xb_ld(&bar[XB_XCNT(j)]); sum += c; cnt += (c > 0u) ? 1u : 0u; mine = (j == x) ? c : mine; }
        if (sum == G) break;
        __builtin_amdgcn_s_sleep(1);
        if ((++sp & 255u) == 0u) { if (xb_ld(&bar[XB_TMO])) break; if (sp > XB_SPIN_CAP) { atomicAdd(&bar[XB_TMO], 1u); break; } }
    }
    nloc = mine > 0u ? mine : 1u; nx = cnt > 0u ? cnt : 1u;
}

__device__ __forceinline__ void xcd_barrier(const XcdBarrier& b) {
    asm volatile("s_waitcnt vmcnt(0)" ::: "memory");
    __syncthreads();
    if (threadIdx.x == 0) {
        unsigned* bar = b.bar;
        __builtin_amdgcn_s_waitcnt(0);
        unsigned nloc = b.st[0], nx = b.st[1];
        if (nloc == 0u) { xcd_barrier_complete(bar, b.x, b.total, nloc, nx); b.st[0] = nloc; b.st[1] = nx; }
        const unsigned old = xb_add(&bar[XB_XSUB(b.x)], 1u);
        const unsigned gen = old / nloc;
        if (old + 1u == (gen + 1u) * nloc) {
            __builtin_amdgcn_fence(__ATOMIC_RELEASE, "agent");
            asm volatile("s_waitcnt vmcnt(0)" ::: "memory");
            const unsigned og = xb_add(&bar[XB_TOP], 1u);
            const unsigned tg = og / nx;
            if (og + 1u == (tg + 1u) * nx) xb_add(&bar[XB_TOPGEN], 1u);
            else XB_SPIN(xb_ld(&bar[XB_TOPGEN]) == tg, bar);
            __builtin_amdgcn_fence(__ATOMIC_ACQUIRE, "agent");
            xb_add(&bar[XB_XGEN(b.x)], 1u);
            asm volatile("s_waitcnt vmcnt(0)" ::: "memory");
        } else {
            XB_SPIN(xb_ld(&bar[XB_XGEN(b.x)]) == gen, bar);
            __builtin_amdgcn_fence(__ATOMIC_ACQUIRE, "agent");
            asm volatile("s_waitcnt vmcnt(0)" ::: "memory");
        }
    }
    __syncthreads();
}

namespace att {
using bf16x8 = __attribute__((ext_vector_type(8))) short;
using s16x4  = __attribute__((ext_vector_type(4))) short;
using f32x16 = __attribute__((ext_vector_type(16))) float;
using u32x4  = __attribute__((ext_vector_type(4))) unsigned;
constexpr int QBLK = 32, KVBLK = 64, NW = 8, DV = 128, DQK = 64;
constexpr float SCALE = 0.125f, THR = 8.f;
constexpr int ATT_LDP = 8192, ATT_LDO = 1024;
#ifndef ATT_OSTAGE
#define ATT_OSTAGE 1
#endif
constexpr int ATT_OST_OFF = 53248;
constexpr int SHM_V = KVBLK * DV * 2, SHM_K = KVBLK * DQK * 2, SHM_ATTN = 2 * SHM_V + 2 * SHM_K + NW * 64 * 4;
#define ATT_KSWZ(row, colB) ((row) * 128 + ((colB) ^ ((((row) >> 1) & 7) << 4)))
#define ATT_SBAR() __builtin_amdgcn_sched_barrier(0)
__device__ __forceinline__ int crow(int r, int hi) { return (r & 3) + 8 * (r >> 2) + 4 * hi; }
__device__ __forceinline__ unsigned cvtpk(float lo, float hi) { unsigned r; asm volatile("v_cvt_pk_bf16_f32 %0, %1, %2" : "=v"(r) : "v"(lo), "v"(hi)); return r; }

template <int PMODE> __device__ __forceinline__ void partialSM(f32x16& p0, f32x16& p1, float mbC) {
  constexpr float C = SCALE * 1.4426950408889634f;
#pragma unroll
  for (int r = 0; r < 16; ++r) p0[r] = fmaf(p0[r], C, -mbC);
#pragma unroll
  for (int r = 0; r < 16; ++r) p1[r] = fmaf(p1[r], C, -mbC);
#pragma unroll
  for (int r = 0; r < 16; ++r) p0[r] = (PMODE == 1) ? p0[r] : __builtin_amdgcn_exp2f(p0[r]);
}
template <int PMODE> __device__ __forceinline__ void finishSM(f32x16& p0, f32x16& p1, float& l_reg, bf16x8& pa0, bf16x8& pa1, bf16x8& pa2, bf16x8& pa3) {
#pragma unroll
  for (int r = 0; r < 16; ++r) p1[r] = (PMODE == 1) ? p1[r] : __builtin_amdgcn_exp2f(p1[r]);
  float ps = 0;
#pragma unroll
  for (int r = 0; r < 16; ++r) ps += p0[r];
#pragma unroll
  for (int r = 0; r < 16; ++r) ps += p1[r];
  { auto rr = __builtin_amdgcn_permlane32_swap(__float_as_uint(ps), __float_as_uint(ps), false, false);
    ps = __uint_as_float(rr[0]) + __uint_as_float(rr[1]); }
  l_reg += ps;
#define ATT_PK4(P, BASE, OUT) do { unsigned a0 = cvtpk(P[BASE + 0], P[BASE + 1]), a1 = cvtpk(P[BASE + 2], P[BASE + 3]);   \
    unsigned b0 = cvtpk(P[BASE + 4], P[BASE + 5]), b1 = cvtpk(P[BASE + 6], P[BASE + 7]);                              \
    auto r0 = __builtin_amdgcn_permlane32_swap(a0, b0, false, false); auto r1 = __builtin_amdgcn_permlane32_swap(a1, b1, false, false); \
    u32x4 w = {r0[0], r1[0], r0[1], r1[1]}; OUT = *reinterpret_cast<bf16x8*>(&w); } while (0)
  ATT_PK4(p0, 0, pa0); ATT_PK4(p0, 8, pa1); ATT_PK4(p1, 0, pa2); ATT_PK4(p1, 8, pa3);
#undef ATT_PK4
}
__device__ __forceinline__ void qkt(f32x16& p0, f32x16& p1, const char* Ks, const bf16x8 (&qr)[4], int r32, int hi) {
  p0 = f32x16{}; p1 = f32x16{};
#pragma unroll
  for (int d0 = 0; d0 < 4; ++d0) { const int cb = (d0 * 16 + hi * 8) * 2;
    bf16x8 b0 = *reinterpret_cast<const bf16x8*>(Ks + ATT_KSWZ(r32, cb));
    bf16x8 b1 = *reinterpret_cast<const bf16x8*>(Ks + ATT_KSWZ(32 + r32, cb));
    p0 = __builtin_amdgcn_mfma_f32_32x32x16_bf16(b0, qr[d0], p0, 0, 0, 0);
    p1 = __builtin_amdgcn_mfma_f32_32x32x16_bf16(b1, qr[d0], p1, 0, 0, 0); }
}
__device__ __forceinline__ int v_st(int k, int c) { const int kk = (k & ~0xC) | ((k & 4) << 1) | ((k & 8) >> 1); return ((kk >> 3) * 4 + (c >> 5)) * 512 + ((kk & 7) * 32 + (c & 31)) * 2; }
__device__ __forceinline__ int v_rd_base(int lane) { return ((lane & 3) << 3) | (((lane >> 2) & 3) << 6) | (((lane >> 4) & 1) << 5) | (((lane >> 5) & 1) << 8); }
constexpr int v_rd_off(int d0, int ks, int half) { return d0 * 512 + ks * 4096 + half * 2048; }
template <int OFF> __device__ __forceinline__ s16x4 tr_read(int vb) {
  s16x4 r; asm volatile("ds_read_b64_tr_b16 %0, %1 offset:%2" : "=&v"(r) : "v"(vb), "i"(OFF) : "memory"); return r;
}
template <int D0> __device__ __forceinline__ void pv_one(f32x16& od, int vb, bf16x8 pa0, bf16x8 pa1, bf16x8 pa2, bf16x8 pa3) {
  const s16x4 l0 = tr_read<v_rd_off(D0, 0, 0)>(vb), h0 = tr_read<v_rd_off(D0, 0, 1)>(vb), l1 = tr_read<v_rd_off(D0, 1, 0)>(vb), h1 = tr_read<v_rd_off(D0, 1, 1)>(vb);
  const s16x4 l2 = tr_read<v_rd_off(D0, 2, 0)>(vb), h2 = tr_read<v_rd_off(D0, 2, 1)>(vb), l3 = tr_read<v_rd_off(D0, 3, 0)>(vb), h3 = tr_read<v_rd_off(D0, 3, 1)>(vb);
  asm volatile("s_waitcnt lgkmcnt(0)" ::: "memory"); ATT_SBAR();
#define ATT_PK(L, H) (bf16x8){L[0], L[1], L[2], L[3], H[0], H[1], H[2], H[3]}
  od = __builtin_amdgcn_mfma_f32_32x32x16_bf16(pa0, ATT_PK(l0, h0), od, 0, 0, 0);
  od = __builtin_amdgcn_mfma_f32_32x32x16_bf16(pa1, ATT_PK(l1, h1), od, 0, 0, 0);
  od = __builtin_amdgcn_mfma_f32_32x32x16_bf16(pa2, ATT_PK(l2, h2), od, 0, 0, 0);
  od = __builtin_amdgcn_mfma_f32_32x32x16_bf16(pa3, ATT_PK(l3, h3), od, 0, 0, 0);
#undef ATT_PK
}
__device__ __forceinline__ void pv_d0(f32x16 (&o)[4], int vb, bf16x8 pa0, bf16x8 pa1, bf16x8 pa2, bf16x8 pa3) {
  pv_one<0>(o[0], vb, pa0, pa1, pa2, pa3); pv_one<1>(o[1], vb, pa0, pa1, pa2, pa3); pv_one<2>(o[2], vb, pa0, pa1, pa2, pa3); pv_one<3>(o[3], vb, pa0, pa1, pa2, pa3);
}
__device__ __forceinline__ unsigned short f2bf(float f) { unsigned u = __builtin_bit_cast(unsigned, f); return (unsigned short)((u + 0x7fffu + ((u >> 16) & 1u)) >> 16); }

template <int PMODE = 0> __device__ __forceinline__ void attn_unit(const unsigned short* __restrict__ Qb, const unsigned short* __restrict__ Kh, const unsigned short* __restrict__ Vh,
                                          unsigned short* __restrict__ Ob, int seq, char* lds, float mbC) {
  int tid_ = threadIdx.x; asm volatile("" : "+v"(tid_));
  const int tid = tid_, wid = tid >> 6, lane = tid & 63, r32 = lane & 31, hi = lane >> 5;
  char* V_lds = lds; char* K_lds = lds + 2 * SHM_V;
  float* wsf = (float*)(lds + 2 * SHM_V + 2 * SHM_K) + wid * 64; float* li_l = wsf;
  float l_reg = 0; f32x16 o[4] = {}; bf16x8 qr[4];
  const unsigned short* Qw = Qb + (long)(wid * QBLK + r32) * ATT_LDP + hi * 8;
#pragma unroll
  for (int d0 = 0; d0 < 4; ++d0) qr[d0] = *reinterpret_cast<const bf16x8*>(Qw + d0 * 16);
  const int sr = tid >> 4, sc = (tid & 15) * 8, vst0 = v_st(sr, sc), vst1 = v_st(32 + sr, sc);
  const int kr = tid >> 3, kc = (tid & 7) * 8, kst = ATT_KSWZ(kr, kc * 2);
  const int vb0 = (int)(uintptr_t)V_lds + v_rd_base(lane);
  bf16x8 s_vs0[2], s_vs1[2], s_ks[2];
#define ATT_SLOAD(i, k0) do { s_vs0[i] = *reinterpret_cast<const bf16x8*>(&Vh[(long)((k0) + sr) * ATT_LDP + sc]); s_vs1[i] = *reinterpret_cast<const bf16x8*>(&Vh[(long)((k0) + 32 + sr) * ATT_LDP + sc]); \
    s_ks[i] = *reinterpret_cast<const bf16x8*>(&Kh[(long)((k0) + kr) * ATT_LDP + kc]); } while (0)
#define ATT_SWRITE(b, i) do { *(bf16x8*)(V_lds + (b) * SHM_V + vst0) = s_vs0[i]; *(bf16x8*)(V_lds + (b) * SHM_V + vst1) = s_vs1[i]; \
    *(bf16x8*)(K_lds + (b) * SHM_K + kst) = s_ks[i]; } while (0)
#define ATT_SWAIT() asm volatile("s_waitcnt vmcnt(3)" ::: "memory")
  f32x16 pA0, pA1, pB0, pB1; bf16x8 pa0, pa1, pa2, pa3; const int NT = seq / KVBLK;
  ATT_SLOAD(0, 0); asm volatile("s_waitcnt vmcnt(0)" ::: "memory"); ATT_SWRITE(0, 0); __syncthreads();
  qkt(pA0, pA1, K_lds, qr, r32, hi); partialSM<PMODE>(pA0, pA1, mbC);
  ATT_SLOAD(1, KVBLK); if (2 < NT) ATT_SLOAD(0, 2 * KVBLK);
  ATT_SWAIT(); ATT_SWRITE(1, 1); __syncthreads();
  for (int j = 1; j + 1 < NT; j += 2) {
    ATT_SBAR(); qkt(pB0, pB1, K_lds + SHM_K, qr, r32, hi);
    finishSM<PMODE>(pA0, pA1, l_reg, pa0, pa1, pa2, pa3); ATT_SBAR();
    ATT_SLOAD(1, (j + 2) * KVBLK); ATT_SBAR();
    if (PMODE != 2) pv_d0(o, vb0, pa0, pa1, pa2, pa3); else { o[0][0] += __builtin_bit_cast(float, (int)pa0[0]); } partialSM<PMODE>(pB0, pB1, mbC);
    __syncthreads(); ATT_SWAIT(); ATT_SWRITE(0, 0);
    __syncthreads();
    ATT_SBAR(); qkt(pA0, pA1, K_lds, qr, r32, hi);
    finishSM<PMODE>(pB0, pB1, l_reg, pa0, pa1, pa2, pa3); ATT_SBAR();
    if (j + 3 < NT) ATT_SLOAD(0, (j + 3) * KVBLK); ATT_SBAR();
    if (PMODE != 2) pv_d0(o, vb0 + SHM_V, pa0, pa1, pa2, pa3); else { o[0][0] += __builtin_bit_cast(float, (int)pa1[0]); } partialSM<PMODE>(pA0, pA1, mbC);
    __syncthreads(); ATT_SWAIT(); ATT_SWRITE(1, 1);
    __syncthreads();
  }
  ATT_SBAR(); qkt(pB0, pB1, K_lds + SHM_K, qr, r32, hi);
  finishSM<PMODE>(pA0, pA1, l_reg, pa0, pa1, pa2, pa3); ATT_SBAR();
  if (PMODE != 2) pv_d0(o, vb0, pa0, pa1, pa2, pa3); else { o[0][0] += __builtin_bit_cast(float, (int)pa0[0]); } partialSM<PMODE>(pB0, pB1, mbC);
  __syncthreads();
  finishSM<PMODE>(pB0, pB1, l_reg, pa0, pa1, pa2, pa3); ATT_SBAR();
  if (PMODE != 2) pv_d0(o, vb0 + SHM_V, pa0, pa1, pa2, pa3); else { o[0][0] += __builtin_bit_cast(float, (int)pa1[0]); }
  if (hi == 0) li_l[r32] = l_reg; asm volatile("s_waitcnt lgkmcnt(0)" ::: "memory");
  float rli[16];
#pragma unroll
  for (int r = 0; r < 16; ++r) rli[r] = __builtin_amdgcn_rcpf(li_l[crow(r, hi)]);
  unsigned short* Ow = Ob + (long)(wid * QBLK) * ATT_LDO;
#if ATT_OSTAGE
  char* Ost = lds + ATT_OST_OFF + wid * (32 * 272);
#pragma unroll
  for (int r = 0; r < 16; r += 2)
#pragma unroll
    for (int d0 = 0; d0 < 4; ++d0) { const unsigned w2 = pg8::cvt_pk_bf16(o[d0][r] * rli[r], o[d0][r + 1] * rli[r + 1]);
      *(unsigned short*)(Ost + crow(r, hi) * 272 + (d0 * 32 + r32) * 2) = (unsigned short)(w2 & 0xffffu);
      *(unsigned short*)(Ost + crow(r + 1, hi) * 272 + (d0 * 32 + r32) * 2) = (unsigned short)(w2 >> 16); }
  asm volatile("s_waitcnt lgkmcnt(0)" ::: "memory");
#pragma unroll
  for (int it = 0; it < 8; ++it) { const int row = it * 4 + (lane >> 4), c16 = lane & 15;
    const uint4 v4 = *(const uint4*)(Ost + row * 272 + c16 * 16);
    *(uint4*)(Ow + (long)row * ATT_LDO + c16 * 8) = v4; }
#else
#pragma unroll
  for (int r = 0; r < 16; ++r) { const int orow = crow(r, hi);
#pragma unroll
    for (int d0 = 0; d0 < 4; ++d0) Ow[(long)orow * ATT_LDO + d0 * 32 + r32] = f2bf(o[d0][r] * rli[r]); }
#endif
#undef ATT_SLOAD
#undef ATT_SWRITE
#undef ATT_SWAIT
}
}

#ifndef W_DROP_BITS
#define W_DROP_BITS 0
#endif

constexpr int NWAVES = 8;
constexpr int D = 2048, BATCH = 16, SEQ = 2048, DEPTH = 4, M = BATCH * SEQ;
constexpr int DFF = 5504, NGU = 2 * DFF, DIN = 8192;
constexpr int C_HGQ = 0, C_HGI = 1024, C_HGZF = 2048, C_HGZB = 3072, C_HGG = 4096, C_DAQ = 5120, C_DAK = 5632, C_DAV = 6144, C_SCB = 6656, C_SCC = 7168, C_SCU = 7680;
constexpr float EPS = 1e-6f;
enum { I_X = 0, I_POS, I_F1N, I_F1G, I_F1U, I_F1D, I_MIXN, I_WIN, I_LB, I_HGN, I_DAQN, I_DAKN, I_LQ1, I_LK1, I_LQ2, I_LK2, I_DAON, I_CW, I_CB, I_CN, I_WOUT, I_F2N, I_F2G, I_F2U, I_F2D, N_IN };

constexpr size_t MiB = 1u << 20;
constexpr size_t WS_CTL = 0, CTL_ZERO_BYTES = 3 * MiB;
constexpr size_t WS_ROWSQ = 1 * MiB;
constexpr size_t WS_SMALL = 5 * MiB;
constexpr size_t WS_ROPE = 6 * MiB;
constexpr size_t SZ_WGU = (size_t)NGU * D * 2, SZ_WD = (size_t)D * DFF * 2, SZ_WIN = (size_t)DIN * D * 2, SZ_WOUT = (size_t)D * D * 2;
constexpr size_t WS_WGU = 14 * MiB;
constexpr size_t WS_WD = WS_WGU + 8 * SZ_WGU;
constexpr size_t WS_WIN = WS_WD + 8 * SZ_WD;
constexpr size_t WS_WOUT = WS_WIN + 4 * SZ_WIN;
constexpr size_t WS_H = WS_WOUT + 4 * SZ_WOUT;
constexpr size_t WS_P = WS_H + (size_t)M * D * 2;
constexpr size_t WS_OF = WS_P + (size_t)M * DIN * 2;
constexpr size_t WS_OA = WS_OF + (size_t)2 * M * 1024 * 2;
constexpr size_t WS_END = WS_OA + (size_t)M * 1024 * 2;
static_assert(WS_WGU % 256 == 0 && WS_WD % 256 == 0 && WS_WIN % 256 == 0 && WS_H % 256 == 0 && WS_P % 256 == 0 && WS_OF % 256 == 0 && WS_OA % 256 == 0, "ws alignment");
static_assert(WS_ROWSQ + (size_t)13 * M * 4 <= CTL_ZERO_BYTES, "rowsq slots inside the per-call memset");
constexpr int CW_BAR = 4096;

constexpr int RING_OFF = 0, RING_BYTES = 131072;
constexpr int LDSCTL_OFF = 146944, MISC_OFF = LDSCTL_OFF + 320;
constexpr int LDS_BYTES = 147456;
static_assert(MISC_OFF + 128 <= LDS_BYTES && LDSCTL_OFF >= RING_BYTES, "LDS map");

typedef unsigned v2u __attribute__((ext_vector_type(2)));
typedef float f32x2 __attribute__((ext_vector_type(2)));
__device__ __forceinline__ float wave_sum(float v) {
#pragma unroll
    for (int o = 1; o < 64; o <<= 1) v += __shfl_xor(v, o);
    return v;
}
__device__ __forceinline__ float bflo(unsigned w) { return __builtin_bit_cast(float, w << 16); }
__device__ __forceinline__ float bfhi(unsigned w) { return __builtin_bit_cast(float, w & 0xffff0000u); }
__device__ __forceinline__ void unpack8(const v4u w, float (&x)[8]) { x[0] = bflo(w.x); x[1] = bfhi(w.x); x[2] = bflo(w.y); x[3] = bfhi(w.y); x[4] = bflo(w.z); x[5] = bfhi(w.z); x[6] = bflo(w.w); x[7] = bfhi(w.w); }
__device__ __forceinline__ v4u pack8(const float (&x)[8]) { v4u w; w.x = pg8::cvt_pk_bf16(x[0], x[1]); w.y = pg8::cvt_pk_bf16(x[2], x[3]); w.z = pg8::cvt_pk_bf16(x[4], x[5]); w.w = pg8::cvt_pk_bf16(x[6], x[7]); return w; }

__constant__ double c_inv_freq[32] = {1.0, 0.7498942093324559, 0.5623413251903491, 0.4216965034285822, 0.31622776601683794, 0.23713737056616552, 0.1778279410038923, 0.1333521432163324, 0.1, 0.07498942093324558, 0.05623413251903491,
    0.042169650342858224, 0.03162277660168379, 0.023713737056616554, 0.01778279410038923, 0.01333521432163324, 0.01, 0.007498942093324558, 0.005623413251903491, 0.004216965034285823, 0.0031622776601683794, 0.0023713737056616554,
    0.0017782794100389228, 0.001333521432163324, 0.001, 0.0007498942093324559, 0.0005623413251903491, 0.00042169650342858224, 0.00031622776601683794, 0.00023713737056616554, 0.00017782794100389227, 0.0001333521432163324};
__constant__ float c_lam_init[4] = {0.20000000000000007f, 0.35550906759096934f, 0.4707130183435842f, 0.5560582041556406f};

__device__ __forceinline__ void p0_transpose_item(const float* W, int K, int N, bf16* WT, int gu, const float* gain, LAS float* scr, int item, int lane) {
    const int nblk = N / 32, kb = item / nblk, nb = item % nblk, k0 = 64 * kb, n0 = 32 * nb;
#pragma unroll
    for (int i = 0; i < 8; ++i) { const int kk = 8 * i + (lane >> 3), n4 = (lane & 7) * 4;
        f32x4 v = *(const GAS f32x4*)(W + (size_t)(k0 + kk) * N + n0 + n4); if (gain) v = v * gain[k0 + kk];
        LAS float* d = scr + kk * 33 + n4; d[0] = v.x; d[1] = v.y; d[2] = v.z; d[3] = v.w; }
    LDS_WAIT(); asm volatile("" ::: "memory");
    const int c = lane & 7;
#pragma unroll
    for (int j = 0; j < 4; ++j) { const int n = (lane >> 3) + 8 * j; const LAS float* s = scr + (8 * c) * 33 + n;
        v4u o; o.x = pg8::cvt_pk_bf16(s[0 * 33], s[1 * 33]); o.y = pg8::cvt_pk_bf16(s[2 * 33], s[3 * 33]); o.z = pg8::cvt_pk_bf16(s[4 * 33], s[5 * 33]); o.w = pg8::cvt_pk_bf16(s[6 * 33], s[7 * 33]);
        const int ns = n0 + n; const int dr = gu ? ((ns >> 7) * 256 + (gu - 1) * 128 + (ns & 127)) : ns;
        *(GAS v4u*)(WT + (size_t)dr * K + k0 + 8 * c) = o; }
    LDS_WAIT(); asm volatile("" ::: "memory");
}

constexpr int CONV_I_GU = (D / 64) * (DFF / 32), CONV_I_DN = (DFF / 64) * (D / 32), CONV_I_IN = (D / 64) * (DIN / 32), CONV_I_OUT = (D / 64) * (D / 32);
constexpr int CONV_PER_LAYER = 2 * (2 * CONV_I_GU + CONV_I_DN) + CONV_I_IN + CONV_I_OUT;
struct ConvItem { const float* W; bf16* WT; const float* gain; int K, N, gu, item; };
template <class ArgsT> __device__ __forceinline__ ConvItem conv_decode(const ArgsT& args, unsigned char* ws, int L, int r) {
    ConvItem c; c.gain = nullptr; c.K = D; c.N = DFF; c.gu = 0;
    const size_t oGU = (size_t)L * D * DFF;
    if (r < CONV_I_GU) { c.W = (const float*)args.in[I_F1G] + oGU; c.WT = (bf16*)(ws + WS_WGU + (size_t)(2 * L) * SZ_WGU); c.gu = 1; c.gain = (const float*)args.in[I_F1N] + (size_t)L * D; }
    else if ((r -= CONV_I_GU) < CONV_I_GU) { c.W = (const float*)args.in[I_F1U] + oGU; c.WT = (bf16*)(ws + WS_WGU + (size_t)(2 * L) * SZ_WGU); c.gu = 2; c.gain = (const float*)args.in[I_F1N] + (size_t)L * D; }
    else if ((r -= CONV_I_GU) < CONV_I_DN) { c.W = (const float*)args.in[I_F1D] + oGU; c.WT = (bf16*)(ws + WS_WD + (size_t)(2 * L) * SZ_WD); c.K = DFF; c.N = D; }
    else if ((r -= CONV_I_DN) < CONV_I_GU) { c.W = (const float*)args.in[I_F2G] + oGU; c.WT = (bf16*)(ws + WS_WGU + (size_t)(2 * L + 1) * SZ_WGU); c.gu = 1; c.gain = (const float*)args.in[I_F2N] + (size_t)L * D; }
    else if ((r -= CONV_I_GU) < CONV_I_GU) { c.W = (const float*)args.in[I_F2U] + oGU; c.WT = (bf16*)(ws + WS_WGU + (size_t)(2 * L + 1) * SZ_WGU); c.gu = 2; c.gain = (const float*)args.in[I_F2N] + (size_t)L * D; }
    else if ((r -= CONV_I_GU) < CONV_I_DN) { c.W = (const float*)args.in[I_F2D] + oGU; c.WT = (bf16*)(ws + WS_WD + (size_t)(2 * L + 1) * SZ_WD); c.K = DFF; c.N = D; }
    else if ((r -= CONV_I_DN) < CONV_I_IN) { c.W = (const float*)args.in[I_WIN] + (size_t)L * D * DIN; c.WT = (bf16*)(ws + WS_WIN + (size_t)L * SZ_WIN); c.N = DIN; c.gain = (const float*)args.in[I_MIXN] + (size_t)L * D; }
    else { r -= CONV_I_IN; c.W = (const float*)args.in[I_WOUT] + (size_t)L * D * D; c.WT = (bf16*)(ws + WS_WOUT + (size_t)L * SZ_WOUT); c.N = D; }
    c.item = r; return c;
}
constexpr int CONV_JIT_C = CONV_PER_LAYER / 2, CONV_JIT_P0 = DEPTH * CONV_PER_LAYER - (2 * DEPTH - 1) * CONV_JIT_C - CONV_I_DN;
template <class ArgsT> __device__ __forceinline__ ConvItem conv_decode_need(const ArgsT& args, unsigned char* ws, int q) {
    const int L = q / CONV_PER_LAYER; int s = q % CONV_PER_LAYER, r;
    constexpr int A0 = 2 * CONV_I_GU, A1 = A0 + CONV_I_DN, A2 = A1 + CONV_I_IN, A3 = A2 + CONV_I_OUT, A4 = A3 + 2 * CONV_I_GU;
    if (s < A1) r = s;
    else if (s < A2) r = 2 * (2 * CONV_I_GU + CONV_I_DN) + (s - A1);
    else if (s < A3) r = 2 * (2 * CONV_I_GU + CONV_I_DN) + CONV_I_IN + (s - A2);
    else if (s < A4) r = (2 * CONV_I_GU + CONV_I_DN) + (s - A3);
    else r = (2 * CONV_I_GU + CONV_I_DN) + 2 * CONV_I_GU + (s - A4);
    return conv_decode(args, ws, L, r);
}
__device__ __forceinline__ void conv_load(const ConvItem& c, f32x4 (&v)[8], float (&gv)[8], int lane) {
    const int nblk = c.N / 32, kb = c.item / nblk, nb = c.item % nblk, k0 = 64 * kb, n0 = 32 * nb;
#pragma unroll
    for (int i = 0; i < 8; ++i) { const int kk = 8 * i + (lane >> 3), n4 = (lane & 7) * 4;
        v[i] = *(const GAS f32x4*)(c.W + (size_t)(k0 + kk) * c.N + n0 + n4); gv[i] = c.gain ? c.gain[k0 + kk] : 1.0f; }
}
__device__ __forceinline__ void conv_finish(const ConvItem& c, const f32x4 (&v)[8], const float (&gv)[8], LAS float* scr, int lane) {
    const int nblk = c.N / 32, kb = c.item / nblk, nb = c.item % nblk, k0 = 64 * kb, n0 = 32 * nb;
#pragma unroll
    for (int i = 0; i < 8; ++i) { const int kk = 8 * i + (lane >> 3), n4 = (lane & 7) * 4; const f32x4 x = v[i] * gv[i];
        LAS float* d = scr + kk * 33 + n4; d[0] = x.x; d[1] = x.y; d[2] = x.z; d[3] = x.w; }
    LDS_WAIT(); asm volatile("" ::: "memory");
    const int cc = lane & 7;
#pragma unroll
    for (int j = 0; j < 4; ++j) { const int n = (lane >> 3) + 8 * j; const LAS float* s = scr + (8 * cc) * 33 + n;
        v4u o; o.x = pg8::cvt_pk_bf16(s[0 * 33], s[1 * 33]); o.y = pg8::cvt_pk_bf16(s[2 * 33], s[3 * 33]); o.z = pg8::cvt_pk_bf16(s[4 * 33], s[5 * 33]); o.w = pg8::cvt_pk_bf16(s[6 * 33], s[7 * 33]);
#if W_DROP_BITS > 0
        { constexpr unsigned C_ = (1u << (W_DROP_BITS - 1)) * 0x00010001u, M_ = ~(((1u << W_DROP_BITS) - 1u) * 0x00010001u); o.x = (o.x + C_) & M_; o.y = (o.y + C_) & M_; o.z = (o.z + C_) & M_; o.w = (o.w + C_) & M_; }
#endif
        const int ns = n0 + n; const int dr = c.gu ? ((ns >> 7) * 256 + (c.gu - 1) * 128 + (ns & 127)) : (EPI_WIDE ? ((ns & ~255) + ((ns >> 5) & 1) * 128 + ((ns >> 6) & 3) * 32 + (ns & 31)) : ns);
        *(GAS v4u*)(c.WT + (size_t)dr * c.K + k0 + 8 * cc) = o; }
    LDS_WAIT(); asm volatile("" ::: "memory");
}
template <bool NEED = false, class ArgsT> __device__ __forceinline__ void convert_items(const ArgsT& args, unsigned char* ws, int nl_per, int r, int r_end, int stride, int Lbase, LAS float* scr, int lane) {
    for (; r < r_end; r += 4 * stride) {
        ConvItem c0 = (NEED ? conv_decode_need(args, ws, r) : conv_decode(args, ws, Lbase + r / nl_per, r % nl_per)), c1 = c0, c2 = c0, c3 = c0;
        const bool h1 = r + stride < r_end, h2 = r + 2 * stride < r_end, h3 = r + 3 * stride < r_end;
        if (h1) c1 = (NEED ? conv_decode_need(args, ws, r + stride) : conv_decode(args, ws, Lbase + (r + stride) / nl_per, (r + stride) % nl_per));
        if (h2) c2 = (NEED ? conv_decode_need(args, ws, r + 2 * stride) : conv_decode(args, ws, Lbase + (r + 2 * stride) / nl_per, (r + 2 * stride) % nl_per));
        if (h3) c3 = (NEED ? conv_decode_need(args, ws, r + 3 * stride) : conv_decode(args, ws, Lbase + (r + 3 * stride) / nl_per, (r + 3 * stride) % nl_per));
        f32x4 v0[8], v1[8], v2[8], v3[8]; float g0[8], g1[8], g2[8], g3[8];
        conv_load(c0, v0, g0, lane); conv_load(c1, v1, g1, lane); conv_load(c2, v2, g2, lane); conv_load(c3, v3, g3, lane);
        conv_finish(c0, v0, g0, scr, lane);
        if (h1) conv_finish(c1, v1, g1, scr, lane);
        if (h2) conv_finish(c2, v2, g2, scr, lane);
        if (h3) conv_finish(c3, v3, g3, scr, lane);
    }
}

__device__ __forceinline__ void xcopy_phase(const float* x, bf16* XB, unsigned* rowsq, int gw, int NGW, int lane) {
    for (int m = gw; m < M; m += NGW) {
        const GAS f32x4* xr = (const GAS f32x4*)(x + (size_t)m * D) + lane;
        f32x4 v[8]; float s = 0.f;
#pragma unroll
        for (int j = 0; j < 8; ++j) { v[j] = xr[64 * j]; s += (v[j].x * v[j].x + v[j].y * v[j].y) + (v[j].z * v[j].z + v[j].w * v[j].w); }
        s = wave_sum(s);
        GAS v2u* o8 = (GAS v2u*)(XB + (size_t)m * D) + lane;
#pragma unroll
        for (int j = 0; j < 8; ++j) { v2u w; w.x = pg8::cvt_pk_bf16(v[j].x, v[j].y); w.y = pg8::cvt_pk_bf16(v[j].z, v[j].w); o8[64 * j] = w; }
        if (lane == 0) rowsq[m] = (unsigned)(s * pg8::RSQ_SCALE);
    }
}

__device__ __forceinline__ void prep_phase(bf16* P, const float* cosT, const float* sinT, const float* qg, const float* kg, int gw, int NGW, int lane) {
    const int grp = lane >> 2, sub = lane & 3;
    float ga1[8], ga2[8];
    { const float* gp = (grp < 8 ? qg : kg);
#pragma unroll
      for (int e = 0; e < 8; ++e) { ga1[e] = gp[sub * 8 + e]; ga2[e] = gp[32 + sub * 8 + e]; } }
    for (int m = gw; m < M; m += NGW) {
        bf16* row = P + (size_t)m * DIN;
        bf16* p1 = row + C_DAQ + grp * 64 + sub * 8; bf16* p2 = p1 + 32;
        const v4u a = *(const GAS v4u*)p1, b = *(const GAS v4u*)p2;
        const GAS f32x4* cp = (const GAS f32x4*)(cosT + (size_t)m * 32 + sub * 8); const GAS f32x4* sp = (const GAS f32x4*)(sinT + (size_t)m * 32 + sub * 8);
        const f32x4 cA = cp[0], cB = cp[1], sA = sp[0], sB = sp[1];
        float x1[8], x2[8]; unpack8(a, x1); unpack8(b, x2);
        float ss = 0.f;
#pragma unroll
        for (int e = 0; e < 8; ++e) ss += x1[e] * x1[e] + x2[e] * x2[e];
        ss += __shfl_xor(ss, 1); ss += __shfl_xor(ss, 2);
        const float rstd = 1.0f / sqrtf(ss * (1.0f / 64.0f) + EPS);
        const float cs[8] = {cA.x, cA.y, cA.z, cA.w, cB.x, cB.y, cB.z, cB.w}, sn[8] = {sA.x, sA.y, sA.z, sA.w, sB.x, sB.y, sB.z, sB.w};
        float o1[8], o2[8];
#pragma unroll
        for (int e = 0; e < 8; ++e) { const float y1 = x1[e] * rstd * ga1[e], y2 = x2[e] * rstd * ga2[e]; o1[e] = y1 * cs[e] - y2 * sn[e]; o2[e] = y2 * cs[e] + y1 * sn[e]; }
        *(GAS v4u*)p1 = pack8(o1); *(GAS v4u*)p2 = pack8(o2);
    }
}

__device__ __forceinline__ void combine_phase(const bf16* P, const bf16* OA, bf16* Y, const float* hgn, const float* daon, const float* lq1, const float* lk1, const float* lq2, const float* lk2, float lam_init,
                                              const float* cw, const float* cb, const float* cn, int gw, int NGW, int lane, int m0 = 0, int m1 = M) {
    const float d1 = wave_sum(lq1[lane] * lk1[lane]), d2 = wave_sum(lq2[lane] * lk2[lane]);
    const float lam = expf(d1) - expf(d2) + lam_init;
    const int ca = lane * 16, c8 = lane * 8;
    const int head = lane >> 4, v0 = (lane & 15) * 8;
    float ga[16], gb[8], w0[8], w1[8], w2[8], bb[8], gn[8];
#pragma unroll
    for (int e = 0; e < 16; ++e) ga[e] = hgn[ca + e];
#pragma unroll
    for (int e = 0; e < 8; ++e) { gb[e] = daon[c8 + e] * (1.0f - lam_init); w0[e] = cw[c8 + e]; w1[e] = cw[512 + c8 + e]; w2[e] = cw[1024 + c8 + e]; bb[e] = cb[c8 + e]; gn[e] = cn[c8 + e]; }
    for (int m = m0 + gw; m < m1; m += NGW) {
        const int s = m & (SEQ - 1);
        const bf16* row = P + (size_t)m * DIN;
        const bf16* rowp = (s > 0) ? row - DIN : row; const bf16* rown = (s < SEQ - 1) ? row + DIN : row;
        const float fp = (s > 0) ? 1.f : 0.f, fn = (s < SEQ - 1) ? 1.f : 0.f;
        const bf16* f0 = row + C_HGZF + ca; const bf16* f1 = row + C_HGZB + ca; const bf16* gp = row + C_HGG + ca;
        const bf16* ap = OA + (size_t)m * 1024 + head * 256 + v0;
        const v4u L0 = *(const GAS v4u*)f0, L1 = *(const GAS v4u*)(f0 + 8), L2 = *(const GAS v4u*)f1, L3 = *(const GAS v4u*)(f1 + 8), L4 = *(const GAS v4u*)gp, L5 = *(const GAS v4u*)(gp + 8);
        const v4u L6 = *(const GAS v4u*)ap, L7 = *(const GAS v4u*)(ap + 128);
        const v4u L8 = *(const GAS v4u*)(row + C_SCC + c8), L9 = *(const GAS v4u*)(row + C_SCU + c8), L10 = *(const GAS v4u*)(rowp + C_SCC + c8), L11 = *(const GAS v4u*)(rowp + C_SCU + c8);
        const v4u L12 = *(const GAS v4u*)(rown + C_SCC + c8), L13 = *(const GAS v4u*)(rown + C_SCU + c8), L14 = *(const GAS v4u*)(row + C_SCB + c8);
        {
            float a[16], b[16], g[16]; float t[8];
            unpack8(L0, t);
#pragma unroll
            for (int e = 0; e < 8; ++e) a[e] = t[e];
            unpack8(L1, t);
#pragma unroll
            for (int e = 0; e < 8; ++e) a[8 + e] = t[e];
            unpack8(L2, t);
#pragma unroll
            for (int e = 0; e < 8; ++e) b[e] = t[e];
            unpack8(L3, t);
#pragma unroll
            for (int e = 0; e < 8; ++e) b[8 + e] = t[e];
            unpack8(L4, t);
#pragma unroll
            for (int e = 0; e < 8; ++e) g[e] = t[e];
            unpack8(L5, t);
#pragma unroll
            for (int e = 0; e < 8; ++e) g[8 + e] = t[e];
            float ss = 0.f;
#pragma unroll
            for (int e = 0; e < 16; ++e) { a[e] += b[e]; ss += a[e] * a[e]; }
            ss += __shfl_xor(ss, 1); ss += __shfl_xor(ss, 2); ss += __shfl_xor(ss, 4);
            const float rstd = 1.0f / sqrtf(ss * (1.0f / 128.0f) + EPS);
            float o0[8], o1[8];
#pragma unroll
            for (int e = 0; e < 8; ++e) { const float g0 = g[e], g1 = g[8 + e];
                o0[e] = a[e] * rstd * ga[e] * (g0 * __builtin_amdgcn_rcpf(1.0f + __expf(-g0))); o1[e] = a[8 + e] * rstd * ga[8 + e] * (g1 * __builtin_amdgcn_rcpf(1.0f + __expf(-g1))); }
            GAS v4u* yp = (GAS v4u*)(Y + (size_t)m * D + ca); yp[0] = pack8(o0); yp[1] = pack8(o1);
        }
        {
            float a0[8], a1[8]; unpack8(L6, a0); unpack8(L7, a1);
            float ss = 0.f;
#pragma unroll
            for (int e = 0; e < 8; ++e) { a0[e] = a0[e] - lam * a1[e]; ss += a0[e] * a0[e]; }
            ss += __shfl_xor(ss, 1); ss += __shfl_xor(ss, 2); ss += __shfl_xor(ss, 4); ss += __shfl_xor(ss, 8);
            const float rstd = 1.0f / sqrtf(ss * (1.0f / 128.0f) + EPS);
#pragma unroll
            for (int e = 0; e < 8; ++e) a0[e] = a0[e] * rstd * gb[e];
            *(GAS v4u*)(Y + (size_t)m * D + 1024 + c8) = pack8(a0);
        }
        {
            float cc[8], uc[8], cpv[8], upv[8], cnx[8], unx[8], bg[8];
            unpack8(L8, cc); unpack8(L9, uc); unpack8(L10, cpv); unpack8(L11, upv); unpack8(L12, cnx); unpack8(L13, unx); unpack8(L14, bg);
            float y[8]; float ss = 0.f;
#pragma unroll
            for (int e = 0; e < 8; ++e) { y[e] = (bb[e] + w0[e] * (cpv[e] * upv[e] * fp) + w1[e] * (cc[e] * uc[e]) + w2[e] * (cnx[e] * unx[e] * fn)) * bg[e]; ss += y[e] * y[e]; }
            ss += __shfl_xor(ss, 1); ss += __shfl_xor(ss, 2); ss += __shfl_xor(ss, 4); ss += __shfl_xor(ss, 8);
            const float rstd = 1.0f / sqrtf(ss * (1.0f / 128.0f) + EPS);
#pragma unroll
            for (int e = 0; e < 8; ++e) y[e] = y[e] * rstd * gn[e];
            *(GAS v4u*)(Y + (size_t)m * D + 1536 + c8) = pack8(y);
        }
    }
}

__device__ __forceinline__ void scan_unit_v1(const bf16* P, const float* lbt, bf16* OFd, int b, int h, int dir, LAS unsigned char* ldsb, int tid) {
    LAS float* Fs = (LAS float*)ldsb; LAS float* Ks = Fs + 4096; LAS float* Qs = Ks + 4096; LAS float* Vs = Qs + 4096; LAS float* Os = Vs + 4096;
    const int lane = tid & 63, wv = tid >> 6, v = wv * 16 + (lane & 15), kq = lane >> 4;
    const int tok = tid >> 4, ch0 = (tid & 15) * 8;
    float lbv[8];
#pragma unroll
    for (int e = 0; e < 8; ++e) lbv[e] = lbt[h * 128 + ch0 + e];
    float S[32];
#pragma unroll
    for (int j = 0; j < 32; ++j) S[j] = 0.f;
    const int zc = (dir ? C_HGZB : C_HGZF) + h * 128 + ch0;
    for (int blk = 0; blk < SEQ / 32; ++blk) {
        const int tau = blk * 32 + tok, s = dir ? (SEQ - 1 - tau) : tau; const size_t m = (size_t)b * SEQ + s;
        const bf16* row = P + m * DIN;
        { float q[8], iv[8], z[8], f[8], kk[8];
          unpack8(*(const GAS v4u*)(row + C_HGQ + h * 128 + ch0), q); unpack8(*(const GAS v4u*)(row + C_HGI + h * 128 + ch0), iv); unpack8(*(const GAS v4u*)(row + zc), z);
#pragma unroll
          for (int e = 0; e < 8; ++e) { const float ex = __expf(-z[e]); const float sg = 1.0f / (1.0f + ex); const float om = 1.0f - lbv[e]; f[e] = lbv[e] + om * sg; kk[e] = om * (ex * sg); }
          LAS f32x4* d;
          d = (LAS f32x4*)(Fs + tok * 128 + ch0); d[0] = (f32x4){f[0], f[1], f[2], f[3]}; d[1] = (f32x4){f[4], f[5], f[6], f[7]};
          d = (LAS f32x4*)(Ks + tok * 128 + ch0); d[0] = (f32x4){kk[0], kk[1], kk[2], kk[3]}; d[1] = (f32x4){kk[4], kk[5], kk[6], kk[7]};
          d = (LAS f32x4*)(Qs + tok * 128 + ch0); d[0] = (f32x4){q[0], q[1], q[2], q[3]}; d[1] = (f32x4){q[4], q[5], q[6], q[7]};
          d = (LAS f32x4*)(Vs + tok * 128 + ch0); d[0] = (f32x4){iv[0], iv[1], iv[2], iv[3]}; d[1] = (f32x4){iv[4], iv[5], iv[6], iv[7]}; }
        __syncthreads();
#pragma unroll 1
        for (int t = 0; t < 32; ++t) {
            const float vv = Vs[t * 128 + v]; float acc = 0.f;
            const LAS f32x4* fp = (const LAS f32x4*)(Fs + t * 128 + kq * 32); const LAS f32x4* kp = (const LAS f32x4*)(Ks + t * 128 + kq * 32); const LAS f32x4* qp = (const LAS f32x4*)(Qs + t * 128 + kq * 32);
#pragma unroll
            for (int j4 = 0; j4 < 8; ++j4) { const f32x4 f4 = fp[j4], k4 = kp[j4], q4 = qp[j4];
                S[4 * j4 + 0] = f4.x * S[4 * j4 + 0] + k4.x * vv; acc += S[4 * j4 + 0] * q4.x;
                S[4 * j4 + 1] = f4.y * S[4 * j4 + 1] + k4.y * vv; acc += S[4 * j4 + 1] * q4.y;
                S[4 * j4 + 2] = f4.z * S[4 * j4 + 2] + k4.z * vv; acc += S[4 * j4 + 2] * q4.z;
                S[4 * j4 + 3] = f4.w * S[4 * j4 + 3] + k4.w * vv; acc += S[4 * j4 + 3] * q4.w; }
            acc += __shfl_xor(acc, 16); acc += __shfl_xor(acc, 32);
            if (kq == 0) Os[t * 128 + v] = acc;
        }
        __syncthreads();
        { const LAS f32x4* op = (const LAS f32x4*)(Os + tok * 128 + ch0); const f32x4 oA = op[0], oB = op[1];
          const float o8[8] = {oA.x, oA.y, oA.z, oA.w, oB.x, oB.y, oB.z, oB.w};
          *(GAS v4u*)(OFd + m * 1024 + h * 128 + ch0) = pack8(o8); }
    }
    __syncthreads();
}


namespace sc2 {
typedef short bf16x8 __attribute__((ext_vector_type(8)));
typedef float f32x4 __attribute__((ext_vector_type(4)));
typedef float f32x2 __attribute__((ext_vector_type(2)));
typedef unsigned u32x2 __attribute__((ext_vector_type(2)));
typedef unsigned u32x4 __attribute__((ext_vector_type(4)));
constexpr int CH = 32;
constexpr int RS_RAW = 256;
constexpr int O_RZ = 0, O_RQ = 8192, O_RV = 16384, O_TOT = 24576;
constexpr int RS_QI = 272;
constexpr int O_QI = 28672, O_KI = O_QI + 32 * RS_QI;
constexpr int RS_T = 80;
constexpr int O_KHT = O_KI + 32 * RS_QI, O_VT = O_KHT + 128 * RS_T;
constexpr int O_DK = O_VT + 128 * RS_T;
constexpr int RS_OB = 528;
constexpr int O_OB = O_DK + 512;
constexpr int LDS_END = O_OB + 32 * RS_OB;
static_assert(LDS_END <= 131072 && O_QI % 16 == 0 && O_KHT % 16 == 0 && O_DK % 16 == 0 && O_OB % 16 == 0, "scan LDS map");
typedef __bf16 bf16v2 __attribute__((ext_vector_type(2)));
__device__ __forceinline__ unsigned pk(float lo, float hi) { const f32x2 v = {lo, hi}; return __builtin_bit_cast(unsigned, __builtin_convertvector(v, bf16v2)); }
__device__ __forceinline__ bf16x8 mk8(u32x2 a, u32x2 b) { u32x4 w = {a.x, a.y, b.x, b.y}; return __builtin_bit_cast(bf16x8, w); }
#define SC2_MFMA(a, b, c) __builtin_amdgcn_mfma_f32_16x16x32_bf16((a), (b), (c), 0, 0, 0)

__device__ __forceinline__ void scan_unit(unsigned short* P, const float* lbt, int b, int h, int dir, LAS unsigned char* L, int tid_in) {
    int tid = tid_in; asm volatile("" : "+v"(tid));
    const int lane = tid & 63, w = __builtin_amdgcn_readfirstlane(tid >> 6), c16 = lane & 15, g = lane >> 4;
    const int tok = tid >> 4, ch0 = (tid & 15) * 8;
    const int kp = lane;
    const float lb0 = lbt[h * 128 + 2 * kp], lb1 = lbt[h * 128 + 2 * kp + 1];
    const float om0 = 1.0f - lb0, om1 = 1.0f - lb1;
    const int zc = (dir ? C_HGZB : C_HGZF) + h * 128 + ch0;
    f32x4 S[8];
#pragma unroll
    for (int i = 0; i < 8; ++i) S[i] = (f32x4){0.f, 0.f, 0.f, 0.f};
    v4u rq, rz, rv;
    { const int s = dir ? (SEQ - 1 - tok) : tok; const unsigned short* row = P + ((size_t)b * SEQ + s) * DIN;
      rq = *(const GAS v4u*)(row + C_HGQ + h * 128 + ch0); rv = *(const GAS v4u*)(row + C_HGI + h * 128 + ch0); rz = *(const GAS v4u*)(row + zc); }
    *(LAS v4u*)(L + O_RQ + tok * RS_RAW + ch0 * 2) = rq; *(LAS v4u*)(L + O_RV + tok * RS_RAW + ch0 * 2) = rv; *(LAS v4u*)(L + O_RZ + tok * RS_RAW + ch0 * 2) = rz;
    __syncthreads();
#pragma unroll 1
    for (int c = 0; c < SEQ / CH; ++c) {
        if (c > 0) { const int tau = (c - 1) * CH + tok, s = dir ? (SEQ - 1 - tau) : tau;
            const LAS f32x4* op = (const LAS f32x4*)(L + O_OB + tok * RS_OB + ch0 * 4); const f32x4 oA = op[0], oB = op[1];
            v4u o; o.x = pk(oA.x, oA.y); o.y = pk(oA.z, oA.w); o.z = pk(oB.x, oB.y); o.w = pk(oB.z, oB.w);
            *(GAS v4u*)(P + ((size_t)b * SEQ + s) * DIN + zc) = o; }
        if (c + 1 < SEQ / CH) { const int tau = (c + 1) * CH + tok, s = dir ? (SEQ - 1 - tau) : tau; const unsigned short* row = P + ((size_t)b * SEQ + s) * DIN;
            rq = *(const GAS v4u*)(row + C_HGQ + h * 128 + ch0); rv = *(const GAS v4u*)(row + C_HGI + h * 128 + ch0); rz = *(const GAS v4u*)(row + zc); }
        float c0[4], c1[4], kk0[4], kk1[4];
        { float a0 = 0.f, a1 = 0.f;
#pragma unroll
          for (int i = 0; i < 4; ++i) { const unsigned zw = *(const LAS unsigned*)(L + O_RZ + (4 * w + i) * RS_RAW + kp * 4);
              const float z0 = fminf(fmaxf(bflo(zw), -30.f), 30.f), z1 = fminf(fmaxf(bfhi(zw), -30.f), 30.f);
              const float e0 = __expf(-z0), e1 = __expf(-z1); const float s0 = __builtin_amdgcn_rcpf(1.0f + e0), s1 = __builtin_amdgcn_rcpf(1.0f + e1);
              const float f0 = lb0 + om0 * s0, f1 = lb1 + om1 * s1; kk0[i] = om0 * (e0 * s0); kk1[i] = om1 * (e1 * s1);
              a0 += __logf(f0); a1 += __logf(f1); c0[i] = a0; c1[i] = a1; }
          *(LAS f32x2*)(L + O_TOT + (w * 128 + 2 * kp) * 4) = (f32x2){a0, a1}; }
        __syncthreads();
        { float off0 = 0.f, off1 = 0.f, end0 = 0.f, end1 = 0.f;
#pragma unroll
          for (int ww = 0; ww < 8; ++ww) { const f32x2 t = *(const LAS f32x2*)(L + O_TOT + (ww * 128 + 2 * kp) * 4); end0 += t.x; end1 += t.y; if (ww < w) { off0 += t.x; off1 += t.y; } }
          float kh0[4], kh1[4]; unsigned vw[4];
#pragma unroll
          for (int i = 0; i < 4; ++i) { const int tau = 4 * w + i;
              const unsigned qw = *(const LAS unsigned*)(L + O_RQ + tau * RS_RAW + kp * 4); vw[i] = *(const LAS unsigned*)(L + O_RV + tau * RS_RAW + kp * 4);
              const float cu0 = off0 + c0[i], cu1 = off1 + c1[i];
              const float eq0 = __expf(cu0), eq1 = __expf(cu1), ek0 = __expf(fminf(-cu0, 60.f)), ek1 = __expf(fminf(-cu1, 60.f));
              kh0[i] = kk0[i] * __expf(end0 - cu0); kh1[i] = kk1[i] * __expf(end1 - cu1);
              *(LAS unsigned*)(L + O_QI + tau * RS_QI + kp * 4) = pk(bflo(qw) * eq0, bfhi(qw) * eq1);
              *(LAS unsigned*)(L + O_KI + tau * RS_QI + kp * 4) = pk(kk0[i] * ek0, kk1[i] * ek1); }
          *(LAS u32x2*)(L + O_KHT + (2 * kp) * RS_T + 8 * w) = (u32x2){pk(kh0[0], kh0[1]), pk(kh0[2], kh0[3])};
          *(LAS u32x2*)(L + O_KHT + (2 * kp + 1) * RS_T + 8 * w) = (u32x2){pk(kh1[0], kh1[1]), pk(kh1[2], kh1[3])};
          *(LAS u32x2*)(L + O_VT + (2 * kp) * RS_T + 8 * w) = (u32x2){(vw[0] & 0xffffu) | (vw[1] << 16), (vw[2] & 0xffffu) | (vw[3] << 16)};
          *(LAS u32x2*)(L + O_VT + (2 * kp + 1) * RS_T + 8 * w) = (u32x2){(vw[0] >> 16) | (vw[1] & 0xffff0000u), (vw[2] >> 16) | (vw[3] & 0xffff0000u)};
          if (w == 0) *(LAS f32x2*)(L + O_DK + 2 * kp * 4) = (f32x2){__expf(end0), __expf(end1)}; }
        __syncthreads();
        { const bf16x8 vf = mk8(*(const LAS u32x2*)(L + O_VT + (16 * w + c16) * RS_T + 8 * g), *(const LAS u32x2*)(L + O_VT + (16 * w + c16) * RS_T + 32 + 8 * g));
          bf16x8 qf[2][4], kf[2][4];
#pragma unroll
          for (int tb = 0; tb < 2; ++tb)
#pragma unroll
              for (int ks = 0; ks < 4; ++ks) { const int ro = (16 * tb + c16) * RS_QI + (32 * ks + 4 * g) * 2;
                  qf[tb][ks] = mk8(*(const LAS u32x2*)(L + O_QI + ro), *(const LAS u32x2*)(L + O_QI + ro + 32));
                  kf[tb][ks] = mk8(*(const LAS u32x2*)(L + O_KI + ro), *(const LAS u32x2*)(L + O_KI + ro + 32)); }
          f32x4 p00 = {0.f, 0.f, 0.f, 0.f}, p01 = p00, p11 = p00;
#pragma unroll
          for (int ks = 0; ks < 4; ++ks) { p00 = SC2_MFMA(kf[0][ks], qf[0][ks], p00); p01 = SC2_MFMA(kf[0][ks], qf[1][ks], p01); p11 = SC2_MFMA(kf[1][ks], qf[1][ks], p11); }
#pragma unroll
          for (int r = 0; r < 4; ++r) { const bool keep = (4 * g + r) <= c16; p00[r] = keep ? p00[r] : 0.f; p11[r] = keep ? p11[r] : 0.f; }
          const bf16x8 pa0 = mk8((u32x2){pk(p00[0], p00[1]), pk(p00[2], p00[3])}, (u32x2){0u, 0u});
          const bf16x8 pa1 = mk8((u32x2){pk(p01[0], p01[1]), pk(p01[2], p01[3])}, (u32x2){pk(p11[0], p11[1]), pk(p11[2], p11[3])});
          f32x4 o0 = {0.f, 0.f, 0.f, 0.f}, o1 = o0;
          o0 = SC2_MFMA(pa0, vf, o0); o1 = SC2_MFMA(pa1, vf, o1);
#pragma unroll
          for (int ks = 0; ks < 4; ++ks) { const bf16x8 sf = mk8((u32x2){pk(S[2 * ks][0], S[2 * ks][1]), pk(S[2 * ks][2], S[2 * ks][3])}, (u32x2){pk(S[2 * ks + 1][0], S[2 * ks + 1][1]), pk(S[2 * ks + 1][2], S[2 * ks + 1][3])});
              o0 = SC2_MFMA(qf[0][ks], sf, o0); o1 = SC2_MFMA(qf[1][ks], sf, o1); }
#pragma unroll
          for (int kb = 0; kb < 8; ++kb) { const int ro = (16 * kb + c16) * RS_T + 8 * g;
              const bf16x8 hf = mk8(*(const LAS u32x2*)(L + O_KHT + ro), *(const LAS u32x2*)(L + O_KHT + ro + 32));
              const f32x4 dv = *(const LAS f32x4*)(L + O_DK + (16 * kb + 4 * g) * 4);
              S[kb] = S[kb] * dv; S[kb] = SC2_MFMA(hf, vf, S[kb]); }
#pragma unroll
          for (int r = 0; r < 4; ++r) { *(LAS float*)(L + O_OB + (4 * g + r) * RS_OB + (16 * w + c16) * 4) = o0[r]; *(LAS float*)(L + O_OB + (16 + 4 * g + r) * RS_OB + (16 * w + c16) * 4) = o1[r]; } }
        if (c + 1 < SEQ / CH) { *(LAS v4u*)(L + O_RQ + tok * RS_RAW + ch0 * 2) = rq; *(LAS v4u*)(L + O_RV + tok * RS_RAW + ch0 * 2) = rv; *(LAS v4u*)(L + O_RZ + tok * RS_RAW + ch0 * 2) = rz; }
        __syncthreads();
    }
    { const int tau = (SEQ / CH - 1) * CH + tok, s = dir ? (SEQ - 1 - tau) : tau;
      const LAS f32x4* op = (const LAS f32x4*)(L + O_OB + tok * RS_OB + ch0 * 4); const f32x4 oA = op[0], oB = op[1];
      v4u o; o.x = pk(oA.x, oA.y); o.y = pk(oA.z, oA.w); o.z = pk(oB.x, oB.y); o.w = pk(oB.z, oB.w);
      *(GAS v4u*)(P + ((size_t)b * SEQ + s) * DIN + zc) = o; }
    __syncthreads();
}
#undef SC2_MFMA
}


#ifndef SCAN_XPRIO
#define SCAN_XPRIO 0
#endif
namespace sc3 {
using sc2::bf16x8; using sc2::f32x4; using sc2::f32x2; using sc2::u32x2; using sc2::u32x4; using sc2::pk; using sc2::mk8;
constexpr int CH = 32, NCH = SEQ / CH;
constexpr int RS_RAW = 256, RAW_BYTES = 3 * 8192;
constexpr int RS_QI = 272, RS_T = 80, RS_OB = 272;
constexpr int IMG_QI = 0, IMG_KI = 32 * RS_QI, IMG_KHT = 2 * 32 * RS_QI, IMG_VT = IMG_KHT + 128 * RS_T, IMG_DK = IMG_VT + 128 * RS_T, IMG_BYTES = IMG_DK + 512;
constexpr int O_RAW = 0, O_IMG = 2 * RAW_BYTES, O_OB = O_IMG + 2 * IMG_BYTES, OB_BYTES = 32 * RS_OB, LDS_END = O_OB + 2 * OB_BYTES;
static_assert(LDS_END <= LDSCTL_OFF, "scan v3 LDS map");
static_assert(IMG_BYTES % 16 == 0 && O_IMG % 16 == 0 && O_OB % 16 == 0, "alignment");
#define SC3_MFMA(a, b, c) __builtin_amdgcn_mfma_f32_16x16x32_bf16((a), (b), (c), 0, 0, 0)

template <int PROBE_OUT = 0> __device__ __forceinline__ void scan_unit(unsigned short* P, const float* lbt, int b, int h, int dir, LAS unsigned char* L, int tid_in, unsigned short* Yp = nullptr) {
    int tid = tid_in; asm volatile("" : "+v"(tid));
    const int lane = tid & 63, w = __builtin_amdgcn_readfirstlane(tid >> 6);
    const int zcol = (dir ? C_HGZB : C_HGZF) + h * 128, qcol = C_HGQ + h * 128, vcol = C_HGI + h * 128;
    const int xt = tid & 255;
    const int k = 32 * (w & 3) + (lane & 31), hf = lane >> 5;
    const int kp_ = (k & ~31) + 8 * ((k >> 2) & 3) + 4 * ((k >> 4) & 1) + (k & 3);
    float lb = 0.f, om = 1.f;
    const int c16 = lane & 15, g = lane >> 4, wy = w & 3;
    f32x4 S[2][8];
#pragma unroll
    for (int sl = 0; sl < 2; ++sl)
#pragma unroll
        for (int i = 0; i < 8; ++i) S[sl][i] = (f32x4){0.f, 0.f, 0.f, 0.f};
    if (w < 4) { lb = lbt[h * 128 + k]; om = 1.0f - lb; }
#if SCAN_XPRIO
    if (w < 4) __builtin_amdgcn_s_setprio(SCAN_XPRIO);
#endif

#define SC3_ROW(cidx, tau) (P + ((size_t)b * SEQ + (dir ? (SEQ - 1 - ((cidx) * CH + (tau))) : ((cidx) * CH + (tau)))) * DIN)
#define SC3_DMA(cidx, par) do { const unsigned short* r0_ = SC3_ROW(cidx, xt >> 4); const unsigned short* r1_ = SC3_ROW(cidx, 16 + (xt >> 4)); const int co_ = (xt & 15) * 8; \
        LAS unsigned char* rb_ = L + O_RAW + (par) * RAW_BYTES + w * 1024; \
        __builtin_amdgcn_global_load_lds((const unsigned*)(r0_ + zcol + co_), (LAS unsigned*)(rb_), 16, 0, 0);         __builtin_amdgcn_global_load_lds((const unsigned*)(r1_ + zcol + co_), (LAS unsigned*)(rb_ + 4096), 16, 0, 0); \
        __builtin_amdgcn_global_load_lds((const unsigned*)(r0_ + qcol + co_), (LAS unsigned*)(rb_ + 8192), 16, 0, 0);  __builtin_amdgcn_global_load_lds((const unsigned*)(r1_ + qcol + co_), (LAS unsigned*)(rb_ + 8192 + 4096), 16, 0, 0); \
        __builtin_amdgcn_global_load_lds((const unsigned*)(r0_ + vcol + co_), (LAS unsigned*)(rb_ + 16384), 16, 0, 0); __builtin_amdgcn_global_load_lds((const unsigned*)(r1_ + vcol + co_), (LAS unsigned*)(rb_ + 16384 + 4096), 16, 0, 0); } while (0)
#define SC3_DMA_WAIT() asm volatile("s_waitcnt vmcnt(0)" ::: "memory")
#define SC3_IMAGES(par) do { \
        const LAS unsigned char* rw_ = L + O_RAW + (par) * RAW_BYTES + (16 * hf) * RS_RAW + k * 2; LAS unsigned char* im_ = L + O_IMG + (par) * IMG_BYTES; \
        unsigned zr_[16], qr_[16], vr_[16];                        \
        _Pragma("unroll") for (int i = 0; i < 16; ++i) zr_[i] = *(const LAS unsigned short*)(rw_ + i * RS_RAW); \
        _Pragma("unroll") for (int i = 0; i < 16; ++i) qr_[i] = *(const LAS unsigned short*)(rw_ + 8192 + i * RS_RAW); \
        _Pragma("unroll") for (int i = 0; i < 16; ++i) vr_[i] = *(const LAS unsigned short*)(rw_ + 16384 + i * RS_RAW); \
        float cp_[16], kk_[16]; float a_ = 1.0f;                   \
        _Pragma("unroll") for (int i = 0; i < 16; ++i) { const float z_ = fminf(fmaxf(bflo(zr_[i]), -30.f), 30.f); \
            const float e_ = __expf(-z_); const float s_ = __builtin_amdgcn_rcpf(1.0f + e_); kk_[i] = om * (e_ * s_); a_ *= (lb + om * s_); cp_[i] = a_; } \
        const float oth_ = __shfl_xor(a_, 32); const float off_ = hf ? oth_ : 1.0f; const float dk_ = a_ * oth_; \
        unsigned kh_[8], vv_[8], qi_[16], ki_[16]; \
        _Pragma("unroll") for (int i = 0; i < 16; ++i) { const float eq_ = fmaxf(off_ * cp_[i], 8.7565e-27f);      \
            const float ek_ = __builtin_amdgcn_rcpf(eq_); \
            const float q_ = bflo(qr_[i]); const unsigned v_ = vr_[i]; \
            const float kt_ = kk_[i] * ek_; const float kh = kt_ * dk_; \
            qi_[i] = pk(q_ * eq_, 0.f); ki_[i] = pk(kt_, 0.f); \
            if (i & 1) { kh_[i >> 1] = pk(cp_[i - 1], kh); vv_[i >> 1] |= v_ << 16; } else { cp_[i] = kh; vv_[i >> 1] = v_; } } \
        _Pragma("unroll") for (int i = 0; i < 16; ++i) { *(LAS unsigned short*)(im_ + IMG_QI + (16 * hf + i) * RS_QI + kp_ * 2) = (unsigned short)(qi_[i] & 0xffffu); \
            *(LAS unsigned short*)(im_ + IMG_KI + (16 * hf + i) * RS_QI + kp_ * 2) = (unsigned short)(ki_[i] & 0xffffu); } \
        _Pragma("unroll") for (int gg = 0; gg < 4; ++gg) {        \
            *(LAS u32x2*)(im_ + IMG_KHT + k * RS_T + 16 * gg + 8 * hf) = (u32x2){kh_[2 * gg], kh_[2 * gg + 1]}; \
            *(LAS u32x2*)(im_ + IMG_VT + k * RS_T + 16 * gg + 8 * hf) = (u32x2){vv_[2 * gg], vv_[2 * gg + 1]}; } \
        if (hf == 0) *(LAS float*)(im_ + IMG_DK + k * 4) = dk_; } while (0)

    if (w < 4) { SC3_DMA(0, 0); if (1 < NCH) SC3_DMA(1, 1); SC3_DMA_WAIT(); }
    __syncthreads();
    if (w < 4) { SC3_IMAGES(0); }
    __syncthreads();
#pragma unroll 1
    for (int c = 0; c < NCH; ++c) {
        const int par = c & 1;
        if (w < 4) {
            if (c > 0) {
#pragma unroll
                for (int pz = 0; pz < 2; ++pz) { const int p = xt + 256 * pz, tau = p >> 4, co = (p & 15) * 8;
                    const v4u o = *(const LAS v4u*)(L + O_OB + (par ^ 1) * OB_BYTES + tau * RS_OB + co * 2);
                    if (PROBE_OUT) *(GAS v4u*)(Yp + (size_t)(SC3_ROW(c - 1, tau) - P) / DIN * D + dir * 1024 + h * 128 + co) = o; else *(GAS v4u*)(SC3_ROW(c - 1, tau) + zcol + co) = o; } }
            if (c + 2 < NCH) SC3_DMA(c + 2, par);
            if (c + 1 < NCH && PROBE_OUT != 2) SC3_IMAGES(par ^ 1);
        } else if (PROBE_OUT != 3) {
            const LAS unsigned char* im = L + O_IMG + par * IMG_BYTES;
            bf16x8 qf[2][4], kf[2][4];
#pragma unroll
            for (int tb = 0; tb < 2; ++tb)
#pragma unroll
                for (int ks = 0; ks < 4; ++ks) { const int ro = (16 * tb + c16) * RS_QI + (32 * ks + 8 * g) * 2;
                    qf[tb][ks] = __builtin_bit_cast(bf16x8, *(const LAS u32x4*)(im + IMG_QI + ro));
                    kf[tb][ks] = __builtin_bit_cast(bf16x8, *(const LAS u32x4*)(im + IMG_KI + ro)); }
            f32x4 p00 = {0.f, 0.f, 0.f, 0.f}, p01 = p00, p11 = p00;
#pragma unroll
            for (int ks = 0; ks < 4; ++ks) { p00 = SC3_MFMA(kf[0][ks], qf[0][ks], p00); p01 = SC3_MFMA(kf[0][ks], qf[1][ks], p01); p11 = SC3_MFMA(kf[1][ks], qf[1][ks], p11); }
#pragma unroll
            for (int r = 0; r < 4; ++r) { const bool keep = (4 * g + r) <= c16; p00[r] = keep ? p00[r] : 0.f; p11[r] = keep ? p11[r] : 0.f; }
            const bf16x8 pa0 = mk8((u32x2){pk(p00[0], p00[1]), pk(p00[2], p00[3])}, (u32x2){0u, 0u});
            const bf16x8 pa1 = mk8((u32x2){pk(p01[0], p01[1]), pk(p01[2], p01[3])}, (u32x2){pk(p11[0], p11[1]), pk(p11[2], p11[3])});
            bf16x8 vf[2]; f32x4 o[2][2];
#pragma unroll
            for (int sl = 0; sl < 2; ++sl) { const int vr = (32 * wy + 16 * sl + c16) * RS_T + 16 * g;
                vf[sl] = __builtin_bit_cast(bf16x8, *(const LAS u32x4*)(im + IMG_VT + vr));
                o[sl][0] = SC3_MFMA(pa0, vf[sl], ((f32x4){0.f, 0.f, 0.f, 0.f})); o[sl][1] = SC3_MFMA(pa1, vf[sl], ((f32x4){0.f, 0.f, 0.f, 0.f})); }
#pragma unroll
            for (int sl = 0; sl < 2; ++sl)
#pragma unroll
                for (int ks = 0; ks < 4; ++ks) { const bf16x8 sf = mk8((u32x2){pk(S[sl][2 * ks][0], S[sl][2 * ks][1]), pk(S[sl][2 * ks][2], S[sl][2 * ks][3])}, (u32x2){pk(S[sl][2 * ks + 1][0], S[sl][2 * ks + 1][1]), pk(S[sl][2 * ks + 1][2], S[sl][2 * ks + 1][3])});
                    o[sl][0] = SC3_MFMA(qf[0][ks], sf, o[sl][0]); o[sl][1] = SC3_MFMA(qf[1][ks], sf, o[sl][1]); }
#pragma unroll
            for (int kb = 0; kb < 8; ++kb) { const int ro = (16 * kb + c16) * RS_T + 16 * g;
                const bf16x8 hfr = __builtin_bit_cast(bf16x8, *(const LAS u32x4*)(im + IMG_KHT + ro));
                const f32x4 dv = *(const LAS f32x4*)(im + IMG_DK + (16 * kb + 4 * g) * 4);
#pragma unroll
                for (int sl = 0; sl < 2; ++sl) { S[sl][kb] = S[sl][kb] * dv; S[sl][kb] = SC3_MFMA(hfr, vf[sl], S[sl][kb]); } }
            LAS unsigned char* ob = L + O_OB + par * OB_BYTES;
#pragma unroll
            for (int sl = 0; sl < 2; ++sl)
#pragma unroll
                for (int r = 0; r < 4; ++r) { *(LAS unsigned short*)(ob + (4 * g + r) * RS_OB + (32 * wy + 16 * sl + c16) * 2) = (unsigned short)(pk(o[sl][0][r], 0.f) & 0xffffu);
                    *(LAS unsigned short*)(ob + (16 + 4 * g + r) * RS_OB + (32 * wy + 16 * sl + c16) * 2) = (unsigned short)(pk(o[sl][1][r], 0.f) & 0xffffu); }
        }
        if (w < 4) SC3_DMA_WAIT();
        __syncthreads();
    }
    if (w < 4) {
#pragma unroll
        for (int pz = 0; pz < 2; ++pz) { const int p = xt + 256 * pz, tau = p >> 4, co = (p & 15) * 8;
            const v4u o = *(const LAS v4u*)(L + O_OB + ((NCH - 1) & 1) * OB_BYTES + tau * RS_OB + co * 2);
            if (PROBE_OUT) *(GAS v4u*)(Yp + (size_t)(SC3_ROW(NCH - 1, tau) - P) / DIN * D + dir * 1024 + h * 128 + co) = o; else *(GAS v4u*)(SC3_ROW(NCH - 1, tau) + zcol + co) = o; } }
#if SCAN_XPRIO
    __builtin_amdgcn_s_setprio(0);
#endif
    __syncthreads();
#undef SC3_ROW
#undef SC3_DMA
#undef SC3_DMA_WAIT
#undef SC3_IMAGES
}
#undef SC3_MFMA
}

#ifndef WIN_STAGGER_TICKS
#define WIN_STAGGER_TICKS 0
#endif
#ifndef GU_STAGGER_TICKS
#define GU_STAGGER_TICKS 0
#endif
#ifndef PROBE_T1
#define PROBE_T1 66000ull
#define PROBE_T2 70000ull
#define PROBE_T3 74000ull
#endif
#ifndef WIN_FUSE_PREP
#define WIN_FUSE_PREP 1
#endif
#ifndef MERGE_SCAN_ATTN
#define MERGE_SCAN_ATTN 1
#endif
#ifndef DOWN_REV
#define DOWN_REV 1
#endif
#ifndef GROUP_SEAMS
#define GROUP_SEAMS 1
#endif
#ifndef TAIL_CONVERT
#define TAIL_CONVERT 1
#endif
#ifndef PROBE_PM_MASK
#define PROBE_PM_MASK 0
#define PROBE_PN_MASK 0
#endif
#ifndef WGM_GU
#define WGM_GU 8
#define WGM_WIN 4
#define WGM_RES 4
#endif
#ifndef ATT_PROBE_MODE
#define ATT_PROBE_MODE 0
#endif
#ifndef GEMM_ALIGN
#define GEMM_ALIGN true
#endif
#ifndef PROBE_EPI_MODE
#define PROBE_EPI_MODE 4
#endif
#ifndef SCAN_PROBE_MODE
#define SCAN_PROBE_MODE 1
#endif
#ifndef PROBE_ARR_STEP
#define PROBE_ARR_FIRST 0
#define PROBE_ARR_STEP 8
#endif
#ifndef PROBE_ARRIVE
#define PROBE_ARRIVE 0
#endif
#ifndef DUP_MASK
#define DUP_MASK 0
#endif
#define REPS(b) ((((DUP_MASK) >> (b)) & 1) + 1)
#ifndef EN_P0
#define EN_P0 1
#endif
#ifndef EN_NORM
#define EN_NORM 1
#endif
#ifndef EN_GU
#define EN_GU 1
#endif
#ifndef EN_WIN
#define EN_WIN 1
#endif
#ifndef EN_PREP
#define EN_PREP 1
#endif
#ifndef EN_SCAN
#define EN_SCAN 1
#endif
#ifndef EN_ATTN
#define EN_ATTN 1
#endif
#ifndef EN_COMB
#define EN_COMB 1
#endif
#ifndef EN_RES
#define EN_RES 1
#endif
struct Args { const void* in[N_IN]; float* out; unsigned char* ws; int ph_lo, ph_hi; };
constexpr int PH_PER_LAYER = 9, NPH = 1 + DEPTH * PH_PER_LAYER;

__global__ void __launch_bounds__(NWAVES * 64, 2) fwd_kernel(Args args) {
    extern __shared__ __attribute__((aligned(16))) unsigned char lds[];
    LAS unsigned char* ldsb = (LAS unsigned char*)lds;
    volatile LAS unsigned* MISC = (volatile LAS unsigned*)(ldsb + MISC_OFF);
    const int tid0 = threadIdx.x;
    const int G = gridDim.x; const int bx = blockIdx.x; const int vcu = (G % 8 == 0) ? (bx % 8) * (G / 8) + bx / 8 : bx;
    const int NGW = G * NWAVES;
#define PHASE_IDS() int tid = threadIdx.x; asm volatile("" : "+v"(tid)); const int lane = tid & 63, wave = __builtin_amdgcn_readfirstlane(tid >> 6), gw = vcu * NWAVES + wave; (void)lane; (void)gw
    unsigned char* ws = args.ws;
    gu32* ctl = (gu32*)(ws + WS_CTL);
    for (int u = tid0; u < (LDS_BYTES - LDSCTL_OFF) / 4; u += NWAVES * 64) ((LAS unsigned*)(ldsb + LDSCTL_OFF))[u] = 0u;
    __syncthreads();
    const int lo = args.ph_lo, hi = args.ph_hi;
    const bool multi = (hi - lo) > 1;
    XcdBarrier bar; bar.bar = (unsigned*)(ctl + CW_BAR); bar.x = 0; bar.st = nullptr; bar.total = 0u;
    if (multi) bar = xcd_barrier_post((unsigned*)(ctl + CW_BAR), MISC + 8);
    const bool grouped = GROUP_SEAMS && multi && G == 256;
    XcdBarrier gbar = bar;
    if (grouped) gbar = xcd_barrier_post((unsigned*)(ctl + CW_BAR + 4096 * (1 + (bx & 7))), MISC + 12, (unsigned)(G / 8));
#define RUN(k) (lo <= (k) && (k) < hi)
#if PROBE_ARRIVE
#define SEAM(k) do { if (RUN(k) && RUN((k) + 1)) { if ((k) == PROBE_ARRIVE && threadIdx.x == 0) ((volatile unsigned long long*)(ws + WS_SMALL + 262144))[bx] = __builtin_amdgcn_s_memrealtime(); xcd_barrier(bar); } } while (0)
#else
#define SEAM(k) do { if (RUN(k) && RUN((k) + 1)) { xcd_barrier(bar); if (DUP_MASK & 4096) xcd_barrier(bar); } } while (0)
#endif
#define SEAM_L(k) do { if (RUN(k) && RUN((k) + 1)) { xcd_barrier(gbar); } } while (0)

    float* out = args.out;
    bf16* Y = (bf16*)(ws + WS_H); bf16* P = (bf16*)(ws + WS_P); bf16* ACT = P; bf16* XB = (bf16*)(ws + WS_OF); bf16* OA = (bf16*)(ws + WS_OA);
    unsigned* rowsq = (unsigned*)(ws + WS_ROWSQ);
    float* lbt = (float*)(ws + WS_SMALL); float* cosT = (float*)(ws + WS_ROPE); float* sinT = cosT + (size_t)M * 32;

    if (EN_P0 && RUN(0)) {
        PHASE_IDS();
        for (int rep = 0; rep < REPS(7); ++rep) {
        LAS float* scr = (LAS float*)(ldsb + RING_OFF + wave * 16384);
        { const int nq = (TAIL_CONVERT && G == 256) ? CONV_JIT_P0 : DEPTH * CONV_PER_LAYER;
          convert_items<true>(args, ws, CONV_PER_LAYER, gw, nq, NGW, 0, scr, lane); }
        xcopy_phase((const float*)args.in[I_X], XB, rowsq, gw, NGW, lane);
        { const int* pos = (const int*)args.in[I_POS];
          for (int i = (vcu * NWAVES * 64 + tid); i < M * 32; i += G * NWAVES * 64) { const int m = i >> 5, j = i & 31;
              const double ang = (double)(float)((float)pos[m] * (float)c_inv_freq[j]);
              double rev = ang * 0.15915494309189533577; rev -= __builtin_rint(rev);
              const float rf = (float)rev; cosT[i] = __builtin_amdgcn_cosf(rf); sinT[i] = __builtin_amdgcn_sinf(rf); } }
        { const float* lg = (const float*)args.in[I_LB];
          for (int i = (vcu * NWAVES * 64 + tid); i < 2 * 1024; i += G * NWAVES * 64) { const int dir = i >> 10, c = i & 1023;
              float l[DEPTH], mx = -1e30f;
#pragma unroll
              for (int j = 0; j < DEPTH; ++j) { l[j] = lg[(dir * DEPTH + j) * 1024 + c]; mx = fmaxf(mx, l[j]); }
              float sum = 0.f;
#pragma unroll
              for (int j = 0; j < DEPTH; ++j) { l[j] = expf(l[j] - mx); sum += l[j]; }
              float cum = 0.f;
#pragma unroll
              for (int j = 0; j < DEPTH; ++j) { if (j > 0) cum += l[j] / sum; lbt[(dir * DEPTH + j) * 1024 + c] = cum; } } }
        }
    }
    SEAM(0);

#pragma unroll 1
    for (int L = 0; L < DEPTH; ++L) {
#pragma unroll 1
        for (int st = 0; st < 3; ++st) {
            const int pb = 1 + PH_PER_LAYER * L + (st == 0 ? 0 : (st == 1 ? 2 : 7));
            const unsigned* rsq_in = rowsq + (size_t)(3 * L + st) * M;
            int plast;
            if (st != 1) {
                if (EN_GU && RUN(pb)) {
                    const bf16* W = (const bf16*)(ws + WS_WGU + (size_t)(2 * L + (st == 2 ? 1 : 0)) * SZ_WGU);
                    pg8::Gemm g{XB, W, M, NGU, D}; pg8::StaticOrder S; S.init(M, NGU, G, bx, WGM_GU);
                    pg8::EpiSwiGLU E{ACT, DFF, rsq_in};
#if DUP_MASK & 512
                    { pg8::EpiNone EN{(float*)(ws + WS_SMALL + 65536)}; pg8::gemm_phase<pg8::EpiNone, pg8::StaticOrder, GEMM_ALIGN, true>(ldsb + RING_OFF, g, S, EN); }
#endif
                    for (int rep = 0; rep < REPS(0); ++rep) pg8::gemm_phase<pg8::EpiSwiGLU, pg8::StaticOrder, GEMM_ALIGN, true>(ldsb + RING_OFF, g, S, E, (PROBE_STAMP && bx == 0 && L == 1 && st == 0) ? (unsigned long long*)(ws + WS_SMALL + 131072) : nullptr);
                    if (TAIL_CONVERT && G == 256 && bx >= 128) {
                        PHASE_IDS();
                        LAS float* scr = (LAS float*)(ldsb + RING_OFF + wave * 16384);
                        const int kph = 2 * L + (st == 2 ? 1 : 0), lo_q = CONV_JIT_P0 + kph * CONV_JIT_C, hi_q = (lo_q + CONV_JIT_C < DEPTH * CONV_PER_LAYER) ? lo_q + CONV_JIT_C : DEPTH * CONV_PER_LAYER;
                        convert_items<true>(args, ws, CONV_PER_LAYER, lo_q + (bx - 128) * NWAVES + wave, hi_q, 128 * NWAVES, 0, scr, lane);
                    }
                }
                SEAM(pb);
                plast = pb + 1;
            } else {
                if (EN_WIN && RUN(pb)) {
                    const bf16* W = (const bf16*)(ws + WS_WIN + (size_t)L * SZ_WIN);
                    pg8::Gemm g{XB, W, M, DIN, D}; pg8::StaticOrder S; S.init(M, DIN, G, bx, WGM_WIN);
                    pg8::EpiBf16Rot E{P, DIN, rsq_in, cosT, sinT, (const float*)args.in[I_DAQN] + L * 64, (const float*)args.in[I_DAKN] + L * 64, C_DAQ / 256, C_DAK / 256, C_DAV / 256};
#if DUP_MASK & 32768
                    { struct ProbeOrder : pg8::StaticOrder { __device__ bool next(int i, pg8::Unit& u) const { pg8::Unit t; const bool r = pg8::StaticOrder::next(i, t); u.pm = t.pm & PROBE_PM_MASK; u.pn = t.pn & PROBE_PN_MASK; return r; } } PS; PS.init(M, DIN, G, bx);
                      pg8::EpiNone EN{(float*)(ws + WS_SMALL + 65536)}; pg8::gemm_phase<pg8::EpiNone, ProbeOrder, true, true>(ldsb + RING_OFF, g, PS, EN); }
#endif
#if DUP_MASK & 65536
                    { pg8::EpiBf16Probe<PROBE_EPI_MODE> EN{P, 256}; pg8::gemm_phase<pg8::EpiBf16Probe<PROBE_EPI_MODE>, pg8::StaticOrder, GEMM_ALIGN, true>(ldsb + RING_OFF, g, S, EN); }
#endif
#if DUP_MASK & 2048
                    { pg8::EpiNone EN{(float*)(ws + WS_SMALL + 65536)}; pg8::gemm_phase<pg8::EpiNone, pg8::StaticOrder, GEMM_ALIGN, true>(ldsb + RING_OFF, g, S, EN); }
#endif
                    for (int rep = 0; rep < REPS(2); ++rep) pg8::gemm_phase<pg8::EpiBf16Rot, pg8::StaticOrder, GEMM_ALIGN, true>(ldsb + RING_OFF, g, S, E);
                }
                SEAM_L(pb);
                if (RUN(pb + 1)) {
                    PHASE_IDS();
                    if (EN_PREP && !WIN_FUSE_PREP) prep_phase(P, cosT, sinT, (const float*)args.in[I_DAQN] + L * 64, (const float*)args.in[I_DAKN] + L * 64, gw, NGW, lane);
#if DUP_MASK & 16
                    for (int u = vcu; u < BATCH * 8 * 2; u += G) { const int b = u >> 4, h = (u >> 1) & 7, dir = u & 1;
                        sc3::scan_unit<SCAN_PROBE_MODE>(P, lbt + (size_t)(dir * DEPTH + L) * 1024, b, h, dir, ldsb + RING_OFF, tid, Y); }
#endif
                    if (EN_SCAN)
                    for (int u = vcu; u < BATCH * 8 * 2; u += G) { const int b = u >> 4, h = (u >> 1) & 7, dir = u & 1;
                        sc3::scan_unit(P, lbt + (size_t)(dir * DEPTH + L) * 1024, b, h, dir, ldsb + RING_OFF, tid); }
                }
#if !(WIN_FUSE_PREP && MERGE_SCAN_ATTN)
                SEAM(pb + 1);
#endif
                if (EN_ATTN && RUN(pb + 2)) {
                    float mbC;
                    { PHASE_IDS(); const float gq = fabsf(((const float*)args.in[I_DAQN])[L * 64 + lane]), gk = fabsf(((const float*)args.in[I_DAKN])[L * 64 + lane]); float mq = gq, mk = gk;
#pragma unroll
                      for (int o = 1; o < 64; o <<= 1) { mq = fmaxf(mq, __shfl_xor(mq, o)); mk = fmaxf(mk, __shfl_xor(mk, o)); }
                      mbC = fminf(8.0f * mq * mk, 40.0f) * 1.4426950408889634f; }
#if ATT_PROBE_MODE
                    for (int u = vcu; u < BATCH * 4 * 2 * (SEQ / 256); u += G) { const int qb = u & 7, cmb = u >> 3, map = cmb & 1, h = (cmb >> 1) & 3, b = cmb >> 3;
                        const bf16* Pb = P + (size_t)b * SEQ * DIN;
                        __syncthreads();
                        att::attn_unit<ATT_PROBE_MODE>(Pb + (size_t)(qb * 256) * DIN + C_DAQ + h * 128 + map * 64, Pb + C_DAK + h * 128 + map * 64, Pb + C_DAV + h * 128,
                                       OA + ((size_t)b * SEQ + qb * 256) * 1024 + h * 256 + map * 128, SEQ, (char*)lds + RING_OFF, mbC); }
#endif
                    for (int rep = 0; rep < REPS(5); ++rep)
                    for (int uu = vcu; uu < BATCH * 4 * 2 * (SEQ / 256); uu += G) {
                        const int u = grouped ? (bx & 7) * 128 + (bx >> 3) + 32 * (uu >> 8) : uu;
                        const int qb = u & 7, cmb = u >> 3, map = cmb & 1, h = (cmb >> 1) & 3, b = cmb >> 3;
                        const bf16* Pb = P + (size_t)b * SEQ * DIN;
                        __syncthreads();
                        att::attn_unit(Pb + (size_t)(qb * 256) * DIN + C_DAQ + h * 128 + map * 64, Pb + C_DAK + h * 128 + map * 64, Pb + C_DAV + h * 128,
                                       OA + ((size_t)b * SEQ + qb * 256) * 1024 + h * 256 + map * 128, SEQ, (char*)lds + RING_OFF, mbC); }
                    __syncthreads();
                }
                SEAM_L(pb + 2);
                if (EN_COMB && RUN(pb + 3)) {
                    PHASE_IDS();
                    for (int rep = 0; rep < REPS(8); ++rep) combine_phase(P, OA, Y, (const float*)args.in[I_HGN] + L * 1024, (const float*)args.in[I_DAON] + L * 512, (const float*)args.in[I_LQ1] + L * 64, (const float*)args.in[I_LK1] + L * 64,
                                  (const float*)args.in[I_LQ2] + L * 64, (const float*)args.in[I_LK2] + L * 64, c_lam_init[L], (const float*)args.in[I_CW] + L * 1536, (const float*)args.in[I_CB] + L * 512,
                                  (const float*)args.in[I_CN] + L * 512, grouped ? (bx >> 3) * NWAVES + wave : gw, grouped ? (G / 8) * NWAVES : NGW, lane,
                                  grouped ? (bx & 7) * (M / 8) : 0, grouped ? ((bx & 7) + 1) * (M / 8) : M);
                }
                SEAM_L(pb + 3);
                plast = pb + 4;
            }
            if (EN_RES && RUN(plast)) {
                const bf16* A = (st == 1) ? Y : ACT; const int K = (st == 1) ? D : DFF;
                const bf16* W = (st == 1) ? (const bf16*)(ws + WS_WOUT + (size_t)L * SZ_WOUT) : (const bf16*)(ws + WS_WD + (size_t)(2 * L + (st == 2 ? 1 : 0)) * SZ_WD);
                pg8::Gemm g{A, W, M, D, K}; pg8::StaticOrder S; S.init(M, D, G, bx, WGM_RES, (st != 1) ? DOWN_REV : 0);
#if DUP_MASK & 1024
                if (st != 1) { pg8::EpiNone EN{(float*)(ws + WS_SMALL + 65536)}; pg8::gemm_phase<pg8::EpiNone, pg8::StaticOrder, GEMM_ALIGN, true>(ldsb + RING_OFF, g, S, EN); }
#endif
                const float scale = (st == 1) ? 1.0f : 0.5f;
#if DUP_MASK & 2
                if (st != 1) { pg8::EpiResAdd<false, false> E0{XB, out, nullptr, D, 0.0f}; pg8::gemm_phase<pg8::EpiResAdd<false, false>, pg8::StaticOrder, GEMM_ALIGN, true>(ldsb + RING_OFF, g, S, E0); }
#endif
#if DUP_MASK & 8
                if (st == 1) { pg8::EpiResAdd<false, false> E0{XB, out, nullptr, D, 0.0f}; pg8::gemm_phase<pg8::EpiResAdd<false, false>, pg8::StaticOrder, GEMM_ALIGN, true>(ldsb + RING_OFF, g, S, E0); }
#endif
                if (L == DEPTH - 1 && st == 2) { pg8::EpiResAdd<true> E{XB, out, nullptr, D, scale}; pg8::gemm_phase<pg8::EpiResAdd<true>, pg8::StaticOrder, GEMM_ALIGN, true>(ldsb + RING_OFF, g, S, E); }
                else { pg8::EpiResAdd<false> E{XB, out, rowsq + (size_t)(3 * L + st + 1) * M, D, scale}; pg8::gemm_phase<pg8::EpiResAdd<false>, pg8::StaticOrder, GEMM_ALIGN, true>(ldsb + RING_OFF, g, S, E); }
            }
            SEAM_L(plast);
        }
    }
#if PROBE_ARRIVE
    if (hi == NPH) { xcd_barrier(bar); if (bx == 0 && tid0 == 0) { unsigned long long mn = ~0ull, mx = 0; for (int i = PROBE_ARR_FIRST; i < G; i += PROBE_ARR_STEP) { const unsigned long long t = ((volatile unsigned long long*)(ws + WS_SMALL + 262144))[i]; mn = t < mn ? t : mn; mx = t > mx ? t : mx; }
        const unsigned long long d_ = mx - mn; const int code_ = (d_ > PROBE_T1) + 2 * (d_ > PROBE_T2) + 4 * (d_ > PROBE_T3); if (code_) out[0] = 1.0e6f * code_; } }
#endif
#if PROBE_STAMP
    if (hi == NPH) { xcd_barrier(bar); if (bx == 0 && tid0 == 0) { const unsigned long long d_ = *(volatile unsigned long long*)(ws + WS_SMALL + 131072); const int code_ = (d_ > PROBE_T1) + 2 * (d_ > PROBE_T2) + 4 * (d_ > PROBE_T3); if (code_) out[0] = 1.0e6f * code_; } }
#endif
#undef RUN
#undef SEAM
}

#ifndef MK_PER_PHASE
#define MK_PER_PHASE 0
#endif
extern "C" void kernel_launch(void* const* d_in, const int* in_sizes, int n_in, void* d_out, int out_size, void* d_ws, size_t ws_size, hipStream_t stream) {
    static int grid = 0;
    if (grid == 0) {
        if (n_in != N_IN || in_sizes[0] != M * D || out_size != M * D || ws_size < WS_END) {
            fprintf(stderr, "kernel_launch: shape/workspace mismatch: n_in %d in0 %d out %d ws %zu (need %zu); nothing launched\n", n_in, n_in > 0 ? in_sizes[0] : -1, out_size, ws_size, (size_t)WS_END); grid = -1; return; }
        int dev = 0, cus = 0, per_cu = 0;
        if (hipGetDevice(&dev) != hipSuccess || hipDeviceGetAttribute(&cus, hipDeviceAttributeMultiprocessorCount, dev) != hipSuccess) { fprintf(stderr, "kernel_launch: device query failed\n"); grid = -1; return; }
        if (hipFuncSetAttribute((const void*)fwd_kernel, hipFuncAttributeMaxDynamicSharedMemorySize, LDS_BYTES) != hipSuccess) { fprintf(stderr, "kernel_launch: hipFuncSetAttribute failed\n"); grid = -1; return; }
        if (hipOccupancyMaxActiveBlocksPerMultiprocessor(&per_cu, (const void*)fwd_kernel, NWAVES * 64, LDS_BYTES) != hipSuccess || per_cu < 1)
            fprintf(stderr, "kernel_launch: note: occupancy query reports %d workgroups per CU\n", per_cu);
        (void)hipGetLastError();
        grid = cus;
    }
    if (grid < 0) return;
    if (hipMemsetAsync((char*)d_ws + WS_CTL, 0, CTL_ZERO_BYTES, stream) != hipSuccess) { fprintf(stderr, "kernel_launch: memset failed\n"); return; }
    Args a{};
    for (int i = 0; i < N_IN; ++i) a.in[i] = d_in[i];
    a.out = (float*)d_out; a.ws = (unsigned char*)d_ws;
#if MK_PER_PHASE
    for (int p = 0; p < NPH; ++p) { a.ph_lo = p; a.ph_hi = p + 1;
        hipLaunchKernelGGL(fwd_kernel, dim3(grid), dim3(NWAVES * 64), LDS_BYTES, stream, a); }
#else
    a.ph_lo = 0; a.ph_hi = NPH;
    hipLaunchKernelGGL(fwd_kernel, dim3(grid), dim3(NWAVES * 64), LDS_BYTES, stream, a);
#endif
    const hipError_t le = hipPeekAtLastError();
    if (le != hipSuccess) fprintf(stderr, "kernel_launch: launch failed: %s\n", hipGetErrorName(le));
}
```
